# Optimizing an MI355X kernel written in HIP

```python
import math
import jax, jax.numpy as jnp
from jax import lax
import numpy as np

D_MODEL = 1024
BATCH = 16
SEQ = 2048
DEPTH = 1

ATT_HEADS = 8
ATT_KV_HEADS = 2
ATT_Q_PER_KV = ATT_HEADS // ATT_KV_HEADS
ATT_HEAD_DIM = 64
WINDOW = 128
ATT_BLOCK = 128
NEG_INF = -1e30
RET_HEADS = 8
RET_DK = 64
RET_DV = 128
RET_CHUNK = 128
ATT_Q_W = ATT_HEADS * ATT_HEAD_DIM
ATT_KV_W = ATT_KV_HEADS * ATT_HEAD_DIM
RET_QK_W = RET_HEADS * RET_DK
RET_V_W = RET_HEADS * RET_DV
SPLIT_SIZES = (ATT_Q_W, ATT_KV_W, ATT_KV_W, RET_QK_W, RET_QK_W, RET_V_W, RET_V_W, D_MODEL, D_MODEL)
SPLIT_POINTS = tuple(int(v) for v in np.cumsum(SPLIT_SIZES)[:-1])
IN_W = int(sum(SPLIT_SIZES))
N_GROUPS = 4
EXPERTS_PER_GROUP = 8
N_EXPERTS = N_GROUPS * EXPERTS_PER_GROUP
TOP_K = 2
D_EXPERT = 512
MOE_BLOCK = 128
EPS = 1e-6

kernel_name = "hybrid_swa_retention_hiermoe_block"


def rms_norm(x, g):
    xf = x.astype(jnp.float32)
    y = xf * lax.rsqrt(jnp.mean(xf * xf, axis=-1, keepdims=True) + EPS)
    return (y * g.astype(jnp.float32)).astype(x.dtype)


def alibi_slopes():
    return 2.0 ** (-8.0 * jnp.arange(1, ATT_HEADS + 1, dtype=jnp.float32) / ATT_HEADS)


def sliding_window_attention(q, k, v, sinks):
    B, S = q.shape[0], q.shape[1]
    N, C = S // ATT_BLOCK, ATT_BLOCK
    qb = q.reshape(B, N, C, ATT_KV_HEADS, ATT_Q_PER_KV, ATT_HEAD_DIM).astype(jnp.float32)
    kb = k.reshape(B, N, C, ATT_KV_HEADS, ATT_HEAD_DIM).astype(jnp.float32)
    vb = v.reshape(B, N, C, ATT_KV_HEADS, ATT_HEAD_DIM).astype(jnp.float32)

    def band(t):
        prev = jnp.pad(t, ((0, 0), (1, 0), (0, 0), (0, 0), (0, 0)))[:, :-1]
        return jnp.concatenate([prev, t], axis=2)

    kband, vband = band(kb), band(vb)
    s = jnp.einsum("bnikgd,bnjkd->bnkgij", qb, kband) * (ATT_HEAD_DIM ** -0.5)
    qi = jnp.arange(C)[:, None] + C
    kj = jnp.arange(2 * C)[None, :]
    dist = qi - kj
    in_window = (dist >= 0) & (dist < WINDOW)
    blk = jnp.arange(N)[:, None, None]
    valid = in_window[None] & ((blk > 0) | (kj[None] >= C))
    slopes = alibi_slopes().reshape(ATT_KV_HEADS, ATT_Q_PER_KV, 1, 1)
    s = s - slopes * dist.astype(jnp.float32)
    s = jnp.where(valid[None, :, None, None], s, NEG_INF)
    sink = sinks.astype(jnp.float32).reshape(ATT_KV_HEADS, ATT_Q_PER_KV, 1, 1)
    m = jnp.maximum(jnp.max(s, axis=-1, keepdims=True), sink)
    p = jnp.exp(s - m)
    denom = jnp.sum(p, axis=-1, keepdims=True) + jnp.exp(sink - m)
    o = jnp.einsum("bnkgij,bnjkd->bnikgd", p / denom, vband)
    return o.reshape(B, S, ATT_Q_W).astype(q.dtype)


def retention(q, k, v):
    B, S = q.shape[0], q.shape[1]
    N, C = S // RET_CHUNK, RET_CHUNK
    log_g = jnp.log(1.0 - 2.0 ** (-5.0 - jnp.arange(RET_HEADS, dtype=jnp.float32)))
    qc = q.reshape(B, N, C, RET_HEADS, RET_DK).astype(jnp.float32)
    kc = k.reshape(B, N, C, RET_HEADS, RET_DK).astype(jnp.float32) * (RET_DK ** -0.5)
    vc = v.reshape(B, N, C, RET_HEADS, RET_DV).astype(jnp.float32)
    pos = jnp.arange(C, dtype=jnp.float32)
    diff = pos[:, None] - pos[None, :]
    decay = jnp.where(diff >= 0, jnp.exp(jnp.maximum(diff, 0.0)[None] * log_g[:, None, None]), 0.0)
    scores = jnp.einsum("bnihd,bnjhd->bnhij", qc, kc) * decay
    inner = jnp.einsum("bnhij,bnjhe->bnihe", scores, vc)
    k_dec = kc * jnp.exp((C - 1 - pos)[:, None] * log_g)[None, None, :, :, None]
    kv = jnp.einsum("bnjhd,bnjhe->nbhde", k_dec, vc)
    chunk_decay = jnp.exp(C * log_g)[None, :, None, None]

    def step(state, kv_n):
        return state * chunk_decay + kv_n, state

    _, state_prev = lax.scan(step, jnp.zeros((B, RET_HEADS, RET_DK, RET_DV), jnp.float32), kv)
    q_dec = qc * jnp.exp((pos + 1.0)[:, None] * log_g)[None, None, :, :, None]
    cross = jnp.einsum("bnihd,nbhde->bnihe", q_dec, state_prev)
    y = (inner + cross).reshape(B, S, RET_HEADS, RET_DV)
    mu = jnp.mean(y, axis=-1, keepdims=True)
    var = jnp.mean(jnp.square(y - mu), axis=-1, keepdims=True)
    return (y - mu) * lax.rsqrt(var + EPS)


def gated_mixer(h, w_in, b_in, attn_sinks, w_attn_up, w_ret_up, w_out):
    B, S = h.shape[0], h.shape[1]
    proj = h @ w_in + b_in
    aq, ak, av, rq, rk, rv, rg, ga, gr = jnp.split(proj, SPLIT_POINTS, axis=-1)
    attn = sliding_window_attention(
        aq.reshape(B, S, ATT_HEADS, ATT_HEAD_DIM),
        ak.reshape(B, S, ATT_KV_HEADS, ATT_HEAD_DIM),
        av.reshape(B, S, ATT_KV_HEADS, ATT_HEAD_DIM), attn_sinks)
    attn = attn @ w_attn_up
    ret = retention(rq.reshape(B, S, RET_HEADS, RET_DK),
                    rk.reshape(B, S, RET_HEADS, RET_DK),
                    rv.reshape(B, S, RET_HEADS, RET_DV))
    ret = (ret.reshape(B, S, RET_V_W) * jax.nn.silu(rg.astype(jnp.float32))).astype(h.dtype)
    ret = ret @ w_ret_up
    mix = jax.nn.sigmoid(ga) * attn + jax.nn.sigmoid(gr) * ret
    return mix @ w_out


def hierarchical_moe(h, w_group_router, b_group_router, w_expert_router, b_expert_router,
                     w_gate_e, w_up_e, w_down_e):
    B, S, D = h.shape
    T = B * S
    A = T * TOP_K
    P = A + N_EXPERTS * MOE_BLOCK
    NB = P // MOE_BLOCK
    ht = h.reshape(T, D)
    g_logits = (ht @ w_group_router + b_group_router).astype(jnp.float32)
    g_probs = jax.nn.softmax(g_logits, axis=-1)
    g_idx = jnp.argmax(g_logits, axis=-1)
    g_prob = jnp.take_along_axis(g_probs, g_idx[:, None], axis=-1)
    e_logits = (ht @ w_expert_router + b_expert_router).astype(jnp.float32)
    e_logits = e_logits.reshape(T, N_GROUPS, EXPERTS_PER_GROUP)
    e_in_group = jnp.take_along_axis(e_logits, g_idx[:, None, None], axis=1)[:, 0]
    top_vals, top_idx = lax.top_k(e_in_group, TOP_K)
    weights = g_prob * jax.nn.softmax(top_vals, axis=-1)
    expert_ids = (g_idx[:, None] * EXPERTS_PER_GROUP + top_idx).reshape(A).astype(jnp.int32)
    tok_ids = jnp.arange(A, dtype=jnp.int32) // TOP_K
    order = jnp.argsort(expert_ids)
    sorted_e = expert_ids[order]
    counts = jnp.zeros((N_EXPERTS,), jnp.int32).at[expert_ids].add(1)
    pad_sizes = ((counts + MOE_BLOCK - 1) // MOE_BLOCK) * MOE_BLOCK
    pad_end = jnp.cumsum(pad_sizes)
    pad_start = pad_end - pad_sizes
    cnt_start = jnp.cumsum(counts) - counts
    dest_sorted = pad_start[sorted_e] + (jnp.arange(A, dtype=jnp.int32) - cnt_start[sorted_e])
    dest = jnp.zeros((A,), jnp.int32).at[order].set(dest_sorted)
    buf_tok = jnp.full((P,), T, jnp.int32).at[dest].set(tok_ids)
    h_pad = jnp.concatenate([ht, jnp.zeros((1, D), ht.dtype)], axis=0)
    x_blocks = h_pad[buf_tok].reshape(NB, MOE_BLOCK, D)
    block_start = jnp.arange(NB, dtype=jnp.int32) * MOE_BLOCK
    block_e = jnp.minimum(jnp.searchsorted(pad_end, block_start, side="right"), N_EXPERTS - 1)

    def expert_block(args):
        xb, e = args
        return (jax.nn.silu(xb @ w_gate_e[e]) * (xb @ w_up_e[e])) @ w_down_e[e]

    y_buf = lax.map(expert_block, (x_blocks, block_e)).reshape(P, D)
    y = jnp.sum(y_buf[dest].reshape(T, TOP_K, D) * weights[..., None].astype(h.dtype), axis=1)
    return y.reshape(B, S, D)


def setup_inputs(seed: int = 0) -> dict:
    key = jax.random.key(seed)
    ks = jax.random.split(key, 20)
    L, D = DEPTH, D_MODEL
    f32 = jnp.float32

    def nrm(k, shape, scale):
        return jax.random.normal(k, shape, f32) * scale

    return {
        "x": jax.random.normal(ks[0], (BATCH, SEQ, D), f32),
        "norm_mix_g": 1.0 + nrm(ks[1], (L, D), 0.02),
        "w_in": nrm(ks[2], (L, D, IN_W), D ** -0.5),
        "b_in": nrm(ks[3], (L, IN_W), 0.02),
        "attn_sinks": nrm(ks[4], (L, ATT_HEADS), 0.5),
        "w_attn_up": nrm(ks[5], (L, ATT_Q_W, D), ATT_Q_W ** -0.5),
        "w_ret_up": nrm(ks[6], (L, RET_V_W, D), RET_V_W ** -0.5),
        "w_out": nrm(ks[7], (L, D, D), D ** -0.5),
        "norm_ffn_g": 1.0 + nrm(ks[8], (L, D), 0.02),
        "w_group_router": nrm(ks[9], (L, D, N_GROUPS), D ** -0.5),
        "b_group_router": nrm(ks[10], (L, N_GROUPS), 0.01),
        "w_expert_router": nrm(ks[11], (L, D, N_EXPERTS), D ** -0.5),
        "b_expert_router": nrm(ks[12], (L, N_EXPERTS), 0.01),
        "w_gate_e": nrm(ks[13], (L, N_EXPERTS, D, D_EXPERT), D ** -0.5),
        "w_up_e": nrm(ks[14], (L, N_EXPERTS, D, D_EXPERT), D ** -0.5),
        "w_down_e": nrm(ks[15], (L, N_EXPERTS, D_EXPERT, D), D_EXPERT ** -0.5),
        "norm_final_g": 1.0 + nrm(ks[16], (D,), 0.02),
    }


def reference(x, norm_mix_g, w_in, b_in, attn_sinks, w_attn_up, w_ret_up, w_out,
              norm_ffn_g, w_group_router, b_group_router, w_expert_router, b_expert_router,
              w_gate_e, w_up_e, w_down_e, norm_final_g):
    for l in range(DEPTH):
        h = rms_norm(x, norm_mix_g[l])
        x = x + gated_mixer(h, w_in[l], b_in[l], attn_sinks[l], w_attn_up[l], w_ret_up[l], w_out[l])
        h = rms_norm(x, norm_ffn_g[l])
        x = x + hierarchical_moe(h, w_group_router[l], b_group_router[l], w_expert_router[l],
                                 b_expert_router[l], w_gate_e[l], w_up_e[l], w_down_e[l])
    return rms_norm(x, norm_final_g)
```

```cpp
#include <hip/hip_runtime.h>
#include <hip/hip_cooperative_groups.h>
#include <cstdio>
#include <cstdint>
namespace cg = cooperative_groups;

#ifndef PROBE_REP
#define PROBE_REP 0
#endif
#ifndef MK_N_LAUNCHES
#define MK_N_LAUNCHES 1
#endif

#define LAS __attribute__((address_space(3)))
#define GAS __attribute__((address_space(1)))
typedef unsigned short bf16_t;
typedef short bf16x8 __attribute__((ext_vector_type(8)));
typedef float f32x4 __attribute__((ext_vector_type(4)));
typedef float f32x2 __attribute__((ext_vector_type(2)));
typedef unsigned u32x4 __attribute__((ext_vector_type(4)));
typedef unsigned u32x2 __attribute__((ext_vector_type(2)));

constexpr int DM = 1024, NB = 16, SEQ = 2048, T = NB * SEQ;
constexpr int INW = 5888, PAW = 3840, GTW = 2048;
constexpr int C_AQ = 0, C_AK = 512, C_AV = 640, C_RQ = 768, C_RK = 1280, C_RV = 1792, C_RG = 2816;
constexpr int ARW = 1536;
constexpr int NEXP = 32, DEXP = 512;
constexpr int PSLOT = 65536 + 8192;
constexpr float EPS = 1e-6f;

constexpr size_t MiB = 1u << 20;
constexpr size_t WS_CTL = 0, CTL_ZERO_BYTES = 1 * MiB;
constexpr size_t WS_WIN = 2 * MiB;
constexpr size_t WS_WUP = 14 * MiB;
constexpr size_t WS_WOUT = 17 * MiB;
constexpr size_t WS_WGU = 20 * MiB;
constexpr size_t WS_WD = 84 * MiB;
constexpr size_t WS_PA = 116 * MiB;
constexpr size_t WS_GT = 356 * MiB;
constexpr size_t WS_TOK = 484 * MiB;
constexpr size_t WS_END = 486 * MiB;
constexpr size_t WS_MIX = 116 * MiB;
constexpr size_t WS_H2 = 180 * MiB;
constexpr size_t WS_XG = 244 * MiB;
constexpr size_t WS_ACT = 388 * MiB;
constexpr size_t WS_YB = 116 * MiB;
constexpr int CW_CNT = 1024;
constexpr int CW_BAR = 4096;

constexpr int RING_BYTES = 131072;
constexpr int SCRATCH_BYTES = 147456;
constexpr int MISC_OFF = SCRATCH_BYTES;
constexpr int LDS_BYTES = SCRATCH_BYTES + 1024;

__device__ __forceinline__ unsigned f2bf(float f) { unsigned u = __builtin_bit_cast(unsigned, f); return (u + 0x7fffu + ((u >> 16) & 1u)) >> 16; }
__device__ __forceinline__ unsigned pk2(float lo, float hi) { return f2bf(lo) | (f2bf(hi) << 16); }
__device__ __forceinline__ float bflo(unsigned w) { return __builtin_bit_cast(float, w << 16); }
__device__ __forceinline__ float bfhi(unsigned w) { return __builtin_bit_cast(float, w & 0xffff0000u); }
__device__ __forceinline__ float bf2f(bf16_t b) { return __builtin_bit_cast(float, (unsigned)b << 16); }
__device__ __forceinline__ unsigned cvt_pk_bf16(float lo, float hi) { unsigned r; asm volatile("v_cvt_pk_bf16_f32 %0, %1, %2" : "=v"(r) : "v"(lo), "v"(hi)); return r; }
__device__ __forceinline__ float sigmoidf_(float v) { return 1.0f / (1.0f + __expf(-v)); }
__device__ __forceinline__ float wave_sum(float v) {
#pragma unroll
    for (int o = 1; o < 64; o <<= 1) v += __shfl_xor(v, o);
    return v;
}
#define LDS_WAIT() asm volatile("s_waitcnt lgkmcnt(0)" ::: "memory")
#define VM_WAIT() asm volatile("s_waitcnt vmcnt(0)" ::: "memory")

namespace pg8 {
constexpr int BM = 256, BK = 64, HALF = 128, HTB = HALF * BK * 2, STAGE_BYTES = 8 * HTB;
__host__ __device__ __forceinline__ int lds_byte(int r, int c) { const int st = (r >> 4) * 2 + (c >> 5), rr = r & 15, cc = c & 31, ob = rr * 64 + cc * 2; return st * 1024 + (ob ^ (((ob >> 9) & 1) << 5)); }
__host__ __device__ __forceinline__ void stage_rc(int b, int& R, int& C) { const int st = b / 1024, sb = b % 1024, swz = sb ^ (((sb >> 9) & 1) << 5); R = (st >> 1) * 16 + swz / 64; C = (st & 1) * 32 + (swz % 64) / 2; }
__host__ __device__ __forceinline__ int perm32(int rho) { const int n = rho >> 4, i = rho & 15; return 8 * (i >> 2) + 4 * n + (i & 3); }

struct Unit { const char* a; const char* b; int pm, pn, nt, aux; };

template <class Epi, class Sched>
__device__ __forceinline__ void gemm_phase(LAS unsigned char* lds, const int ld  , const Sched& S, const Epi& E) {
    const int tid = threadIdx.x, wid = __builtin_amdgcn_readfirstlane(tid >> 6), lane = tid & 63, wr = wid >> 2, wc = wid & 3, fr = lane & 15, fq = lane >> 4;
    unsigned voffA[2], voffB[2];
#pragma unroll
    for (int i = 0; i < 2; ++i) { int R, C; stage_rc(tid * 16 + i * 8192, R, C); const int Rb = Epi::PERM ? ((R & ~31) + perm32(R & 31)) : R;
        voffA[i] = (unsigned)(R * ld + C) * 2u; voffB[i] = (unsigned)(Rb * ld + C) * 2u; }
    const size_t kstep = (size_t)(BK * 2);
    const size_t hstep = (size_t)HALF * ld * 2;
    const unsigned ldsw = (unsigned)wid * 1024u;
    const int aoff = lds_byte(wr * 64 + fr, fq * 8), boff = lds_byte(wc * 32 + fr, fq * 8);
#define PG8_SA(b, h) (((b) * 2 + (h)) * HTB)
#define PG8_SB(b, h) ((4 + (b) * 2 + (h)) * HTB)
#define PG8_STAGE(bufoff, gbase, voff) do { _Pragma("unroll") for (int _i = 0; _i < 2; ++_i) \
        __builtin_amdgcn_global_load_lds((const unsigned*)((const char*)(gbase) + (voff)[_i]), (LAS unsigned*)(lds + (bufoff) + ldsw + _i * 8192), 16, 0, 0); } while (0)
#define PG8_LDA(dst, b, h) do { _Pragma("unroll") for (int m = 0; m < 4; ++m) _Pragma("unroll") for (int k = 0; k < 2; ++k) dst[m][k] = *(const LAS bf16x8*)(lds + PG8_SA(b, h) + aoff + m * 2048 + k * 1024); } while (0)
#define PG8_LDB(dst, b, h) do { _Pragma("unroll") for (int n = 0; n < 2; ++n) _Pragma("unroll") for (int k = 0; k < 2; ++k) dst[n][k] = *(const LAS bf16x8*)(lds + PG8_SB(b, h) + boff + n * 2048 + k * 1024); } while (0)
#define PG8_MMA(ai, bj, At, Bt) do { __builtin_amdgcn_s_setprio(1); _Pragma("unroll") for (int m = 0; m < 4; ++m) _Pragma("unroll") for (int n = 0; n < 2; ++n) _Pragma("unroll") for (int k = 0; k < 2; ++k) \
        acc[ai][bj][m][n] = __builtin_amdgcn_mfma_f32_16x16x32_bf16(Bt[n][k], At[m][k], acc[ai][bj][m][n], 0, 0, 0); __builtin_amdgcn_s_setprio(0); } while (0)
#define PG8_WAIT_V(n) asm volatile("s_waitcnt vmcnt(" #n ")" ::: "memory")
#define PG8_WAIT_L(n) asm volatile("s_waitcnt lgkmcnt(" #n ")" ::: "memory")
#define PG8_BAR __builtin_amdgcn_s_barrier()
#define PG8_SCHED __builtin_amdgcn_sched_barrier(0)
    Unit cur, nxt; int ui = 0;
    if (!S.next(0, cur)) return;
    f32x4 acc[2][2][4][2];
#pragma unroll
    for (int a = 0; a < 2; ++a)
#pragma unroll
        for (int b = 0; b < 2; ++b)
#pragma unroll
            for (int m = 0; m < 4; ++m)
#pragma unroll
                for (int n = 0; n < 2; ++n) acc[a][b][m][n] = (f32x4){0.f, 0.f, 0.f, 0.f};
    bf16x8 At[4][2], B0[2][2], B1[2][2];
    const char* cA = cur.a; const char* cB = cur.b;
    PG8_STAGE(PG8_SB(0, 0), cB, voffB); PG8_STAGE(PG8_SB(0, 1), cB + hstep, voffB); PG8_STAGE(PG8_SA(0, 0), cA, voffA); PG8_STAGE(PG8_SA(0, 1), cA + hstep, voffA);
    if (wr == 1) PG8_BAR;
    PG8_WAIT_V(2); PG8_BAR;
    PG8_STAGE(PG8_SB(1, 0), cB + kstep, voffB); PG8_STAGE(PG8_SA(1, 0), cA + kstep, voffA); PG8_STAGE(PG8_SB(1, 1), cB + hstep + kstep, voffB);
    PG8_WAIT_V(6); PG8_BAR;
    for (;;) {
        const bool has_next = S.next(ui + 1, nxt);
        const char* nA = has_next ? nxt.a : cA; const char* nB = has_next ? nxt.b : cB;
        const int nt = cur.nt;
        for (int t = 0; t < nt; t += 2) {
            const bool last = (t == nt - 2);
            const char* a1 = cA + (size_t)(t + 1) * kstep;
            const char* a2 = last ? nA : cA + (size_t)(t + 2) * kstep; const char* b2 = last ? nB : cB + (size_t)(t + 2) * kstep;
            const char* a3 = a2 + kstep; const char* b3 = b2 + kstep;
            PG8_LDB(B0, 0, 0); PG8_LDB(B1, 0, 1); PG8_SCHED; PG8_LDA(At, 0, 0); PG8_STAGE(PG8_SA(1, 1), a1 + hstep, voffA);
            PG8_WAIT_V(8); PG8_WAIT_L(0); PG8_BAR; PG8_MMA(0, 0, At, B0); PG8_MMA(0, 1, At, B1); PG8_BAR; PG8_SCHED;
            PG8_LDA(At, 0, 1); PG8_STAGE(PG8_SB(0, 0), b2, voffB); PG8_STAGE(PG8_SB(0, 1), b2 + hstep, voffB); PG8_STAGE(PG8_SA(0, 0), a2, voffA);
            PG8_WAIT_V(8); PG8_WAIT_L(0); PG8_BAR; PG8_MMA(1, 0, At, B0); PG8_MMA(1, 1, At, B1); PG8_BAR; PG8_SCHED;
            PG8_LDB(B0, 1, 0); PG8_LDB(B1, 1, 1); PG8_SCHED; PG8_LDA(At, 1, 0); PG8_STAGE(PG8_SA(0, 1), a2 + hstep, voffA);
            PG8_WAIT_V(8); PG8_WAIT_L(0); PG8_BAR; PG8_MMA(0, 0, At, B0); PG8_MMA(0, 1, At, B1); PG8_BAR; PG8_SCHED;
            PG8_LDA(At, 1, 1); PG8_STAGE(PG8_SB(1, 0), b3, voffB); PG8_STAGE(PG8_SB(1, 1), b3 + hstep, voffB); PG8_STAGE(PG8_SA(1, 0), a3, voffA);
            PG8_WAIT_V(8); PG8_WAIT_L(0); PG8_BAR; PG8_MMA(1, 0, At, B0); PG8_MMA(1, 1, At, B1); PG8_BAR; PG8_SCHED;
        }
        if (wr == 0) PG8_BAR;
        E(acc, cur, wr, wc, fr, fq);
        if (!has_next) break;
#pragma unroll
        for (int a = 0; a < 2; ++a)
#pragma unroll
            for (int b = 0; b < 2; ++b)
#pragma unroll
                for (int m = 0; m < 4; ++m)
#pragma unroll
                    for (int n = 0; n < 2; ++n) acc[a][b][m][n] = (f32x4){0.f, 0.f, 0.f, 0.f};
        cur = nxt; cA = nA; cB = nB; ++ui;
        if (wr == 1) PG8_BAR;
    }
    PG8_WAIT_V(0);
    PG8_BAR;
#undef PG8_SA
#undef PG8_SB
#undef PG8_STAGE
#undef PG8_LDA
#undef PG8_LDB
#undef PG8_MMA
#undef PG8_WAIT_V
#undef PG8_WAIT_L
#undef PG8_BAR
#undef PG8_SCHED
}
typedef f32x4 Acc[2][2][4][2];
}

#define XB_TMO      128
#define XB_XCNT(j)  (256  + 64 * (j))
#define XB_XSUB(j)  (1280 + 64 * (j))
#define XB_XGEN(j)  (2304 + 64 * (j))
#define XB_TOP      3328
#define XB_TOPGEN   3392
#define XCD_BAR_WORDS 3456
#define XB_SPIN_CAP (1u << 18)
__device__ __forceinline__ unsigned xb_ld(unsigned* p)              { return __hip_atomic_load(p, __ATOMIC_RELAXED, __HIP_MEMORY_SCOPE_AGENT); }
__device__ __forceinline__ unsigned xb_add(unsigned* p, unsigned v) { return __hip_atomic_fetch_add(p, v, __ATOMIC_RELAXED, __HIP_MEMORY_SCOPE_AGENT); }
__device__ __forceinline__ unsigned xb_xcc_id() { return (unsigned)__builtin_amdgcn_s_getreg((3 << 11) | 20) & 0xFu; }
#define XB_SPIN(cond, bar) do { unsigned _sp = 0; while (cond) { __builtin_amdgcn_s_sleep(1); \
    if ((++_sp & 255u) == 0u) { if (xb_ld(&(bar)[XB_TMO])) break; if (_sp > XB_SPIN_CAP) { atomicAdd(&(bar)[XB_TMO], 1u); break; } } } } while (0)
struct XcdBarrier { unsigned* bar; unsigned x; volatile LAS unsigned* st; };
__device__ __forceinline__ XcdBarrier xcd_barrier_post(unsigned* bar, volatile LAS unsigned* st) {
    XcdBarrier b; b.bar = bar; b.x = xb_xcc_id(); b.st = st;
    if (threadIdx.x == 0) (void)xb_add(&bar[XB_XCNT(b.x)], 1u);
    return b;
}
__device__ __forceinline__ void xcd_barrier_complete(unsigned* bar, unsigned x, unsigned& nloc, unsigned& nx) {
    const unsigned G = gridDim.x * gridDim.y * gridDim.z;
    unsigned sum, cnt, mine, sp = 0u;
    for (;;) {
        sum = 0u; cnt = 0u; mine = 0u;
#pragma unroll
        for (unsigned j = 0; j < 16; ++j) { const unsigned c = xb_ld(&bar[XB_XCNT(j)]); sum += c; cnt += (c > 0u) ? 1u : 0u; mine = (j == x) ? c : mine; }
        if (sum == G) break;
        __builtin_amdgcn_s_sleep(1);
        if ((++sp & 255u) == 0u) { if (xb_ld(&bar[XB_TMO])) break; if (sp > XB_SPIN_CAP) { atomicAdd(&bar[XB_TMO], 1u); break; } }
    }
    nloc = mine > 0u ? mine : 1u; nx = cnt > 0u ? cnt : 1u;
}
__device__ __forceinline__ void xcd_barrier(const XcdBarrier& b) {
    asm volatile("s_waitcnt vmcnt(0)" ::: "memory");
    __syncthreads();
    if (threadIdx.x == 0) {
        unsigned* bar = b.bar;
        __builtin_amdgcn_s_waitcnt(0);
        unsigned nloc = b.st[0], nx = b.st[1];
        if (nloc == 0u) { xcd_barrier_complete(bar, b.x, nloc, nx); b.st[0] = nloc; b.st[1] = nx; }
        const unsigned old = xb_add(&bar[XB_XSUB(b.x)], 1u);
        const unsigned gen = old / nloc;
        if (old + 1u == (gen + 1u) * nloc) {
            __builtin_amdgcn_fence(__ATOMIC_RELEASE, "agent");
            asm volatile("s_waitcnt vmcnt(0)" ::: "memory");
            const unsigned og = xb_add(&bar[XB_TOP], 1u);
            const unsigned tg = og / nx;
            if (og + 1u == (tg + 1u) * nx) xb_add(&bar[XB_TOPGEN], 1u);
            else XB_SPIN(xb_ld(&bar[XB_TOPGEN]) == tg, bar);
            __builtin_amdgcn_fence(__ATOMIC_ACQUIRE, "agent");
            xb_add(&bar[XB_XGEN(b.x)], 1u);
            asm volatile("s_waitcnt vmcnt(0)" ::: "memory");
        } else {
            XB_SPIN(xb_ld(&bar[XB_XGEN(b.x)]) == gen, bar);
            __builtin_amdgcn_fence(__ATOMIC_ACQUIRE, "agent");
            asm volatile("s_waitcnt vmcnt(0)" ::: "memory");
        }
    }
    __syncthreads();
}

constexpr int NWAVES = 8;
struct Frame {
    LAS unsigned char* lds;
    volatile LAS unsigned* MISC;
    unsigned* ctl;
    int tid, lane, wave, vcu, G;
    unsigned char* ws; unsigned char* outb;
};
enum InId { I_X = 0, I_G1, I_WIN, I_BIN, I_SINKS, I_WAU, I_WRU, I_WOUT, I_G2, I_WGR, I_BGR, I_WER, I_BER, I_WGE, I_WUE, I_WDE, I_GF };
__device__ __forceinline__ const float* inptr(const Frame& F, int k) {
    const unsigned lo = __builtin_amdgcn_readfirstlane(F.MISC[64 + 2 * k]), hi = __builtin_amdgcn_readfirstlane(F.MISC[65 + 2 * k]);
    return (const float*)(((unsigned long long)hi << 32) | lo);
}

__device__ __forceinline__ void p0_transpose_item(const float* W, int N, int k0, int n0, bf16_t* WT, size_t dpitch, int drow0, int dcol0, LAS float* scr, int lane) {
#pragma unroll 8
    for (int i = 0; i < 32; ++i) { const int kk = 2 * i + (lane >> 5); scr[kk * 33 + (lane & 31)] = W[(size_t)(k0 + kk) * N + n0 + (lane & 31)]; }
    LDS_WAIT(); asm volatile("" ::: "memory");
    const int c = lane & 7;
#pragma unroll
    for (int j = 0; j < 4; ++j) { const int n = (lane >> 3) + 8 * j; const LAS float* s = scr + (8 * c) * 33 + n;
        u32x4 o; o.x = pk2(s[0 * 33], s[1 * 33]); o.y = pk2(s[2 * 33], s[3 * 33]); o.z = pk2(s[4 * 33], s[5 * 33]); o.w = pk2(s[6 * 33], s[7 * 33]);
        *(GAS u32x4*)(WT + (size_t)(drow0 + n) * dpitch + dcol0 + k0 + 8 * c) = o; }
    LDS_WAIT(); asm volatile("" ::: "memory");
}
__device__ __forceinline__ void p0_prologue(Frame& F) {
    LAS float* scr = (LAS float*)(F.lds + F.wave * 16384);
    const int gw = F.vcu * NWAVES + F.wave, NGW = F.G * NWAVES;
    constexpr int I_IN = 16 * 184, I_AU = 8 * 32, I_RU = 16 * 32, I_OUT = 16 * 32, I_G = 32 * 256, I_U = 32 * 256, I_D = 32 * 256;
    constexpr int NITEMS = I_IN + I_AU + I_RU + I_OUT + I_G + I_U + I_D;
    bf16_t* WinT = (bf16_t*)(F.ws + WS_WIN); bf16_t* WupT = (bf16_t*)(F.ws + WS_WUP); bf16_t* WoutT = (bf16_t*)(F.ws + WS_WOUT);
    bf16_t* WguT = (bf16_t*)(F.ws + WS_WGU); bf16_t* WdT = (bf16_t*)(F.ws + WS_WD);
    const float* w_in = inptr(F, I_WIN); const float* w_au = inptr(F, I_WAU); const float* w_ru = inptr(F, I_WRU); const float* w_out = inptr(F, I_WOUT);
    const float* w_ge = inptr(F, I_WGE); const float* w_ue = inptr(F, I_WUE); const float* w_de = inptr(F, I_WDE); const float* xin = inptr(F, I_X);
    for (int it = gw; it < NITEMS; it += NGW) {
        int r = it;
        if (r < I_IN) { const int kb = r / 184, nb = r % 184; p0_transpose_item(w_in, INW, 64 * kb, 32 * nb, WinT, 1024, 32 * nb, 0, scr, F.lane); continue; } r -= I_IN;
        if (r < I_AU) { const int kb = r / 32, nb = r % 32; p0_transpose_item(w_au, 1024, 64 * kb, 32 * nb, WupT, 1536, 32 * nb, 0, scr, F.lane); continue; } r -= I_AU;
        if (r < I_RU) { const int kb = r / 32, nb = r % 32; p0_transpose_item(w_ru, 1024, 64 * kb, 32 * nb, WupT, 1536, 32 * nb, 512, scr, F.lane); continue; } r -= I_RU;
        if (r < I_OUT) { const int kb = r / 32, nb = r % 32; p0_transpose_item(w_out, 1024, 64 * kb, 32 * nb, WoutT, 1024, 32 * nb, 0, scr, F.lane); continue; } r -= I_OUT;
        if (r < I_G) { const int e = r / 256, q = r % 256, kb = q / 16, nb = q % 16, n0 = 32 * nb;
            p0_transpose_item(w_ge + (size_t)e * 1024 * 512, 512, 64 * kb, n0, WguT + (size_t)e * 1024 * 1024, 1024, 256 * (n0 >> 7) + (n0 & 127), 0, scr, F.lane); continue; } r -= I_G;
        if (r < I_U) { const int e = r / 256, q = r % 256, kb = q / 16, nb = q % 16, n0 = 32 * nb;
            p0_transpose_item(w_ue + (size_t)e * 1024 * 512, 512, 64 * kb, n0, WguT + (size_t)e * 1024 * 1024, 1024, 256 * (n0 >> 7) + 128 + (n0 & 127), 0, scr, F.lane); continue; } r -= I_U;
        { const int e = r / 256, q = r % 256, kb = q / 32, nb = q % 32;
            p0_transpose_item(w_de + (size_t)e * 512 * 1024, 1024, 64 * kb, 32 * nb, WdT + (size_t)e * 1024 * 512, 512, 32 * nb, 0, scr, F.lane); }
    }
    bf16_t* XN = (bf16_t*)F.outb;
    f32x4 gv[4];
#pragma unroll
    for (int j = 0; j < 4; ++j) gv[j] = ((const GAS f32x4*)inptr(F, I_G1))[F.lane + 64 * j];
    for (int m = gw; m < T; m += NGW) {
        const GAS f32x4* xr = (const GAS f32x4*)(xin + (size_t)m * DM) + F.lane;
        f32x4 v[4]; float s = 0.f;
#pragma unroll
        for (int j = 0; j < 4; ++j) { v[j] = xr[64 * j]; s += (v[j].x * v[j].x + v[j].y * v[j].y) + (v[j].z * v[j].z + v[j].w * v[j].w); }
        const float rstd = 1.0f / sqrtf(wave_sum(s) * (1.f / DM) + EPS);
        GAS u32x2* o8 = (GAS u32x2*)(XN + (size_t)m * DM) + F.lane;
#pragma unroll
        for (int j = 0; j < 4; ++j) { u32x2 w; w.x = pk2(v[j].x * rstd * gv[j].x, v[j].y * rstd * gv[j].y); w.y = pk2(v[j].z * rstd * gv[j].z, v[j].w * rstd * gv[j].w); o8[64 * j] = w; }
    }
}

struct DenseOrder {
    const char* A; const char* Bt; int nM, nN, nwg, G, c, ld, nt;
    __device__ __forceinline__ void tile(int wg, int& pm, int& pn) const {
        int wgid = wg; { const int q = nwg / 8, r = nwg % 8, xcd = wgid % 8, off = wgid / 8; wgid = (xcd < r ? xcd * (q + 1) : r * (q + 1) + (xcd - r) * q) + off; }
        const int nig = 8 * nN, gid = wgid / nig, fm = gid * 8, gsz = (nM - fm) < 8 ? (nM - fm) : 8;
        pm = fm + ((wgid % nig) % gsz); pn = (wgid % nig) / gsz;
    }
    __device__ __forceinline__ bool next(int i, pg8::Unit& u) const {
        const long L = (long)i * G + c; if (L >= nwg) return false;
        int pm, pn; tile((int)L, pm, pn);
        u.pm = pm; u.pn = pn; u.nt = nt; u.aux = 0;
        u.a = A + (size_t)pm * 256 * ld * 2; u.b = Bt + (size_t)pn * 256 * ld * 2; return true;
    }
};
struct UpOrder {
    DenseOrder d;
    __device__ __forceinline__ bool next(int i, pg8::Unit& u) const {
        const long L = (long)(i >> 1) * d.G + d.c; if (L >= d.nwg) return false;
        int pm, pn; d.tile((int)L, pm, pn);
        const int part = i & 1;
        u.pm = pm; u.pn = pn; u.aux = part; u.nt = part ? 16 : 8;
        u.a = d.A + (size_t)pm * 256 * ARW * 2 + (part ? 1024 : 0); u.b = d.Bt + (size_t)pn * 256 * ARW * 2 + (part ? 1024 : 0); return true;
    }
};
struct ExpertOrder {
    const char* A; const char* Bt; const volatile LAS int* tp; int ntiles, G, c, ldA, nt; size_t bstride  , bpn  ;
    __device__ __forceinline__ bool next(int i, pg8::Unit& u) const {
        const long L = (long)i * G + c; if (L >= (long)ntiles * 4) return false;
        const int tix = (int)(L >> 2), pn = (int)(L & 3);
        int e = 0;
        for (int k = 1; k < NEXP; ++k) e += (tix >= tp[k]) ? 1 : 0;
        u.pm = tix; u.pn = pn; u.nt = nt; u.aux = e;
        u.a = A + (size_t)tix * 256 * ldA * 2; u.b = Bt + (size_t)e * bstride + (size_t)pn * bpn; return true;
    }
};

struct EpiProj {
    static constexpr bool PERM = true;
    bf16_t* PA; bf16_t* GT; const float* bias;
    __device__ __forceinline__ void operator()(const pg8::Acc& acc, const pg8::Unit& u, int wr, int wc, int fr, int fq) const {
        const int ct = u.pn; const int mode = ct < 11 ? 0 : (ct < 15 ? 1 : 2);
        bf16_t* base; int ldc, colt;
        if (ct < 15) { base = PA; ldc = PAW; colt = ct * 256; } else { base = GT; ldc = GTW; colt = ct * 256 - PAW; }
        const int row0 = u.pm * 256 + wr * 64 + fr, col0 = colt + wc * 32 + 8 * fq, bcol0 = ct * 256 + wc * 32 + 8 * fq;
        f32x4 bv[2][2];
#pragma unroll
        for (int bj = 0; bj < 2; ++bj)
#pragma unroll
            for (int n = 0; n < 2; ++n) bv[bj][n] = *(const f32x4*)(bias + bcol0 + bj * 128 + 4 * n);
#pragma unroll
        for (int ai = 0; ai < 2; ++ai)
#pragma unroll
            for (int m = 0; m < 4; ++m) { bf16_t* rowp = base + (size_t)(row0 + ai * 128 + m * 16) * ldc + col0;
#pragma unroll
                for (int bj = 0; bj < 2; ++bj) { f32x4 v0 = acc[ai][bj][m][0] + bv[bj][0], v1 = acc[ai][bj][m][1] + bv[bj][1];
                    if (mode != 0) {
#pragma unroll
                        for (int j = 0; j < 4; ++j) { const float s0 = sigmoidf_(v0[j]), s1 = sigmoidf_(v1[j]); v0[j] = (mode == 1) ? v0[j] * s0 : s0; v1[j] = (mode == 1) ? v1[j] * s1 : s1; } }
                    u32x4 w; w.x = cvt_pk_bf16(v0[0], v0[1]); w.y = cvt_pk_bf16(v0[2], v0[3]); w.z = cvt_pk_bf16(v1[0], v1[1]); w.w = cvt_pk_bf16(v1[2], v1[3]);
                    *(u32x4*)(rowp + bj * 128) = w; } }
    }
};
struct EpiUp {
    static constexpr bool PERM = true;
    bf16_t* MIX; const bf16_t* GT;
    __device__ __forceinline__ void operator()(const pg8::Acc& acc, const pg8::Unit& u, int wr, int wc, int fr, int fq) const {
        const int part = u.aux;
        const int row0 = u.pm * 256 + wr * 64 + fr, col0 = u.pn * 256 + wc * 32 + 8 * fq;
#pragma unroll
        for (int ai = 0; ai < 2; ++ai)
#pragma unroll
            for (int m = 0; m < 4; ++m) { const size_t row = (size_t)(row0 + ai * 128 + m * 16);
#pragma unroll
                for (int bj = 0; bj < 2; ++bj) {
                    const u32x4 g = *(const u32x4*)(GT + row * GTW + part * 1024 + col0 + bj * 128);
                    bf16_t* mp = MIX + row * DM + col0 + bj * 128;
                    const f32x4 a0 = acc[ai][bj][m][0], a1 = acc[ai][bj][m][1];
                    float r[8];
                    r[0] = bflo(g.x) * a0[0]; r[1] = bfhi(g.x) * a0[1]; r[2] = bflo(g.y) * a0[2]; r[3] = bfhi(g.y) * a0[3];
                    r[4] = bflo(g.z) * a1[0]; r[5] = bfhi(g.z) * a1[1]; r[6] = bflo(g.w) * a1[2]; r[7] = bfhi(g.w) * a1[3];
                    if (part) { const u32x4 p = *(const u32x4*)mp;
                        r[0] += bflo(p.x); r[1] += bfhi(p.x); r[2] += bflo(p.y); r[3] += bfhi(p.y); r[4] += bflo(p.z); r[5] += bfhi(p.z); r[6] += bflo(p.w); r[7] += bfhi(p.w); }
                    u32x4 w; w.x = cvt_pk_bf16(r[0], r[1]); w.y = cvt_pk_bf16(r[2], r[3]); w.z = cvt_pk_bf16(r[4], r[5]); w.w = cvt_pk_bf16(r[6], r[7]);
                    *(u32x4*)mp = w; } }
    }
};
struct EpiOut {
    static constexpr bool PERM = false;
    const float* x; float* X2;
    __device__ __forceinline__ void operator()(const pg8::Acc& acc, const pg8::Unit& u, int wr, int wc, int fr, int fq) const {
        const int row0 = u.pm * 256 + wr * 64 + fr, col0 = u.pn * 256 + wc * 32 + 4 * fq;
#pragma unroll
        for (int ai = 0; ai < 2; ++ai)
#pragma unroll
            for (int m = 0; m < 4; ++m) { const size_t off = (size_t)(row0 + ai * 128 + m * 16) * DM + col0;
#pragma unroll
                for (int bj = 0; bj < 2; ++bj)
#pragma unroll
                    for (int n = 0; n < 2; ++n) { const f32x4 xv = *(const f32x4*)(x + off + bj * 128 + n * 16); *(f32x4*)(X2 + off + bj * 128 + n * 16) = xv + acc[ai][bj][m][n]; } }
    }
};
struct EpiSwiglu {
    static constexpr bool PERM = true;
    bf16_t* ACT;
    __device__ __forceinline__ void operator()(const pg8::Acc& acc, const pg8::Unit& u, int wr, int wc, int fr, int fq) const {
        const int row0 = u.pm * 256 + wr * 64 + fr, col0 = u.pn * 128 + wc * 32 + 8 * fq;
#pragma unroll
        for (int ai = 0; ai < 2; ++ai)
#pragma unroll
            for (int m = 0; m < 4; ++m) { bf16_t* rowp = ACT + (size_t)(row0 + ai * 128 + m * 16) * DEXP + col0;
                float r[8];
#pragma unroll
                for (int n = 0; n < 2; ++n)
#pragma unroll
                    for (int j = 0; j < 4; ++j) { const float g = acc[ai][0][m][n][j], up = acc[ai][1][m][n][j]; r[4 * n + j] = g * sigmoidf_(g) * up; }
                u32x4 w; w.x = cvt_pk_bf16(r[0], r[1]); w.y = cvt_pk_bf16(r[2], r[3]); w.z = cvt_pk_bf16(r[4], r[5]); w.w = cvt_pk_bf16(r[6], r[7]);
                *(u32x4*)rowp = w; }
    }
};
struct EpiDown {
    static constexpr bool PERM = true;
    bf16_t* YB;
    __device__ __forceinline__ void operator()(const pg8::Acc& acc, const pg8::Unit& u, int wr, int wc, int fr, int fq) const {
        const int row0 = u.pm * 256 + wr * 64 + fr, col0 = u.pn * 256 + wc * 32 + 8 * fq;
#pragma unroll
        for (int ai = 0; ai < 2; ++ai)
#pragma unroll
            for (int m = 0; m < 4; ++m) { bf16_t* rowp = YB + (size_t)(row0 + ai * 128 + m * 16) * DM + col0;
#pragma unroll
                for (int bj = 0; bj < 2; ++bj) { const f32x4 v0 = acc[ai][bj][m][0], v1 = acc[ai][bj][m][1];
                    u32x4 w; w.x = cvt_pk_bf16(v0[0], v0[1]); w.y = cvt_pk_bf16(v0[2], v0[3]); w.z = cvt_pk_bf16(v1[0], v1[1]); w.w = cvt_pk_bf16(v1[2], v1[3]);
                    *(u32x4*)(rowp + bj * 128) = w; } }
    }
};

__device__ __forceinline__ void ld8bf(const bf16_t* p, float* o) { const u32x4 w = *(const u32x4*)p; o[0] = bflo(w.x); o[1] = bfhi(w.x); o[2] = bflo(w.y); o[3] = bfhi(w.y); o[4] = bflo(w.z); o[5] = bfhi(w.z); o[6] = bflo(w.w); o[7] = bfhi(w.w); }
__device__ __forceinline__ void p2_attention_naive(Frame& F, int u0, int ustride) {
    LAS float* Ks = (LAS float*)F.lds;
    LAS float* Vs = Ks + 256 * 68;
    const bf16_t* PA = (const bf16_t*)(F.ws + WS_PA); bf16_t* AR = (bf16_t*)F.outb;
    const int tid = F.tid, part = tid & 7;
    for (int unit = u0; unit < NB * 16 * 8; unit += ustride) {
        const int h = unit & 7, n = (unit >> 3) & 15, b = unit >> 7, kvh = h >> 2;
        const size_t tok0 = (size_t)b * SEQ + n * 128;
        __syncthreads();
        for (int idx = tid; idx < 256 * 8; idx += 512) {
            const int j = idx >> 3, c = idx & 7;
            float kf[8], vf[8];
            if (n == 0 && j < 128) {
#pragma unroll
                for (int i = 0; i < 8; ++i) { kf[i] = 0.f; vf[i] = 0.f; }
            } else {
                const bf16_t* rp = PA + (tok0 - 128 + j) * PAW;
                ld8bf(rp + C_AK + kvh * 64 + c * 8, kf); ld8bf(rp + C_AV + kvh * 64 + c * 8, vf);
            }
            *(LAS f32x4*)(Ks + j * 68 + c * 8) = (f32x4){kf[0], kf[1], kf[2], kf[3]}; *(LAS f32x4*)(Ks + j * 68 + c * 8 + 4) = (f32x4){kf[4], kf[5], kf[6], kf[7]};
            *(LAS f32x4*)(Vs + j * 68 + c * 8) = (f32x4){vf[0], vf[1], vf[2], vf[3]}; *(LAS f32x4*)(Vs + j * 68 + c * 8 + 4) = (f32x4){vf[4], vf[5], vf[6], vf[7]};
        }
        __syncthreads();
        const float slope = exp2f(-(float)(h + 1)), sink = inptr(F, I_SINKS)[h];
        for (int qh = 0; qh < 2; ++qh) {
            const int q = qh * 64 + (tid >> 3);
            const size_t tq = tok0 + q;
            float qr[64];
#pragma unroll
            for (int c = 0; c < 8; ++c) ld8bf(PA + tq * PAW + C_AQ + h * 64 + c * 8, qr + 8 * c);
            float o[64];
#pragma unroll
            for (int d = 0; d < 64; ++d) o[d] = 0.f;
            float mx = sink, den = (part == 0) ? 1.0f : 0.0f;
#pragma unroll 1
            for (int jj = 0; jj < 32; ++jj) {
                const int j = part + 8 * jj, dist = q + 128 - j;
                const bool valid = dist >= 0 && dist < 128 && (n > 0 || j >= 128);
                if (valid) {
                    float d = 0.f;
                    const LAS f32x4* kp = (const LAS f32x4*)(Ks + j * 68);
#pragma unroll
                    for (int c = 0; c < 16; ++c) { const f32x4 kv = kp[c]; d += qr[4 * c] * kv.x + qr[4 * c + 1] * kv.y + qr[4 * c + 2] * kv.z + qr[4 * c + 3] * kv.w; }
                    const float sc = d * 0.125f - slope * (float)dist;
                    const float mn = fmaxf(mx, sc), f = __expf(mx - mn), p = __expf(sc - mn);
                    mx = mn; den = den * f + p;
                    const LAS f32x4* vp = (const LAS f32x4*)(Vs + j * 68);
#pragma unroll
                    for (int c = 0; c < 16; ++c) { const f32x4 vv = vp[c]; o[4 * c] = o[4 * c] * f + p * vv.x; o[4 * c + 1] = o[4 * c + 1] * f + p * vv.y; o[4 * c + 2] = o[4 * c + 2] * f + p * vv.z; o[4 * c + 3] = o[4 * c + 3] * f + p * vv.w; }
                }
            }
            float ma = fmaxf(mx, __shfl_xor(mx, 1)); ma = fmaxf(ma, __shfl_xor(ma, 2)); ma = fmaxf(ma, __shfl_xor(ma, 4));
            const float fs = __expf(mx - ma);
            den *= fs; den += __shfl_xor(den, 1); den += __shfl_xor(den, 2); den += __shfl_xor(den, 4);
            const float inv = 1.0f / den;
#pragma unroll
            for (int d = 0; d < 64; ++d) { o[d] *= fs; o[d] += __shfl_xor(o[d], 1); o[d] += __shfl_xor(o[d], 2); o[d] += __shfl_xor(o[d], 4); }
            if (part == 0) {
                bf16_t* op = AR + tq * ARW + h * 64;
#pragma unroll
                for (int c = 0; c < 8; ++c) { u32x4 w0; w0.x = pk2(o[8 * c] * inv, o[8 * c + 1] * inv); w0.y = pk2(o[8 * c + 2] * inv, o[8 * c + 3] * inv); w0.z = pk2(o[8 * c + 4] * inv, o[8 * c + 5] * inv); w0.w = pk2(o[8 * c + 6] * inv, o[8 * c + 7] * inv);
                    *(u32x4*)(op + 8 * c) = w0; }
            }
        }
    }
}
__device__ __forceinline__ void p2_retention_naive(Frame& F, int u0, int ustride) {
    LAS float* Qs = (LAS float*)F.lds;
    LAS float* Ks = Qs + 128 * 68;
    LAS bf16_t* Vs = (LAS bf16_t*)(Ks + 128 * 68);
    LAS float* Ss = (LAS float*)(Vs + 128 * 136);
    const bf16_t* PA = (const bf16_t*)(F.ws + WS_PA); bf16_t* AR = (bf16_t*)F.outb;
    const int tid = F.tid;
    for (int unit = u0; unit < NB * 8; unit += ustride) {
        const int h = unit & 7, b = unit >> 3;
        const float lg = log2f(1.0f - exp2f(-5.0f - (float)h));
        __syncthreads();
        for (int idx = tid; idx < 64 * 128; idx += 512) Ss[idx] = 0.f;
        for (int n = 0; n < 16; ++n) {
            const size_t tok0 = (size_t)b * SEQ + n * 128;
            __syncthreads();
            for (int idx = tid; idx < 128 * 8; idx += 512) {
                const int j = idx >> 3, c = idx & 7; const bf16_t* rp = PA + (tok0 + j) * PAW;
                float qf[8], kf[8]; ld8bf(rp + C_RQ + h * 64 + c * 8, qf); ld8bf(rp + C_RK + h * 64 + c * 8, kf);
                *(LAS f32x4*)(Qs + j * 68 + c * 8) = (f32x4){qf[0], qf[1], qf[2], qf[3]}; *(LAS f32x4*)(Qs + j * 68 + c * 8 + 4) = (f32x4){qf[4], qf[5], qf[6], qf[7]};
                *(LAS f32x4*)(Ks + j * 68 + c * 8) = (f32x4){kf[0], kf[1], kf[2], kf[3]}; *(LAS f32x4*)(Ks + j * 68 + c * 8 + 4) = (f32x4){kf[4], kf[5], kf[6], kf[7]};
            }
            for (int idx = tid; idx < 128 * 16; idx += 512) {
                const int j = idx >> 4, c = idx & 15;
                *(LAS u32x4*)(Vs + j * 136 + c * 8) = *(const u32x4*)(PA + (tok0 + j) * PAW + C_RV + h * 128 + c * 8);
            }
            __syncthreads();
            {
                const int i = tid >> 2, part = tid & 3;
                float qreg[16];
#pragma unroll
                for (int c = 0; c < 4; ++c) { const f32x4 v = *(const LAS f32x4*)(Qs + i * 68 + 16 * part + 4 * c); qreg[4 * c] = v.x; qreg[4 * c + 1] = v.y; qreg[4 * c + 2] = v.z; qreg[4 * c + 3] = v.w; }
                float y[32];
#pragma unroll
                for (int e = 0; e < 32; ++e) y[e] = 0.f;
                const int jmax = i | 15;
                for (int j = 0; j <= jmax; ++j) {
                    float sdot = 0.f;
#pragma unroll
                    for (int c = 0; c < 4; ++c) { const f32x4 kv = *(const LAS f32x4*)(Ks + j * 68 + 16 * part + 4 * c); sdot += qreg[4 * c] * kv.x + qreg[4 * c + 1] * kv.y + qreg[4 * c + 2] * kv.z + qreg[4 * c + 3] * kv.w; }
                    sdot += __shfl_xor(sdot, 1); sdot += __shfl_xor(sdot, 2);
                    const float w = (j <= i) ? sdot * 0.125f * exp2f((float)(i - j) * lg) : 0.f;
#pragma unroll
                    for (int c = 0; c < 4; ++c) { const u32x4 vv = *(const LAS u32x4*)(Vs + j * 136 + 32 * part + 8 * c);
                        y[8 * c] += w * bflo(vv.x); y[8 * c + 1] += w * bfhi(vv.x); y[8 * c + 2] += w * bflo(vv.y); y[8 * c + 3] += w * bfhi(vv.y);
                        y[8 * c + 4] += w * bflo(vv.z); y[8 * c + 5] += w * bfhi(vv.z); y[8 * c + 6] += w * bflo(vv.w); y[8 * c + 7] += w * bfhi(vv.w); }
                }
                const float gi = exp2f((float)(i + 1) * lg);
                for (int d = 0; d < 64; ++d) {
                    const float qd = Qs[i * 68 + d] * gi;
#pragma unroll
                    for (int c = 0; c < 8; ++c) { const f32x4 sv = *(const LAS f32x4*)(Ss + d * 128 + 32 * part + 4 * c); y[4 * c] += qd * sv.x; y[4 * c + 1] += qd * sv.y; y[4 * c + 2] += qd * sv.z; y[4 * c + 3] += qd * sv.w; }
                }
                float sum = 0.f;
#pragma unroll
                for (int e = 0; e < 32; ++e) sum += y[e];
                sum += __shfl_xor(sum, 1); sum += __shfl_xor(sum, 2);
                const float mu = sum * (1.f / 128.f); float var = 0.f;
#pragma unroll
                for (int e = 0; e < 32; ++e) { y[e] -= mu; var += y[e] * y[e]; }
                var += __shfl_xor(var, 1); var += __shfl_xor(var, 2);
                const float rstd = 1.0f / sqrtf(var * (1.f / 128.f) + EPS);
                const size_t t = tok0 + i;
                const bf16_t* gp = PA + t * PAW + C_RG + h * 128 + 32 * part;
                bf16_t* op = AR + t * ARW + 512 + h * 128 + 32 * part;
#pragma unroll
                for (int c = 0; c < 4; ++c) { float g[8]; ld8bf(gp + 8 * c, g);
                    u32x4 w; w.x = pk2(y[8 * c] * rstd * g[0], y[8 * c + 1] * rstd * g[1]); w.y = pk2(y[8 * c + 2] * rstd * g[2], y[8 * c + 3] * rstd * g[3]);
                    w.z = pk2(y[8 * c + 4] * rstd * g[4], y[8 * c + 5] * rstd * g[5]); w.w = pk2(y[8 * c + 6] * rstd * g[6], y[8 * c + 7] * rstd * g[7]);
                    *(u32x4*)(op + 8 * c) = w; }
            }
            __syncthreads();
            {
                const int d = tid >> 3, eg = tid & 7;
                const float cd = exp2f(128.f * lg);
                float a[16];
#pragma unroll
                for (int c = 0; c < 4; ++c) { const f32x4 sv = *(const LAS f32x4*)(Ss + d * 128 + 16 * eg + 4 * c); a[4 * c] = sv.x * cd; a[4 * c + 1] = sv.y * cd; a[4 * c + 2] = sv.z * cd; a[4 * c + 3] = sv.w * cd; }
                for (int j = 0; j < 128; ++j) {
                    const float kd = Ks[j * 68 + d] * 0.125f * exp2f((float)(127 - j) * lg);
#pragma unroll
                    for (int c = 0; c < 2; ++c) { const u32x4 vv = *(const LAS u32x4*)(Vs + j * 136 + 16 * eg + 8 * c);
                        a[8 * c] += kd * bflo(vv.x); a[8 * c + 1] += kd * bfhi(vv.x); a[8 * c + 2] += kd * bflo(vv.y); a[8 * c + 3] += kd * bfhi(vv.y);
                        a[8 * c + 4] += kd * bflo(vv.z); a[8 * c + 5] += kd * bfhi(vv.z); a[8 * c + 6] += kd * bflo(vv.w); a[8 * c + 7] += kd * bfhi(vv.w); }
                }
#pragma unroll
                for (int c = 0; c < 4; ++c) *(LAS f32x4*)(Ss + d * 128 + 16 * eg + 4 * c) = (f32x4){a[4 * c], a[4 * c + 1], a[4 * c + 2], a[4 * c + 3]};
            }
        }
    }
}

typedef float f32x16 __attribute__((ext_vector_type(16)));
typedef short s16x4 __attribute__((ext_vector_type(4)));
__device__ __forceinline__ int crow(int r, int hi) { return (r & 3) + 8 * (r >> 2) + 4 * hi; }
__device__ __forceinline__ s16x4 ds_tr16(const LAS unsigned char* p) { return __builtin_bit_cast(s16x4, __builtin_amdgcn_ds_read_tr16_b64_v4i16((LAS s16x4*)p)); }
__device__ __forceinline__ bf16x8 pack8(const f32x16& p, int b) {
    u32x4 w; w.x = cvt_pk_bf16(p[b], p[b + 1]); w.y = cvt_pk_bf16(p[b + 2], p[b + 3]); w.z = cvt_pk_bf16(p[b + 4], p[b + 5]); w.w = cvt_pk_bf16(p[b + 6], p[b + 7]);
    return __builtin_bit_cast(bf16x8, w);
}
constexpr int AT_K = 0, AT_V = 36864, AT_WS = AT_V + 32768, AT_OST = AT_WS + 8 * 128, AT_END = AT_OST + 8 * 4096;
static_assert(AT_END <= SCRATCH_BYTES, "attention LDS");
__device__ __forceinline__ void p2_attention_mfma(Frame& F, int u0, int ustride) {
    const bf16_t* PA = (const bf16_t*)(F.ws + WS_PA); bf16_t* AR = (bf16_t*)F.outb;
    LAS unsigned char* lds = F.lds;
    const int tid = F.tid, lane = F.lane, wid = F.wave, r32 = lane & 31, hi = lane >> 5;
    const int g = wid >> 1, qhalf = wid & 1;
    constexpr float LOG2E = 1.4426950408889634f;
    for (int unit = u0; unit < NB * 16 * 2; unit += ustride) {
        const int kvh = unit & 1, n = (unit >> 1) & 15, b = unit >> 5;
        const size_t tok0 = (size_t)b * SEQ + n * 128;
        __syncthreads();
#pragma unroll
        for (int it = 0; it < 4; ++it) {
            const int idx = tid + 512 * it, j = idx >> 3, c = idx & 7;
            u32x4 kv = (u32x4){0u, 0u, 0u, 0u}, vv = (u32x4){0u, 0u, 0u, 0u};
            if (n > 0 || j >= 128) { const bf16_t* rp = PA + (tok0 - 128 + j) * PAW; kv = *(const u32x4*)(rp + C_AK + kvh * 64 + c * 8); vv = *(const u32x4*)(rp + C_AV + kvh * 64 + c * 8); }
            *(LAS u32x4*)(lds + AT_K + j * 144 + c * 16) = kv;
            *(LAS u32x4*)(lds + AT_V + (c >> 2) * 16384 + (j >> 4) * 1024 + (j & 15) * 64 + (c & 3) * 16) = vv;
        }
        __syncthreads();
        const int hd = kvh * 4 + g;
        const float SL = exp2f(-(float)(hd + 1)) * LOG2E, SC = 0.125f * LOG2E, sink2 = inptr(F, I_SINKS)[hd] * LOG2E;
#pragma unroll 1
        for (int qb = 0; qb < 2; ++qb) {
            const int m = qhalf * 2 + qb, i0 = 32 * m;
            bf16x8 qr[4];
            { const bf16_t* qp = PA + (tok0 + i0 + r32) * PAW + C_AQ + hd * 64 + hi * 8;
#pragma unroll
              for (int s = 0; s < 4; ++s) qr[s] = *(const bf16x8*)(qp + 16 * s); }
            f32x16 p[5];
#pragma unroll
            for (int c = 0; c < 5; ++c) {
                const LAS unsigned char* kp = lds + AT_K + (32 * (m + c) + r32) * 144 + hi * 16;
                f32x16 a;
#pragma unroll
                for (int r = 0; r < 16; ++r) a[r] = 0.f;
#pragma unroll
                for (int s = 0; s < 4; ++s) a = __builtin_amdgcn_mfma_f32_32x32x16_bf16(*(const LAS bf16x8*)(kp + s * 32), qr[s], a, 0, 0, 0);
                p[c] = a;
            }
            const int iq = i0 + r32;
            float mx = sink2;
#pragma unroll
            for (int c = 0; c < 5; ++c)
#pragma unroll
                for (int r = 0; r < 16; ++r) {
                    const int j = 32 * (m + c) + crow(r, hi), dist = iq + 128 - j;
                    const bool valid = dist >= 0 && dist < 128 && (n > 0 || j >= 128);
                    const float t = valid ? p[c][r] * SC - SL * (float)dist : -1e30f;
                    p[c][r] = t; mx = fmaxf(mx, t);
                }
            mx = fmaxf(mx, __shfl_xor(mx, 32));
            float sum = 0.f;
#pragma unroll
            for (int c = 0; c < 5; ++c)
#pragma unroll
                for (int r = 0; r < 16; ++r) { const float e = __builtin_amdgcn_exp2f(p[c][r] - mx); p[c][r] = e; sum += e; }
            sum += __shfl_xor(sum, 32);
            const float den = sum + __builtin_amdgcn_exp2f(sink2 - mx);
            bf16x8 pa[5][2];
#pragma unroll
            for (int c = 0; c < 5; ++c) { pa[c][0] = pack8(p[c], 0); pa[c][1] = pack8(p[c], 8); }
            f32x16 o[2];
#pragma unroll
            for (int d0 = 0; d0 < 2; ++d0) {
                f32x16 a;
#pragma unroll
                for (int r = 0; r < 16; ++r) a[r] = 0.f;
#pragma unroll
                for (int c = 0; c < 5; ++c)
#pragma unroll
                    for (int s = 0; s < 2; ++s) {
                        const LAS unsigned char* vb = lds + AT_V + d0 * 16384 + (2 * (m + c) + s) * 1024 + ((lane >> 4) & 1) * 32 + (lane & 3) * 8 + (4 * hi + ((lane & 15) >> 2)) * 64;
                        const s16x4 lo = ds_tr16(vb), h4 = ds_tr16(vb + 512);
                        const bf16x8 vf = (bf16x8){lo[0], lo[1], lo[2], lo[3], h4[0], h4[1], h4[2], h4[3]};
                        a = __builtin_amdgcn_mfma_f32_32x32x16_bf16(pa[c][s], vf, a, 0, 0, 0);
                    }
                o[d0] = a;
            }
            LAS float* wsf = (LAS float*)(lds + AT_WS + wid * 128);
            asm volatile("s_waitcnt lgkmcnt(0)" ::: "memory");
            if (hi == 0) wsf[r32] = den;
            asm volatile("s_waitcnt lgkmcnt(0)" ::: "memory");
            float rinv[16];
#pragma unroll
            for (int r = 0; r < 16; ++r) rinv[r] = 1.0f / wsf[crow(r, hi)];
            LAS bf16_t* stg = (LAS bf16_t*)(lds + AT_OST + wid * 4096);
#pragma unroll
            for (int r = 0; r < 16; ++r)
#pragma unroll
                for (int d0 = 0; d0 < 2; ++d0) stg[crow(r, hi) * 64 + d0 * 32 + r32] = (bf16_t)f2bf(o[d0][r] * rinv[r]);
            asm volatile("s_waitcnt lgkmcnt(0)" ::: "memory");
#pragma unroll
            for (int it = 0; it < 4; ++it) { const int row = it * 8 + (lane >> 3), ch = lane & 7;
                const u32x4 v = *(const LAS u32x4*)(stg + row * 64 + ch * 8);
                *(u32x4*)(AR + (tok0 + i0 + row) * ARW + hd * 64 + ch * 8) = v; }
            asm volatile("s_waitcnt lgkmcnt(0)" ::: "memory");
        }
    }
}

constexpr int RT_KR = 0, RT_KT = 18432, RT_V = RT_KT + 16384, RT_ST = RT_V + 32768, RT_RED = RT_ST + 18432, RT_OST = RT_RED + 2048, RT_END = RT_OST + 8 * 4608;
static_assert(RT_END <= SCRATCH_BYTES, "retention LDS");
__device__ __forceinline__ u32x4 scale8bf(u32x4 w, float s) {
    u32x4 o; o.x = pk2(bflo(w.x) * s, bfhi(w.x) * s); o.y = pk2(bflo(w.y) * s, bfhi(w.y) * s); o.z = pk2(bflo(w.z) * s, bfhi(w.z) * s); o.w = pk2(bflo(w.w) * s, bfhi(w.w) * s); return o;
}
__device__ __forceinline__ bf16x8 tr_frag(const LAS unsigned char* p) {
    const s16x4 lo = ds_tr16(p), h4 = ds_tr16(p + 512);
    return (bf16x8){lo[0], lo[1], lo[2], lo[3], h4[0], h4[1], h4[2], h4[3]};
}
__device__ __forceinline__ void p2_retention_mfma(Frame& F, int u0, int ustride) {
    const bf16_t* PA = (const bf16_t*)(F.ws + WS_PA); bf16_t* AR = (bf16_t*)F.outb;
    LAS unsigned char* lds = F.lds;
    const int tid = F.tid, lane = F.lane, wid = F.wave, r32 = lane & 31, hi = lane >> 5;
    const int ib = wid >> 1, eh = wid & 1;
    const int sdb = wid & 1, seb = wid >> 1;
    const int troff = ((lane >> 4) & 1) * 32 + (lane & 3) * 8 + (4 * hi + ((lane & 15) >> 2)) * 64;
    for (int unit = u0; unit < NB * 8; unit += ustride) {
        const int h = unit & 7, b = unit >> 3;
        const float lg = log2f(1.0f - exp2f(-5.0f - (float)h));
        const float fac_i = exp2f((float)(32 * ib + r32 - 127) * lg), gi1 = exp2f((float)(32 * ib + r32 + 1) * lg), cd = exp2f(128.0f * lg);
        f32x16 st;
#pragma unroll
        for (int r = 0; r < 16; ++r) st[r] = 0.f;
        __syncthreads();
        for (int idx = tid; idx < 18432 / 4; idx += 512) ((LAS unsigned*)(lds + RT_ST))[idx] = 0u;
        u32x4 kreg[2], vreg[4]; bf16x8 qn[4];
        {
            const size_t tok0 = (size_t)b * SEQ;
#pragma unroll
            for (int it = 0; it < 2; ++it) { const int idx = tid + 512 * it, j = idx >> 3, c = idx & 7; kreg[it] = *(const u32x4*)(PA + (tok0 + j) * PAW + C_RK + h * 64 + c * 8); }
#pragma unroll
            for (int it = 0; it < 4; ++it) { const int idx = tid + 512 * it, j = idx >> 4, c = idx & 15; vreg[it] = *(const u32x4*)(PA + (tok0 + j) * PAW + C_RV + h * 128 + c * 8); }
            const bf16_t* qp = PA + (tok0 + 32 * ib + r32) * PAW + C_RQ + h * 64 + hi * 8;
#pragma unroll
            for (int s = 0; s < 4; ++s) qn[s] = *(const bf16x8*)(qp + 16 * s);
        }
#pragma unroll 1
        for (int n = 0; n < 16; ++n) {
            const size_t tok0 = (size_t)b * SEQ + n * 128;
#pragma unroll
            for (int it = 0; it < 2; ++it) { const int idx = tid + 512 * it, j = idx >> 3, c = idx & 7;
                const u32x4 kk = scale8bf(kreg[it], 0.125f * exp2f((float)(127 - j) * lg));
                *(LAS u32x4*)(lds + RT_KR + j * 144 + c * 16) = kk;
                *(LAS u32x4*)(lds + RT_KT + (c >> 2) * 8192 + (j >> 4) * 1024 + (j & 15) * 64 + (c & 3) * 16) = kk; }
#pragma unroll
            for (int it = 0; it < 4; ++it) { const int idx = tid + 512 * it, j = idx >> 4, c = idx & 15;
                *(LAS u32x4*)(lds + RT_V + (c >> 2) * 8192 + (j >> 4) * 1024 + (j & 15) * 64 + (c & 3) * 16) = vreg[it]; }
            __syncthreads();
            bf16x8 pb[4][2];
#pragma unroll
            for (int jb = 0; jb < 4; ++jb) {
                if (jb <= ib) {
                    const LAS unsigned char* kp = lds + RT_KR + (32 * jb + r32) * 144 + hi * 16;
                    f32x16 a;
#pragma unroll
                    for (int r = 0; r < 16; ++r) a[r] = 0.f;
#pragma unroll
                    for (int s = 0; s < 4; ++s) a = __builtin_amdgcn_mfma_f32_32x32x16_bf16(*(const LAS bf16x8*)(kp + s * 32), qn[s], a, 0, 0, 0);
                    const bool diag = (jb == ib);
#pragma unroll
                    for (int r = 0; r < 16; ++r) a[r] = (!diag || crow(r, hi) <= r32) ? a[r] * fac_i : 0.f;
                    pb[jb][0] = pack8(a, 0); pb[jb][1] = pack8(a, 8);
                    asm volatile("" ::: "memory");
                } else { pb[jb][0] = (bf16x8){0, 0, 0, 0, 0, 0, 0, 0}; pb[jb][1] = (bf16x8){0, 0, 0, 0, 0, 0, 0, 0}; }
            }
            f32x16 y[2];
#pragma unroll
            for (int t = 0; t < 2; ++t) {
                const int eb = 2 * eh + t;
                const LAS unsigned char* sp = lds + RT_ST + (32 * eb + r32) * 144 + hi * 16;
                f32x16 a;
#pragma unroll
                for (int r = 0; r < 16; ++r) a[r] = 0.f;
#pragma unroll
                for (int s = 0; s < 4; ++s) a = __builtin_amdgcn_mfma_f32_32x32x16_bf16(*(const LAS bf16x8*)(sp + s * 32), qn[s], a, 0, 0, 0);
#pragma unroll
                for (int r = 0; r < 16; ++r) a[r] *= gi1;
#pragma unroll
                for (int jb = 0; jb < 4; ++jb) {
                    if (jb <= ib) {
#pragma unroll
                        for (int s2 = 0; s2 < 2; ++s2) {
                            const bf16x8 vf = tr_frag(lds + RT_V + eb * 8192 + (2 * jb + s2) * 1024 + troff);
                            a = __builtin_amdgcn_mfma_f32_32x32x16_bf16(vf, pb[jb][s2], a, 0, 0, 0);
                        }
                        asm volatile("" ::: "memory");
                    }
                }
                y[t] = a;
            }
            if (n < 15) {
                const size_t tokn = tok0 + 128;
#pragma unroll
                for (int it = 0; it < 2; ++it) { const int idx = tid + 512 * it, j = idx >> 3, c = idx & 7; kreg[it] = *(const u32x4*)(PA + (tokn + j) * PAW + C_RK + h * 64 + c * 8); }
#pragma unroll
                for (int it = 0; it < 4; ++it) { const int idx = tid + 512 * it, j = idx >> 4, c = idx & 15; vreg[it] = *(const u32x4*)(PA + (tokn + j) * PAW + C_RV + h * 128 + c * 8); }
                const bf16_t* qp = PA + (tokn + 32 * ib + r32) * PAW + C_RQ + h * 64 + hi * 8;
#pragma unroll
                for (int s = 0; s < 4; ++s) qn[s] = *(const bf16x8*)(qp + 16 * s);
            }
            float s1 = 0.f, s2 = 0.f;
#pragma unroll
            for (int t = 0; t < 2; ++t)
#pragma unroll
                for (int r = 0; r < 16; ++r) { s1 += y[t][r]; s2 += y[t][r] * y[t][r]; }
            s1 += __shfl_xor(s1, 32); s2 += __shfl_xor(s2, 32);
            if (hi == 0) *(LAS f32x2*)(lds + RT_RED + (wid * 32 + r32) * 8) = (f32x2){s1, s2};
#pragma unroll
            for (int r = 0; r < 16; ++r) st[r] *= cd;
#pragma unroll
            for (int sp = 0; sp < 8; ++sp) {
                const bf16x8 kf = tr_frag(lds + RT_KT + sdb * 8192 + sp * 1024 + troff);
                const bf16x8 vf = tr_frag(lds + RT_V + seb * 8192 + sp * 1024 + troff);
                st = __builtin_amdgcn_mfma_f32_32x32x16_bf16(kf, vf, st, 0, 0, 0);
                if (sp & 1) asm volatile("" ::: "memory");
            }
            __syncthreads();
            {
                const f32x2 o = *(const LAS f32x2*)(lds + RT_RED + ((wid ^ 1) * 32 + r32) * 8);
                const float mu = (s1 + o.x) * (1.f / 128.f), var = (s2 + o.y) * (1.f / 128.f) - mu * mu, rstd = 1.0f / sqrtf(fmaxf(var, 0.f) + EPS);
                LAS unsigned char* stg = lds + RT_OST + wid * 4608;
#pragma unroll
                for (int t = 0; t < 2; ++t)
#pragma unroll
                    for (int gq = 0; gq < 4; ++gq) {
                        u32x2 w; w.x = cvt_pk_bf16((y[t][4 * gq] - mu) * rstd, (y[t][4 * gq + 1] - mu) * rstd); w.y = cvt_pk_bf16((y[t][4 * gq + 2] - mu) * rstd, (y[t][4 * gq + 3] - mu) * rstd);
                        *(LAS u32x2*)(stg + r32 * 144 + (32 * t + 8 * gq + 4 * hi) * 2) = w; }
#pragma unroll
                for (int gq = 0; gq < 4; ++gq) {
                    u32x2 w; w.x = cvt_pk_bf16(st[4 * gq], st[4 * gq + 1]); w.y = cvt_pk_bf16(st[4 * gq + 2], st[4 * gq + 3]);
                    *(LAS u32x2*)(lds + RT_ST + (32 * seb + r32) * 144 + (32 * sdb + 8 * gq + 4 * hi) * 2) = w; }
                asm volatile("s_waitcnt lgkmcnt(0)" ::: "memory");
#pragma unroll
                for (int it = 0; it < 4; ++it) { const int row = it * 8 + (lane >> 3), ch = lane & 7;
                    const u32x4 v = *(const LAS u32x4*)(stg + row * 144 + ch * 16);
                    const size_t t = tok0 + 32 * ib + row;
                    const u32x4 gt = *(const u32x4*)(PA + t * PAW + C_RG + h * 128 + 64 * eh + 8 * ch);
                    u32x4 w; w.x = pk2(bflo(v.x) * bflo(gt.x), bfhi(v.x) * bfhi(gt.x)); w.y = pk2(bflo(v.y) * bflo(gt.y), bfhi(v.y) * bfhi(gt.y));
                    w.z = pk2(bflo(v.z) * bflo(gt.z), bfhi(v.z) * bfhi(gt.z)); w.w = pk2(bflo(v.w) * bflo(gt.w), bfhi(v.w) * bfhi(gt.w));
                    *(u32x4*)(AR + t * ARW + 512 + h * 128 + 64 * eh + 8 * ch) = w; }
                asm volatile("s_waitcnt lgkmcnt(0)" ::: "memory");
            }
        }
    }
}

struct TokRec { int e0, r0; float w0; int e1, r1; float w1; int pad0, pad1; };
__device__ __forceinline__ void p5_router(Frame& F) {
    LAS float* W = (LAS float*)F.lds;
    const float* w_gr = inptr(F, I_WGR); const float* w_er = inptr(F, I_WER); const float* b_gr = inptr(F, I_BGR); const float* b_er = inptr(F, I_BER);
    for (int idx = F.tid; idx < 1024 * 36; idx += 512) {
        const int k = idx / 36, c = idx - k * 36;
        const float v = c < 4 ? w_gr[k * 4 + c] : w_er[k * 32 + (c - 4)];
        const int rho = ((k & 3) + 4 * (k >> 8)) * 64 + ((k >> 2) & 63);
        W[rho * 36 + c] = v;
    }
    __syncthreads();
    const float* X2 = (const float*)F.outb; bf16_t* H2 = (bf16_t*)(F.ws + WS_H2); TokRec* TK = (TokRec*)(F.ws + WS_TOK);
    unsigned* cnt = F.ctl + CW_CNT;
    const int gw = F.vcu * NWAVES + F.wave, NGW = F.G * NWAVES, lane = F.lane;
    f32x4 gv[4];
#pragma unroll
    for (int j = 0; j < 4; ++j) gv[j] = ((const GAS f32x4*)inptr(F, I_G2))[lane + 64 * j];
    for (int p = gw; p < T / 2; p += NGW) {
        f32x4 xv[2][4]; float rstd[2];
#pragma unroll
        for (int tk = 0; tk < 2; ++tk) {
            const size_t t = (size_t)(2 * p + tk);
            const GAS f32x4* xr = (const GAS f32x4*)(X2 + t * DM) + lane; float s = 0.f;
#pragma unroll
            for (int j = 0; j < 4; ++j) { const f32x4 v = xr[64 * j]; xv[tk][j] = v; s += (v.x * v.x + v.y * v.y) + (v.z * v.z + v.w * v.w); }
            rstd[tk] = 1.0f / sqrtf(wave_sum(s) * (1.f / DM) + EPS);
            GAS u32x2* o8 = (GAS u32x2*)(H2 + t * DM) + lane;
#pragma unroll
            for (int j = 0; j < 4; ++j) { xv[tk][j] = xv[tk][j] * gv[j]; const f32x4 hv = xv[tk][j] * rstd[tk]; u32x2 w; w.x = pk2(hv.x, hv.y); w.y = pk2(hv.z, hv.w); o8[64 * j] = w; }
        }
        float acc[2][36];
#pragma unroll
        for (int c = 0; c < 36; ++c) { acc[0][c] = 0.f; acc[1][c] = 0.f; }
#pragma unroll
        for (int j = 0; j < 4; ++j)
#pragma unroll
            for (int i = 0; i < 4; ++i) {
                const LAS f32x4* wp = (const LAS f32x4*)(W + ((i + 4 * j) * 64 + lane) * 36);
                const float x0 = xv[0][j][i], x1 = xv[1][j][i];
#pragma unroll
                for (int c = 0; c < 9; ++c) { const f32x4 w = wp[c];
                    acc[0][4 * c] += x0 * w.x; acc[0][4 * c + 1] += x0 * w.y; acc[0][4 * c + 2] += x0 * w.z; acc[0][4 * c + 3] += x0 * w.w;
                    acc[1][4 * c] += x1 * w.x; acc[1][4 * c + 1] += x1 * w.y; acc[1][4 * c + 2] += x1 * w.z; acc[1][4 * c + 3] += x1 * w.w; }
                asm volatile("" ::: "memory");
            }
        float a[36];
#pragma unroll
        for (int c = 0; c < 36; ++c) { const float s0 = wave_sum(acc[0][c]), s1 = wave_sum(acc[1][c]); a[c] = (lane == 1) ? s1 * rstd[1] : s0 * rstd[0]; }
        if (lane < 2) {
            const int t = 2 * p + lane;
            float gl[4];
#pragma unroll
            for (int c = 0; c < 4; ++c) gl[c] = a[c] + b_gr[c];
            int g = 0; float gm = gl[0];
#pragma unroll
            for (int c = 1; c < 4; ++c) if (gl[c] > gm) { gm = gl[c]; g = c; }
            float gs = 0.f;
#pragma unroll
            for (int c = 0; c < 4; ++c) gs += __expf(gl[c] - gm);
            const float gprob = 1.0f / gs;
            float el[8];
#pragma unroll
            for (int i = 0; i < 8; ++i) el[i] = (g == 0 ? a[4 + i] : g == 1 ? a[12 + i] : g == 2 ? a[20 + i] : a[28 + i]) + b_er[g * 8 + i];
            int i0 = 0; float v0 = el[0];
#pragma unroll
            for (int i = 1; i < 8; ++i) if (el[i] > v0) { v0 = el[i]; i0 = i; }
            int i1 = -1; float v1 = -3.0e38f;
#pragma unroll
            for (int i = 0; i < 8; ++i) if (i != i0 && el[i] > v1) { v1 = el[i]; i1 = i; }
            const float ex = __expf(v1 - v0), w0 = gprob / (1.0f + ex), w1 = gprob * ex / (1.0f + ex);
            const int e0 = g * 8 + i0, e1 = g * 8 + i1;
            const int r0 = (int)atomicAdd(cnt + e0, 1u), r1 = (int)atomicAdd(cnt + e1, 1u);
            TokRec rec; rec.e0 = e0; rec.r0 = r0; rec.w0 = w0; rec.e1 = e1; rec.r1 = r1; rec.w1 = w1; rec.pad0 = 0; rec.pad1 = 0;
            TK[t] = rec;
        }
    }
}
__device__ __forceinline__ int expert_base_lane(Frame& F, int& total_tiles) {
    const int lane = F.lane;
    const unsigned c = (lane < NEXP) ? __hip_atomic_load(F.ctl + CW_CNT + lane, __ATOMIC_RELAXED, __HIP_MEMORY_SCOPE_AGENT) : 0u;
    const int pad = (int)((c + 255u) & ~255u);
    int incl = pad;
#pragma unroll
    for (int o = 1; o < 32; o <<= 1) { const int v = __shfl_up(incl, o); if ((lane & 31) >= o) incl += v; }
    total_tiles = __shfl(incl, 31) >> 8;
    return incl - pad;
}
__device__ __forceinline__ void p6_gather(Frame& F) {
    int ntl; const int basev = expert_base_lane(F, ntl);
    const bf16_t* H2 = (const bf16_t*)(F.ws + WS_H2); bf16_t* XG = (bf16_t*)(F.ws + WS_XG); const TokRec* TK = (const TokRec*)(F.ws + WS_TOK);
    const int gw = F.vcu * NWAVES + F.wave, NGW = F.G * NWAVES, lane = F.lane;
    for (int t = gw; t < T; t += NGW) {
        const TokRec rec = TK[t];
        const int s0 = __shfl(basev, rec.e0) + rec.r0, s1 = __shfl(basev, rec.e1) + rec.r1;
        const GAS u32x4* src = (const GAS u32x4*)(H2 + (size_t)t * DM) + lane;
        const u32x4 v0 = src[0], v1 = src[64];
        GAS u32x4* d0 = (GAS u32x4*)(XG + (size_t)s0 * DM) + lane; GAS u32x4* d1 = (GAS u32x4*)(XG + (size_t)s1 * DM) + lane;
        d0[0] = v0; d0[64] = v1; d1[0] = v0; d1[64] = v1;
    }
}
__device__ __forceinline__ int expert_tiles_to_lds(Frame& F) {
    int ntl; const int basev = expert_base_lane(F, ntl);
    __syncthreads();
    if (F.wave == 0 && F.lane < NEXP) F.MISC[16 + F.lane] = (unsigned)(basev >> 8);
    __syncthreads();
    return ntl;
}
__device__ __forceinline__ void p9_combine(Frame& F) {
    int ntl; const int basev = expert_base_lane(F, ntl);
    float* X2 = (float*)F.outb; const bf16_t* YB = (const bf16_t*)(F.ws + WS_YB); const TokRec* TK = (const TokRec*)(F.ws + WS_TOK);
    const int gw = F.vcu * NWAVES + F.wave, NGW = F.G * NWAVES, lane = F.lane;
    f32x4 gv[4];
#pragma unroll
    for (int j = 0; j < 4; ++j) gv[j] = ((const GAS f32x4*)inptr(F, I_GF))[lane + 64 * j];
    for (int t = gw; t < T; t += NGW) {
        const TokRec rec = TK[t];
        const int s0 = __shfl(basev, rec.e0) + rec.r0, s1 = __shfl(basev, rec.e1) + rec.r1;
        GAS f32x4* xr = (GAS f32x4*)(X2 + (size_t)t * DM) + lane;
        const GAS u32x2* y0 = (const GAS u32x2*)(YB + (size_t)s0 * DM) + lane; const GAS u32x2* y1 = (const GAS u32x2*)(YB + (size_t)s1 * DM) + lane;
        f32x4 v[4]; float s = 0.f;
#pragma unroll
        for (int j = 0; j < 4; ++j) { const f32x4 xv = xr[64 * j]; const u32x2 a = y0[64 * j], b = y1[64 * j];
            f32x4 r;
            r.x = xv.x + rec.w0 * bflo(a.x) + rec.w1 * bflo(b.x); r.y = xv.y + rec.w0 * bfhi(a.x) + rec.w1 * bfhi(b.x);
            r.z = xv.z + rec.w0 * bflo(a.y) + rec.w1 * bflo(b.y); r.w = xv.w + rec.w0 * bfhi(a.y) + rec.w1 * bfhi(b.y);
            v[j] = r; s += (r.x * r.x + r.y * r.y) + (r.z * r.z + r.w * r.w); }
        const float rstd = 1.0f / sqrtf(wave_sum(s) * (1.f / DM) + EPS);
#pragma unroll
        for (int j = 0; j < 4; ++j) xr[64 * j] = v[j] * rstd * gv[j];
    }
}

constexpr int NPHASE = 10;
struct Args { const float* in[17]; float* out; unsigned char* ws; int ph_lo, ph_hi, use_cg, pad; };
__global__ void __launch_bounds__(NWAVES * 64, 2) hybrid_fwd(Args args) {
    extern __shared__ __attribute__((aligned(16))) unsigned char lds[];
    Frame F;
    F.lds = (LAS unsigned char*)lds;
    F.MISC = (volatile LAS unsigned*)(F.lds + MISC_OFF);
    F.tid = threadIdx.x; F.lane = F.tid & 63; F.wave = __builtin_amdgcn_readfirstlane(F.tid >> 6);
    F.G = gridDim.x; { const int bx = blockIdx.x; F.vcu = (F.G % 8 == 0) ? (bx % 8) * (F.G / 8) + bx / 8 : bx; }
    F.ws = args.ws; F.outb = (unsigned char*)args.out; F.ctl = (unsigned*)(args.ws + WS_CTL);
    for (int u = F.tid; u < (LDS_BYTES - MISC_OFF) / 4; u += NWAVES * 64) ((LAS unsigned*)(F.lds + MISC_OFF))[u] = (u >= 64 && u < 64 + 34) ? ((const unsigned*)&args)[u - 64] : 0u;
    __syncthreads();
    const int lo = args.ph_lo, hi = args.ph_hi;
    const bool multi = (hi - lo) > 1;
    XcdBarrier bar; bar.bar = F.ctl + CW_BAR; bar.x = 0; bar.st = nullptr;
    if (multi) bar = xcd_barrier_post(F.ctl + CW_BAR, F.MISC + 8);
    if (args.use_cg == 12345) cg::this_grid().sync();
#define IN(k) (lo <= (k) && (k) < hi)
#define SEAM(k) do { if (IN(k) && IN((k) + 1)) xcd_barrier(bar); } while (0)

#define REP(k) ((PROBE_REP >> (k)) & 1)
#define P1_BODY { DenseOrder S; S.A = (const char*)F.outb; S.Bt = (const char*)(F.ws + WS_WIN); S.nM = T / 256; S.nN = INW / 256; S.nwg = S.nM * S.nN; S.G = F.G; S.c = (int)blockIdx.x; S.ld = DM; S.nt = 16; \
        EpiProj E{(bf16_t*)(F.ws + WS_PA), (bf16_t*)(F.ws + WS_GT), inptr(F, I_BIN)}; pg8::gemm_phase<EpiProj, DenseOrder>(F.lds, DM, S, E); }
#define P2_BODY { if (F.G >= 256) { if (F.vcu < 128) p2_retention_mfma(F, F.vcu, 128); else p2_attention_mfma(F, F.vcu - 128, F.G - 128); } \
        else { p2_retention_mfma(F, F.vcu, F.G); p2_attention_mfma(F, F.vcu, F.G); } }
#define P3_BODY { UpOrder S; S.d.A = (const char*)F.outb; S.d.Bt = (const char*)(F.ws + WS_WUP); S.d.nM = T / 256; S.d.nN = 4; S.d.nwg = S.d.nM * 4; S.d.G = F.G; S.d.c = (int)blockIdx.x; S.d.ld = ARW; S.d.nt = 0; \
        EpiUp E{(bf16_t*)(F.ws + WS_MIX), (const bf16_t*)(F.ws + WS_GT)}; pg8::gemm_phase<EpiUp, UpOrder>(F.lds, ARW, S, E); }
#define P4_BODY { DenseOrder S; S.A = (const char*)(F.ws + WS_MIX); S.Bt = (const char*)(F.ws + WS_WOUT); S.nM = T / 256; S.nN = 4; S.nwg = S.nM * 4; S.G = F.G; S.c = (int)blockIdx.x; S.ld = DM; S.nt = 16; \
        EpiOut E{inptr(F, I_X), (float*)F.outb}; pg8::gemm_phase<EpiOut, DenseOrder>(F.lds, DM, S, E); }
#define P7_BODY { const int ntl = expert_tiles_to_lds(F); \
        ExpertOrder S; S.A = (const char*)(F.ws + WS_XG); S.Bt = (const char*)(F.ws + WS_WGU); S.tp = (const volatile LAS int*)(F.MISC + 16); S.ntiles = ntl; S.G = F.G; S.c = (int)blockIdx.x; S.ldA = DM; S.nt = 16; \
        S.bstride = (size_t)1024 * 1024 * 2; S.bpn = (size_t)256 * 1024 * 2; EpiSwiglu E{(bf16_t*)(F.ws + WS_ACT)}; pg8::gemm_phase<EpiSwiglu, ExpertOrder>(F.lds, DM, S, E); }
#define P8_BODY { const int ntl = expert_tiles_to_lds(F); \
        ExpertOrder S; S.A = (const char*)(F.ws + WS_ACT); S.Bt = (const char*)(F.ws + WS_WD); S.tp = (const volatile LAS int*)(F.MISC + 16); S.ntiles = ntl; S.G = F.G; S.c = (int)blockIdx.x; S.ldA = DEXP; S.nt = 8; \
        S.bstride = (size_t)1024 * 512 * 2; S.bpn = (size_t)256 * 512 * 2; EpiDown E{(bf16_t*)(F.ws + WS_YB)}; pg8::gemm_phase<EpiDown, ExpertOrder>(F.lds, DEXP, S, E); }
#define RUN(k, BODY) do { if (IN(k)) { BODY; if (REP(k)) { xcd_barrier(bar); BODY; } } SEAM(k); } while (0)
    RUN(0, p0_prologue(F));
    RUN(1, P1_BODY);
    RUN(2, P2_BODY);
    RUN(3, P3_BODY);
    RUN(4, P4_BODY);
    if (IN(5)) { p5_router(F);
        if (REP(5)) { xcd_barrier(bar); if (blockIdx.x == 0 && F.tid < NEXP) __hip_atomic_store(F.ctl + CW_CNT + F.tid, 0u, __ATOMIC_RELAXED, __HIP_MEMORY_SCOPE_AGENT); xcd_barrier(bar); p5_router(F); } } SEAM(5);
    RUN(6, p6_gather(F));
    RUN(7, P7_BODY);
    RUN(8, P8_BODY);
    if (IN(9)) { p9_combine(F); }
#undef IN
#undef SEAM
}

extern "C" void kernel_launch(void* const* d_in, const int* in_sizes, int n_in, void* d_out, int out_size, void* d_ws, size_t ws_size, hipStream_t stream) {
    static int grid = 0;
    if (grid == 0) {
        if (n_in != 17 || in_sizes[0] != T * DM || out_size != T * DM || ws_size < WS_END) {
            fprintf(stderr, "kernel_launch: unexpected shapes (n_in %d, in0 %d, out %d, ws %zu); nothing launched\n", n_in, n_in > 0 ? in_sizes[0] : -1, out_size, ws_size); grid = -1; return; }
        int dev = 0, cus = 0, per_cu = 0;
        if (hipGetDevice(&dev) != hipSuccess || hipDeviceGetAttribute(&cus, hipDeviceAttributeMultiprocessorCount, dev) != hipSuccess) { grid = -1; return; }
        if (hipFuncSetAttribute((const void*)hybrid_fwd, hipFuncAttributeMaxDynamicSharedMemorySize, LDS_BYTES) != hipSuccess) { fprintf(stderr, "kernel_launch: hipFuncSetAttribute failed\n"); grid = -1; return; }
        if (hipOccupancyMaxActiveBlocksPerMultiprocessor(&per_cu, (const void*)hybrid_fwd, NWAVES * 64, LDS_BYTES) != hipSuccess || per_cu < 1) { fprintf(stderr, "kernel_launch: occupancy query says %d blocks per CU\n", per_cu); grid = -1; (void)hipGetLastError(); return; }
        grid = cus;
    }
    if (grid < 0) return;
    if (hipMemsetAsync((char*)d_ws + WS_CTL, 0, CTL_ZERO_BYTES, stream) != hipSuccess) return;
    Args a{};
    for (int i = 0; i < 17; ++i) a.in[i] = (const float*)d_in[i];
    a.out = (float*)d_out; a.ws = (unsigned char*)d_ws; a.use_cg = 0; a.pad = 0;
    constexpr int NL = MK_N_LAUNCHES;
    if (NL == 1) {
        a.ph_lo = 0; a.ph_hi = NPHASE;
        void* kargs[] = {&a};
        hipError_t e = hipLaunchCooperativeKernel((const void*)hybrid_fwd, dim3(grid), dim3(NWAVES * 64), kargs, LDS_BYTES, stream);
        if (e != hipSuccess) fprintf(stderr, "kernel_launch: cooperative launch failed: %s (grid %d)\n", hipGetErrorString(e), grid);
    } else {
        for (int li = 0; li < NPHASE; ++li) {
            a.ph_lo = li; a.ph_hi = li + 1;
            hipLaunchKernelGGL(hybrid_fwd, dim3(grid), dim3(NWAVES * 64), LDS_BYTES, stream, a);
        }
    }
}
```

```cpp
#include <hip/hip_runtime.h>
#include <hip/hip_cooperative_groups.h>
#include <cstdio>
#include <cstdint>
namespace cg = cooperative_groups;

#ifndef PROBE_REP
#define PROBE_REP 0
#endif
#ifndef MK_N_LAUNCHES
#define MK_N_LAUNCHES 1
#endif

#define LAS __attribute__((address_space(3)))
#define GAS __attribute__((address_space(1)))
typedef unsigned short bf16_t;
typedef short bf16x8 __attribute__((ext_vector_type(8)));
typedef float f32x4 __attribute__((ext_vector_type(4)));
typedef float f32x2 __attribute__((ext_vector_type(2)));
typedef unsigned u32x4 __attribute__((ext_vector_type(4)));
typedef unsigned u32x2 __attribute__((ext_vector_type(2)));

constexpr int DM = 1024, NB = 16, SEQ = 2048, T = NB * SEQ;
constexpr int INW = 5888, PAW = 3840, GTW = 2048;
constexpr int C_AQ = 0, C_AK = 512, C_AV = 640, C_RQ = 768, C_RK = 1280, C_RV = 1792, C_RG = 2816;
constexpr int ARW = 1536;
constexpr int NEXP = 32, DEXP = 512;
constexpr int PSLOT = 65536 + 8192;
constexpr float EPS = 1e-6f;

constexpr size_t MiB = 1u << 20;
constexpr size_t WS_CTL = 0, CTL_ZERO_BYTES = 1 * MiB;
constexpr size_t WS_WIN = 2 * MiB;
constexpr size_t WS_WUP = 14 * MiB;
constexpr size_t WS_WOUT = 17 * MiB;
constexpr size_t WS_WGU = 20 * MiB;
constexpr size_t WS_WD = 84 * MiB;
constexpr size_t WS_PA = 116 * MiB;
constexpr size_t WS_GT = 356 * MiB;
constexpr size_t WS_TOK = 484 * MiB;
constexpr size_t WS_END = 486 * MiB;
constexpr size_t WS_MIX = 116 * MiB;
constexpr size_t WS_H2 = 180 * MiB;
constexpr size_t WS_XG = 244 * MiB;
constexpr size_t WS_ACT = 388 * MiB;
constexpr size_t WS_YB = 116 * MiB;
constexpr int CW_CNT = 1024;
constexpr int CW_BAR = 4096;

constexpr int RING_BYTES = 131072;
constexpr int SCRATCH_BYTES = 147456;
constexpr int MISC_OFF = SCRATCH_BYTES;
constexpr int LDS_BYTES = SCRATCH_BYTES + 1024;

__device__ __forceinline__ unsigned f2bf(float f) { unsigned u = __builtin_bit_cast(unsigned, f); return (u + 0x7fffu + ((u >> 16) & 1u)) >> 16; }
__device__ __forceinline__ unsigned pk2(float lo, float hi) { return f2bf(lo) | (f2bf(hi) << 16); }
__device__ __forceinline__ float bflo(unsigned w) { return __builtin_bit_cast(float, w << 16); }
__device__ __forceinline__ float bfhi(unsigned w) { return __builtin_bit_cast(float, w & 0xffff0000u); }
__device__ __forceinline__ float bf2f(bf16_t b) { return __builtin_bit_cast(float, (unsigned)b << 16); }
__device__ __forceinline__ unsigned cvt_pk_bf16(float lo, float hi) { unsigned r; asm volatile("v_cvt_pk_bf16_f32 %0, %1, %2" : "=v"(r) : "v"(lo), "v"(hi)); return r; }
__device__ __forceinline__ float sigmoidf_(float v) { return 1.0f / (1.0f + __expf(-v)); }
__device__ __forceinline__ float wave_sum(float v) {
#pragma unroll
    for (int o = 1; o < 64; o <<= 1) v += __shfl_xor(v, o);
    return v;
}
#define LDS_WAIT() asm volatile("s_waitcnt lgkmcnt(0)" ::: "memory")
#define VM_WAIT() asm volatile("s_waitcnt vmcnt(0)" ::: "memory")

namespace pg8 {
constexpr int BM = 256, BK = 64, HALF = 128, HTB = HALF * BK * 2, STAGE_BYTES = 8 * HTB;
__host__ __device__ __forceinline__ int lds_byte(int r, int c) { const int st = (r >> 4) * 2 + (c >> 5), rr = r & 15, cc = c & 31, ob = rr * 64 + cc * 2; return st * 1024 + (ob ^ (((ob >> 9) & 1) << 5)); }
__host__ __device__ __forceinline__ void stage_rc(int b, int& R, int& C) { const int st = b / 1024, sb = b % 1024, swz = sb ^ (((sb >> 9) & 1) << 5); R = (st >> 1) * 16 + swz / 64; C = (st & 1) * 32 + (swz % 64) / 2; }
__host__ __device__ __forceinline__ int perm32(int rho) { const int n = rho >> 4, i = rho & 15; return 8 * (i >> 2) + 4 * n + (i & 3); }

struct Unit { const char* a; const char* b; int pm, pn, nt, aux; };

template <class Epi, class Sched>
__device__ __forceinline__ void gemm_phase(LAS unsigned char* lds, const int ld  , const Sched& S, const Epi& E) {
    const int tid = threadIdx.x, wid = __builtin_amdgcn_readfirstlane(tid >> 6), lane = tid & 63, wr = wid >> 2, wc = wid & 3, fr = lane & 15, fq = lane >> 4;
    unsigned voffA[2], voffB[2];
#pragma unroll
    for (int i = 0; i < 2; ++i) { int R, C; stage_rc(tid * 16 + i * 8192, R, C); const int Rb = Epi::PERM ? ((R & ~31) + perm32(R & 31)) : R;
        voffA[i] = (unsigned)(R * ld + C) * 2u; voffB[i] = (unsigned)(Rb * ld + C) * 2u; }
    const size_t kstep = (size_t)(BK * 2);
    const size_t hstep = (size_t)HALF * ld * 2;
    const unsigned ldsw = (unsigned)wid * 1024u;
    const int aoff = lds_byte(wr * 64 + fr, fq * 8), boff = lds_byte(wc * 32 + fr, fq * 8);
#define PG8_SA(b, h) (((b) * 2 + (h)) * HTB)
#define PG8_SB(b, h) ((4 + (b) * 2 + (h)) * HTB)
#define PG8_STAGE(bufoff, gbase, voff) do { _Pragma("unroll") for (int _i = 0; _i < 2; ++_i) \
        __builtin_amdgcn_global_load_lds((const unsigned*)((const char*)(gbase) + (voff)[_i]), (LAS unsigned*)(lds + (bufoff) + ldsw + _i * 8192), 16, 0, 0); } while (0)
#define PG8_LDA(dst, b, h) do { _Pragma("unroll") for (int m = 0; m < 4; ++m) _Pragma("unroll") for (int k = 0; k < 2; ++k) dst[m][k] = *(const LAS bf16x8*)(lds + PG8_SA(b, h) + aoff + m * 2048 + k * 1024); } while (0)
#define PG8_LDB(dst, b, h) do { _Pragma("unroll") for (int n = 0; n < 2; ++n) _Pragma("unroll") for (int k = 0; k < 2; ++k) dst[n][k] = *(const LAS bf16x8*)(lds + PG8_SB(b, h) + boff + n * 2048 + k * 1024); } while (0)
#define PG8_MMA(ai, bj, At, Bt) do { __builtin_amdgcn_s_setprio(1); _Pragma("unroll") for (int m = 0; m < 4; ++m) _Pragma("unroll") for (int n = 0; n < 2; ++n) _Pragma("unroll") for (int k = 0; k < 2; ++k) \
        acc[ai][bj][m][n] = __builtin_amdgcn_mfma_f32_16x16x32_bf16(Bt[n][k], At[m][k], acc[ai][bj][m][n], 0, 0, 0); __builtin_amdgcn_s_setprio(0); } while (0)
#define PG8_WAIT_V(n) asm volatile("s_waitcnt vmcnt(" #n ")" ::: "memory")
#define PG8_WAIT_L(n) asm volatile("s_waitcnt lgkmcnt(" #n ")" ::: "memory")
#define PG8_BAR __builtin_amdgcn_s_barrier()
#define PG8_SCHED __builtin_amdgcn_sched_barrier(0)
    Unit cur, nxt; int ui = 0;
    if (!S.next(0, cur)) return;
    f32x4 acc[2][2][4][2];
#pragma unroll
    for (int a = 0; a < 2; ++a)
#pragma unroll
        for (int b = 0; b < 2; ++b)
#pragma unroll
            for (int m = 0; m < 4; ++m)
#pragma unroll
                for (int n = 0; n < 2; ++n) acc[a][b][m][n] = (f32x4){0.f, 0.f, 0.f, 0.f};
    bf16x8 At[4][2], B0[2][2], B1[2][2];
    const char* cA = cur.a; const char* cB = cur.b;
    PG8_STAGE(PG8_SB(0, 0), cB, voffB); PG8_STAGE(PG8_SB(0, 1), cB + hstep, voffB); PG8_STAGE(PG8_SA(0, 0), cA, voffA); PG8_STAGE(PG8_SA(0, 1), cA + hstep, voffA);
    if (wr == 1) PG8_BAR;
    PG8_WAIT_V(2); PG8_BAR;
    PG8_STAGE(PG8_SB(1, 0), cB + kstep, voffB); PG8_STAGE(PG8_SA(1, 0), cA + kstep, voffA); PG8_STAGE(PG8_SB(1, 1), cB + hstep + kstep, voffB);
    PG8_WAIT_V(6); PG8_BAR;
    for (;;) {
        const bool has_next = S.next(ui + 1, nxt);
        const char* nA = has_next ? nxt.a : cA; const char* nB = has_next ? nxt.b : cB;
        const int nt = cur.nt;
        for (int t = 0; t < nt; t += 2) {
            const bool last = (t == nt - 2);
            const char* a1 = cA + (size_t)(t + 1) * kstep;
            const char* a2 = last ? nA : cA + (size_t)(t + 2) * kstep; const char* b2 = last ? nB : cB + (size_t)(t + 2) * kstep;
            const char* a3 = a2 + kstep; const char* b3 = b2 + kstep;
            PG8_LDB(B0, 0, 0); PG8_LDB(B1, 0, 1); PG8_SCHED; PG8_LDA(At, 0, 0); PG8_STAGE(PG8_SA(1, 1), a1 + hstep, voffA);
            PG8_WAIT_V(8); PG8_WAIT_L(0); PG8_BAR; PG8_MMA(0, 0, At, B0); PG8_MMA(0, 1, At, B1); PG8_BAR; PG8_SCHED;
            PG8_LDA(At, 0, 1); PG8_STAGE(PG8_SB(0, 0), b2, voffB); PG8_STAGE(PG8_SB(0, 1), b2 + hstep, voffB); PG8_STAGE(PG8_SA(0, 0), a2, voffA);
            PG8_WAIT_V(8); PG8_WAIT_L(0); PG8_BAR; PG8_MMA(1, 0, At, B0); PG8_MMA(1, 1, At, B1); PG8_BAR; PG8_SCHED;
            PG8_LDB(B0, 1, 0); PG8_LDB(B1, 1, 1); PG8_SCHED; PG8_LDA(At, 1, 0); PG8_STAGE(PG8_SA(0, 1), a2 + hstep, voffA);
            PG8_WAIT_V(8); PG8_WAIT_L(0); PG8_BAR; PG8_MMA(0, 0, At, B0); PG8_MMA(0, 1, At, B1); PG8_BAR; PG8_SCHED;
            PG8_LDA(At, 1, 1); PG8_STAGE(PG8_SB(1, 0), b3, voffB); PG8_STAGE(PG8_SB(1, 1), b3 + hstep, voffB); PG8_STAGE(PG8_SA(1, 0), a3, voffA);
            PG8_WAIT_V(8); PG8_WAIT_L(0); PG8_BAR; PG8_MMA(1, 0, At, B0); PG8_MMA(1, 1, At, B1); PG8_BAR; PG8_SCHED;
        }
        if (wr == 0) PG8_BAR;
        E(acc, cur, wr, wc, fr, fq);
        if (!has_next) break;
#pragma unroll
        for (int a = 0; a < 2; ++a)
#pragma unroll
            for (int b = 0; b < 2; ++b)
#pragma unroll
                for (int m = 0; m < 4; ++m)
#pragma unroll
                    for (int n = 0; n < 2; ++n) acc[a][b][m][n] = (f32x4){0.f, 0.f, 0.f, 0.f};
        cur = nxt; cA = nA; cB = nB; ++ui;
        if (wr == 1) PG8_BAR;
    }
    PG8_WAIT_V(0);
    PG8_BAR;
#undef PG8_SA
#undef PG8_SB
#undef PG8_STAGE
#undef PG8_LDA
#undef PG8_LDB
#undef PG8_MMA
#undef PG8_WAIT_V
#undef PG8_WAIT_L
#undef PG8_BAR
#undef PG8_SCHED
}
typedef f32x4 Acc[2][2][4][2];
}

#define XB_TMO      128
#define XB_XCNT(j)  (256  + 64 * (j))
#define XB_XSUB(j)  (1280 + 64 * (j))
#define XB_XGEN(j)  (2304 + 64 * (j))
#define XB_TOP      3328
#define XB_TOPGEN   3392
#define XCD_BAR_WORDS 3456
#define XB_SPIN_CAP (1u << 18)
__device__ __forceinline__ unsigned xb_ld(unsigned* p)              { return __hip_atomic_load(p, __ATOMIC_RELAXED, __HIP_MEMORY_SCOPE_AGENT); }
__device__ __forceinline__ unsigned xb_add(unsigned* p, unsigned v) { return __hip_atomic_fetch_add(p, v, __ATOMIC_RELAXED, __HIP_MEMORY_SCOPE_AGENT); }
__device__ __forceinline__ unsigned xb_xcc_id() { return (unsigned)__builtin_amdgcn_s_getreg((3 << 11) | 20) & 0xFu; }
#define XB_SPIN(cond, bar) do { unsigned _sp = 0; while (cond) { __builtin_amdgcn_s_sleep(1); \
    if ((++_sp & 255u) == 0u) { if (xb_ld(&(bar)[XB_TMO])) break; if (_sp > XB_SPIN_CAP) { atomicAdd(&(bar)[XB_TMO], 1u); break; } } } } while (0)
struct XcdBarrier { unsigned* bar; unsigned x; volatile LAS unsigned* st; };
__device__ __forceinline__ XcdBarrier xcd_barrier_post(unsigned* bar, volatile LAS unsigned* st) {
    XcdBarrier b; b.bar = bar; b.x = xb_xcc_id(); b.st = st;
    if (threadIdx.x == 0) (void)xb_add(&bar[XB_XCNT(b.x)], 1u);
    return b;
}
__device__ __forceinline__ void xcd_barrier_complete(unsigned* bar, unsigned x, unsigned& nloc, unsigned& nx) {
    const unsigned G = gridDim.x * gridDim.y * gridDim.z;
    unsigned sum, cnt, mine, sp = 0u;
    for (;;) {
        sum = 0u; cnt = 0u; mine = 0u;
#pragma unroll
        for (unsigned j = 0; j < 16; ++j) { const unsigned c = xb_ld(&bar[XB_XCNT(j)]); sum += c; cnt += (c > 0u) ? 1u : 0u; mine = (j == x) ? c : mine; }
        if (sum == G) break;
        __builtin_amdgcn_s_sleep(1);
        if ((++sp & 255u) == 0u) { if (xb_ld(&bar[XB_TMO])) break; if (sp > XB_SPIN_CAP) { atomicAdd(&bar[XB_TMO], 1u); break; } }
    }
    nloc = mine > 0u ? mine : 1u; nx = cnt > 0u ? cnt : 1u;
}
__device__ __forceinline__ void xcd_barrier(const XcdBarrier& b) {
    asm volatile("s_waitcnt vmcnt(0)" ::: "memory");
    __syncthreads();
    if (threadIdx.x == 0) {
        unsigned* bar = b.bar;
        __builtin_amdgcn_s_waitcnt(0);
        unsigned nloc = b.st[0], nx = b.st[1];
        if (nloc == 0u) { xcd_barrier_complete(bar, b.x, nloc, nx); b.st[0] = nloc; b.st[1] = nx; }
        const unsigned old = xb_add(&bar[XB_XSUB(b.x)], 1u);
        const unsigned gen = old / nloc;
        if (old + 1u == (gen + 1u) * nloc) {
            __builtin_amdgcn_fence(__ATOMIC_RELEASE, "agent");
            asm volatile("s_waitcnt vmcnt(0)" ::: "memory");
            const unsigned og = xb_add(&bar[XB_TOP], 1u);
            const unsigned tg = og / nx;
            if (og + 1u == (tg + 1u) * nx) xb_add(&bar[XB_TOPGEN], 1u);
            else XB_SPIN(xb_ld(&bar[XB_TOPGEN]) == tg, bar);
            __builtin_amdgcn_fence(__ATOMIC_ACQUIRE, "agent");
            xb_add(&bar[XB_XGEN(b.x)], 1u);
            asm volatile("s_waitcnt vmcnt(0)" ::: "memory");
        } else {
            XB_SPIN(xb_ld(&bar[XB_XGEN(b.x)]) == gen, bar);
            __builtin_amdgcn_fence(__ATOMIC_ACQUIRE, "agent");
            asm volatile("s_waitcnt vmcnt(0)" ::: "memory");
        }
    }
    __syncthreads();
}

constexpr int NWAVES = 8;
struct Frame {
    LAS unsigned char* lds;
    volatile LAS unsigned* MISC;
    unsigned* ctl;
    int tid, lane, wave, vcu, G;
    unsigned char* ws; unsigned char* outb;
    const float *x, *g1, *w_in, *b_in, *sinks, *w_au, *w_ru, *w_out, *g2, *w_gr, *b_gr, *w_er, *b_er, *w_ge, *w_ue, *w_de, *gf;
};

__device__ __forceinline__ void p0_transpose_item(const float* W, int N, int k0, int n0, bf16_t* WT, size_t dpitch, int drow0, int dcol0, LAS float* scr, int lane) {
#pragma unroll 8
    for (int i = 0; i < 32; ++i) { const int kk = 2 * i + (lane >> 5); scr[kk * 33 + (lane & 31)] = W[(size_t)(k0 + kk) * N + n0 + (lane & 31)]; }
    LDS_WAIT(); asm volatile("" ::: "memory");
    const int c = lane & 7;
#pragma unroll
    for (int j = 0; j < 4; ++j) { const int n = (lane >> 3) + 8 * j; const LAS float* s = scr + (8 * c) * 33 + n;
        u32x4 o; o.x = pk2(s[0 * 33], s[1 * 33]); o.y = pk2(s[2 * 33], s[3 * 33]); o.z = pk2(s[4 * 33], s[5 * 33]); o.w = pk2(s[6 * 33], s[7 * 33]);
        *(GAS u32x4*)(WT + (size_t)(drow0 + n) * dpitch + dcol0 + k0 + 8 * c) = o; }
    LDS_WAIT(); asm volatile("" ::: "memory");
}
__device__ __forceinline__ void p0_prologue(Frame& F) {
    LAS float* scr = (LAS float*)(F.lds + F.wave * 16384);
    const int gw = F.vcu * NWAVES + F.wave, NGW = F.G * NWAVES;
    constexpr int I_IN = 16 * 184, I_AU = 8 * 32, I_RU = 16 * 32, I_OUT = 16 * 32, I_G = 32 * 256, I_U = 32 * 256, I_D = 32 * 256;
    constexpr int NITEMS = I_IN + I_AU + I_RU + I_OUT + I_G + I_U + I_D;
    bf16_t* WinT = (bf16_t*)(F.ws + WS_WIN); bf16_t* WupT = (bf16_t*)(F.ws + WS_WUP); bf16_t* WoutT = (bf16_t*)(F.ws + WS_WOUT);
    bf16_t* WguT = (bf16_t*)(F.ws + WS_WGU); bf16_t* WdT = (bf16_t*)(F.ws + WS_WD);
    for (int it = gw; it < NITEMS; it += NGW) {
        int r = it;
        if (r < I_IN) { const int kb = r / 184, nb = r % 184; p0_transpose_item(F.w_in, INW, 64 * kb, 32 * nb, WinT, 1024, 32 * nb, 0, scr, F.lane); continue; } r -= I_IN;
        if (r < I_AU) { const int kb = r / 32, nb = r % 32; p0_transpose_item(F.w_au, 1024, 64 * kb, 32 * nb, WupT, 1536, 32 * nb, 0, scr, F.lane); continue; } r -= I_AU;
        if (r < I_RU) { const int kb = r / 32, nb = r % 32; p0_transpose_item(F.w_ru, 1024, 64 * kb, 32 * nb, WupT, 1536, 32 * nb, 512, scr, F.lane); continue; } r -= I_RU;
        if (r < I_OUT) { const int kb = r / 32, nb = r % 32; p0_transpose_item(F.w_out, 1024, 64 * kb, 32 * nb, WoutT, 1024, 32 * nb, 0, scr, F.lane); continue; } r -= I_OUT;
        if (r < I_G) { const int e = r / 256, q = r % 256, kb = q / 16, nb = q % 16, n0 = 32 * nb;
            p0_transpose_item(F.w_ge + (size_t)e * 1024 * 512, 512, 64 * kb, n0, WguT + (size_t)e * 1024 * 1024, 1024, 256 * (n0 >> 7) + (n0 & 127), 0, scr, F.lane); continue; } r -= I_G;
        if (r < I_U) { const int e = r / 256, q = r % 256, kb = q / 16, nb = q % 16, n0 = 32 * nb;
            p0_transpose_item(F.w_ue + (size_t)e * 1024 * 512, 512, 64 * kb, n0, WguT + (size_t)e * 1024 * 1024, 1024, 256 * (n0 >> 7) + 128 + (n0 & 127), 0, scr, F.lane); continue; } r -= I_U;
        { const int e = r / 256, q = r % 256, kb = q / 32, nb = q % 32;
            p0_transpose_item(F.w_de + (size_t)e * 512 * 1024, 1024, 64 * kb, 32 * nb, WdT + (size_t)e * 1024 * 512, 512, 32 * nb, 0, scr, F.lane); }
    }
    bf16_t* XN = (bf16_t*)F.outb;
    f32x4 gv[4];
#pragma unroll
    for (int j = 0; j < 4; ++j) gv[j] = ((const GAS f32x4*)F.g1)[F.lane + 64 * j];
    for (int m = gw; m < T; m += NGW) {
        const GAS f32x4* xr = (const GAS f32x4*)(F.x + (size_t)m * DM) + F.lane;
        f32x4 v[4]; float s = 0.f;
#pragma unroll
        for (int j = 0; j < 4; ++j) { v[j] = xr[64 * j]; s += (v[j].x * v[j].x + v[j].y * v[j].y) + (v[j].z * v[j].z + v[j].w * v[j].w); }
        const float rstd = 1.0f / sqrtf(wave_sum(s) * (1.f / DM) + EPS);
        GAS u32x2* o8 = (GAS u32x2*)(XN + (size_t)m * DM) + F.lane;
#pragma unroll
        for (int j = 0; j < 4; ++j) { u32x2 w; w.x = pk2(v[j].x * rstd * gv[j].x, v[j].y * rstd * gv[j].y); w.y = pk2(v[j].z * rstd * gv[j].z, v[j].w * rstd * gv[j].w); o8[64 * j] = w; }
    }
}

struct DenseOrder {
    const char* A; const char* Bt; int nM, nN, nwg, G, c, ld, nt;
    __device__ __forceinline__ void tile(int wg, int& pm, int& pn) const {
        int wgid = wg; { const int q = nwg / 8, r = nwg % 8, xcd = wgid % 8, off = wgid / 8; wgid = (xcd < r ? xcd * (q + 1) : r * (q + 1) + (xcd - r) * q) + off; }
        const int nig = 8 * nN, gid = wgid / nig, fm = gid * 8, gsz = (nM - fm) < 8 ? (nM - fm) : 8;
        pm = fm + ((wgid % nig) % gsz); pn = (wgid % nig) / gsz;
    }
    __device__ __forceinline__ bool next(int i, pg8::Unit& u) const {
        const long L = (long)i * G + c; if (L >= nwg) return false;
        int pm, pn; tile((int)L, pm, pn);
        u.pm = pm; u.pn = pn; u.nt = nt; u.aux = 0;
        u.a = A + (size_t)pm * 256 * ld * 2; u.b = Bt + (size_t)pn * 256 * ld * 2; return true;
    }
};
struct UpOrder {
    DenseOrder d;
    __device__ __forceinline__ bool next(int i, pg8::Unit& u) const {
        const long L = (long)(i >> 1) * d.G + d.c; if (L >= d.nwg) return false;
        int pm, pn; d.tile((int)L, pm, pn);
        const int part = i & 1;
        u.pm = pm; u.pn = pn; u.aux = part; u.nt = part ? 16 : 8;
        u.a = d.A + (size_t)pm * 256 * ARW * 2 + (part ? 1024 : 0); u.b = d.Bt + (size_t)pn * 256 * ARW * 2 + (part ? 1024 : 0); return true;
    }
};
struct ExpertOrder {
    const char* A; const char* Bt; const volatile LAS int* tp; int ntiles, G, c, ldA, nt; size_t bstride  , bpn  ;
    __device__ __forceinline__ bool next(int i, pg8::Unit& u) const {
        const long L = (long)i * G + c; if (L >= (long)ntiles * 4) return false;
        const int tix = (int)(L >> 2), pn = (int)(L & 3);
        int e = 0;
        for (int k = 1; k < NEXP; ++k) e += (tix >= tp[k]) ? 1 : 0;
        u.pm = tix; u.pn = pn; u.nt = nt; u.aux = e;
        u.a = A + (size_t)tix * 256 * ldA * 2; u.b = Bt + (size_t)e * bstride + (size_t)pn * bpn; return true;
    }
};

struct EpiProj {
    static constexpr bool PERM = true;
    bf16_t* PA; bf16_t* GT; const float* bias;
    __device__ __forceinline__ void operator()(const pg8::Acc& acc, const pg8::Unit& u, int wr, int wc, int fr, int fq) const {
        const int ct = u.pn; const int mode = ct < 11 ? 0 : (ct < 15 ? 1 : 2);
        bf16_t* base; int ldc, colt;
        if (ct < 15) { base = PA; ldc = PAW; colt = ct * 256; } else { base = GT; ldc = GTW; colt = ct * 256 - PAW; }
        const int row0 = u.pm * 256 + wr * 64 + fr, col0 = colt + wc * 32 + 8 * fq, bcol0 = ct * 256 + wc * 32 + 8 * fq;
        f32x4 bv[2][2];
#pragma unroll
        for (int bj = 0; bj < 2; ++bj)
#pragma unroll
            for (int n = 0; n < 2; ++n) bv[bj][n] = *(const f32x4*)(bias + bcol0 + bj * 128 + 4 * n);
#pragma unroll
        for (int ai = 0; ai < 2; ++ai)
#pragma unroll
            for (int m = 0; m < 4; ++m) { bf16_t* rowp = base + (size_t)(row0 + ai * 128 + m * 16) * ldc + col0;
#pragma unroll
                for (int bj = 0; bj < 2; ++bj) { f32x4 v0 = acc[ai][bj][m][0] + bv[bj][0], v1 = acc[ai][bj][m][1] + bv[bj][1];
                    if (mode != 0) {
#pragma unroll
                        for (int j = 0; j < 4; ++j) { const float s0 = sigmoidf_(v0[j]), s1 = sigmoidf_(v1[j]); v0[j] = (mode == 1) ? v0[j] * s0 : s0; v1[j] = (mode == 1) ? v1[j] * s1 : s1; } }
                    u32x4 w; w.x = cvt_pk_bf16(v0[0], v0[1]); w.y = cvt_pk_bf16(v0[2], v0[3]); w.z = cvt_pk_bf16(v1[0], v1[1]); w.w = cvt_pk_bf16(v1[2], v1[3]);
                    *(u32x4*)(rowp + bj * 128) = w; } }
    }
};
struct EpiUp {
    static constexpr bool PERM = true;
    bf16_t* MIX; const bf16_t* GT;
    __device__ __forceinline__ void operator()(const pg8::Acc& acc, const pg8::Unit& u, int wr, int wc, int fr, int fq) const {
        const int part = u.aux;
        const int row0 = u.pm * 256 + wr * 64 + fr, col0 = u.pn * 256 + wc * 32 + 8 * fq;
#pragma unroll
        for (int ai = 0; ai < 2; ++ai) {
            u32x4 g[4][2], p[4][2];
#pragma unroll
            for (int m = 0; m < 4; ++m)
#pragma unroll
                for (int bj = 0; bj < 2; ++bj) { const size_t row = (size_t)(row0 + ai * 128 + m * 16);
                    g[m][bj] = __builtin_nontemporal_load((const u32x4*)(GT + row * GTW + part * 1024 + col0 + bj * 128));
                    p[m][bj] = part ? *(const u32x4*)(MIX + row * DM + col0 + bj * 128) : (u32x4){0u, 0u, 0u, 0u}; }
            asm volatile("" ::: "memory");
#pragma unroll
            for (int m = 0; m < 4; ++m)
#pragma unroll
                for (int bj = 0; bj < 2; ++bj) { const size_t row = (size_t)(row0 + ai * 128 + m * 16);
                    const f32x4 a0 = acc[ai][bj][m][0], a1 = acc[ai][bj][m][1]; const u32x4 gg = g[m][bj], pp = p[m][bj];
                    float r[8];
                    r[0] = bflo(gg.x) * a0[0] + bflo(pp.x); r[1] = bfhi(gg.x) * a0[1] + bfhi(pp.x); r[2] = bflo(gg.y) * a0[2] + bflo(pp.y); r[3] = bfhi(gg.y) * a0[3] + bfhi(pp.y);
                    r[4] = bflo(gg.z) * a1[0] + bflo(pp.z); r[5] = bfhi(gg.z) * a1[1] + bfhi(pp.z); r[6] = bflo(gg.w) * a1[2] + bflo(pp.w); r[7] = bfhi(gg.w) * a1[3] + bfhi(pp.w);
                    u32x4 w; w.x = cvt_pk_bf16(r[0], r[1]); w.y = cvt_pk_bf16(r[2], r[3]); w.z = cvt_pk_bf16(r[4], r[5]); w.w = cvt_pk_bf16(r[6], r[7]);
                    *(u32x4*)(MIX + row * DM + col0 + bj * 128) = w; }
            asm volatile("" ::: "memory");
        }
    }
};
struct EpiOut {
    static constexpr bool PERM = false;
    const float* x; float* X2;
    __device__ __forceinline__ void operator()(const pg8::Acc& acc, const pg8::Unit& u, int wr, int wc, int fr, int fq) const {
        const int row0 = u.pm * 256 + wr * 64 + fr, col0 = u.pn * 256 + wc * 32 + 4 * fq;
#pragma unroll
        for (int ai = 0; ai < 2; ++ai) {
            f32x4 xv[4][2][2];
#pragma unroll
            for (int m = 0; m < 4; ++m) { const size_t off = (size_t)(row0 + ai * 128 + m * 16) * DM + col0;
#pragma unroll
                for (int bj = 0; bj < 2; ++bj)
#pragma unroll
                    for (int n = 0; n < 2; ++n) xv[m][bj][n] = __builtin_nontemporal_load((const f32x4*)(x + off + bj * 128 + n * 16)); }
            asm volatile("" ::: "memory");
#pragma unroll
            for (int m = 0; m < 4; ++m) { const size_t off = (size_t)(row0 + ai * 128 + m * 16) * DM + col0;
#pragma unroll
                for (int bj = 0; bj < 2; ++bj)
#pragma unroll
                    for (int n = 0; n < 2; ++n) *(f32x4*)(X2 + off + bj * 128 + n * 16) = xv[m][bj][n] + acc[ai][bj][m][n]; }
            asm volatile("" ::: "memory");
        }
    }
};
struct EpiSwiglu {
    static constexpr bool PERM = true;
    bf16_t* ACT;
    __device__ __forceinline__ void operator()(const pg8::Acc& acc, const pg8::Unit& u, int wr, int wc, int fr, int fq) const {
        const int row0 = u.pm * 256 + wr * 64 + fr, col0 = u.pn * 128 + wc * 32 + 8 * fq;
#pragma unroll
        for (int ai = 0; ai < 2; ++ai)
#pragma unroll
            for (int m = 0; m < 4; ++m) { bf16_t* rowp = ACT + (size_t)(row0 + ai * 128 + m * 16) * DEXP + col0;
                float r[8];
#pragma unroll
                for (int n = 0; n < 2; ++n)
#pragma unroll
                    for (int j = 0; j < 4; ++j) { const float g = acc[ai][0][m][n][j], up = acc[ai][1][m][n][j]; r[4 * n + j] = g * sigmoidf_(g) * up; }
                u32x4 w; w.x = cvt_pk_bf16(r[0], r[1]); w.y = cvt_pk_bf16(r[2], r[3]); w.z = cvt_pk_bf16(r[4], r[5]); w.w = cvt_pk_bf16(r[6], r[7]);
                *(u32x4*)rowp = w; }
    }
};
struct EpiDown {
    static constexpr bool PERM = true;
    bf16_t* YB;
    __device__ __forceinline__ void operator()(const pg8::Acc& acc, const pg8::Unit& u, int wr, int wc, int fr, int fq) const {
        const int row0 = u.pm * 256 + wr * 64 + fr, col0 = u.pn * 256 + wc * 32 + 8 * fq;
#pragma unroll
        for (int ai = 0; ai < 2; ++ai)
#pragma unroll
            for (int m = 0; m < 4; ++m) { bf16_t* rowp = YB + (size_t)(row0 + ai * 128 + m * 16) * DM + col0;
#pragma unroll
                for (int bj = 0; bj < 2; ++bj) { const f32x4 v0 = acc[ai][bj][m][0], v1 = acc[ai][bj][m][1];
                    u32x4 w; w.x = cvt_pk_bf16(v0[0], v0[1]); w.y = cvt_pk_bf16(v0[2], v0[3]); w.z = cvt_pk_bf16(v1[0], v1[1]); w.w = cvt_pk_bf16(v1[2], v1[3]);
                    *(u32x4*)(rowp + bj * 128) = w; } }
    }
};

__device__ __forceinline__ void ld8bf(const bf16_t* p, float* o) { const u32x4 w = *(const u32x4*)p; o[0] = bflo(w.x); o[1] = bfhi(w.x); o[2] = bflo(w.y); o[3] = bfhi(w.y); o[4] = bflo(w.z); o[5] = bfhi(w.z); o[6] = bflo(w.w); o[7] = bfhi(w.w); }
__device__ __forceinline__ void p2_attention_naive(Frame& F, int u0, int ustride) {
    LAS float* Ks = (LAS float*)F.lds;
    LAS float* Vs = Ks + 256 * 68;
    const bf16_t* PA = (const bf16_t*)(F.ws + WS_PA); bf16_t* AR = (bf16_t*)F.outb;
    const int tid = F.tid, part = tid & 7;
    for (int unit = u0; unit < NB * 16 * 8; unit += ustride) {
        const int h = unit & 7, n = (unit >> 3) & 15, b = unit >> 7, kvh = h >> 2;
        const size_t tok0 = (size_t)b * SEQ + n * 128;
        __syncthreads();
        for (int idx = tid; idx < 256 * 8; idx += 512) {
            const int j = idx >> 3, c = idx & 7;
            float kf[8], vf[8];
            if (n == 0 && j < 128) {
#pragma unroll
                for (int i = 0; i < 8; ++i) { kf[i] = 0.f; vf[i] = 0.f; }
            } else {
                const bf16_t* rp = PA + (tok0 - 128 + j) * PAW;
                ld8bf(rp + C_AK + kvh * 64 + c * 8, kf); ld8bf(rp + C_AV + kvh * 64 + c * 8, vf);
            }
            *(LAS f32x4*)(Ks + j * 68 + c * 8) = (f32x4){kf[0], kf[1], kf[2], kf[3]}; *(LAS f32x4*)(Ks + j * 68 + c * 8 + 4) = (f32x4){kf[4], kf[5], kf[6], kf[7]};
            *(LAS f32x4*)(Vs + j * 68 + c * 8) = (f32x4){vf[0], vf[1], vf[2], vf[3]}; *(LAS f32x4*)(Vs + j * 68 + c * 8 + 4) = (f32x4){vf[4], vf[5], vf[6], vf[7]};
        }
        __syncthreads();
        const float slope = exp2f(-(float)(h + 1)), sink = F.sinks[h];
        for (int qh = 0; qh < 2; ++qh) {
            const int q = qh * 64 + (tid >> 3);
            const size_t tq = tok0 + q;
            float qr[64];
#pragma unroll
            for (int c = 0; c < 8; ++c) ld8bf(PA + tq * PAW + C_AQ + h * 64 + c * 8, qr + 8 * c);
            float o[64];
#pragma unroll
            for (int d = 0; d < 64; ++d) o[d] = 0.f;
            float mx = sink, den = (part == 0) ? 1.0f : 0.0f;
#pragma unroll 1
            for (int jj = 0; jj < 32; ++jj) {
                const int j = part + 8 * jj, dist = q + 128 - j;
                const bool valid = dist >= 0 && dist < 128 && (n > 0 || j >= 128);
                if (valid) {
                    float d = 0.f;
                    const LAS f32x4* kp = (const LAS f32x4*)(Ks + j * 68);
#pragma unroll
                    for (int c = 0; c < 16; ++c) { const f32x4 kv = kp[c]; d += qr[4 * c] * kv.x + qr[4 * c + 1] * kv.y + qr[4 * c + 2] * kv.z + qr[4 * c + 3] * kv.w; }
                    const float sc = d * 0.125f - slope * (float)dist;
                    const float mn = fmaxf(mx, sc), f = __expf(mx - mn), p = __expf(sc - mn);
                    mx = mn; den = den * f + p;
                    const LAS f32x4* vp = (const LAS f32x4*)(Vs + j * 68);
#pragma unroll
                    for (int c = 0; c < 16; ++c) { const f32x4 vv = vp[c]; o[4 * c] = o[4 * c] * f + p * vv.x; o[4 * c + 1] = o[4 * c + 1] * f + p * vv.y; o[4 * c + 2] = o[4 * c + 2] * f + p * vv.z; o[4 * c + 3] = o[4 * c + 3] * f + p * vv.w; }
                }
            }
            float ma = fmaxf(mx, __shfl_xor(mx, 1)); ma = fmaxf(ma, __shfl_xor(ma, 2)); ma = fmaxf(ma, __shfl_xor(ma, 4));
            const float fs = __expf(mx - ma);
            den *= fs; den += __shfl_xor(den, 1); den += __shfl_xor(den, 2); den += __shfl_xor(den, 4);
            const float inv = 1.0f / den;
#pragma unroll
            for (int d = 0; d < 64; ++d) { o[d] *= fs; o[d] += __shfl_xor(o[d], 1); o[d] += __shfl_xor(o[d], 2); o[d] += __shfl_xor(o[d], 4); }
            if (part == 0) {
                bf16_t* op = AR + tq * ARW + h * 64;
#pragma unroll
                for (int c = 0; c < 8; ++c) { u32x4 w0; w0.x = pk2(o[8 * c] * inv, o[8 * c + 1] * inv); w0.y = pk2(o[8 * c + 2] * inv, o[8 * c + 3] * inv); w0.z = pk2(o[8 * c + 4] * inv, o[8 * c + 5] * inv); w0.w = pk2(o[8 * c + 6] * inv, o[8 * c + 7] * inv);
                    *(u32x4*)(op + 8 * c) = w0; }
            }
        }
    }
}
__device__ __forceinline__ void p2_retention_naive(Frame& F, int u0, int ustride) {
    LAS float* Qs = (LAS float*)F.lds;
    LAS float* Ks = Qs + 128 * 68;
    LAS bf16_t* Vs = (LAS bf16_t*)(Ks + 128 * 68);
    LAS float* Ss = (LAS float*)(Vs + 128 * 136);
    const bf16_t* PA = (const bf16_t*)(F.ws + WS_PA); bf16_t* AR = (bf16_t*)F.outb;
    const int tid = F.tid;
    for (int unit = u0; unit < NB * 8; unit += ustride) {
        const int h = unit & 7, b = unit >> 3;
        const float lg = log2f(1.0f - exp2f(-5.0f - (float)h));
        __syncthreads();
        for (int idx = tid; idx < 64 * 128; idx += 512) Ss[idx] = 0.f;
        for (int n = 0; n < 16; ++n) {
            const size_t tok0 = (size_t)b * SEQ + n * 128;
            __syncthreads();
            for (int idx = tid; idx < 128 * 8; idx += 512) {
                const int j = idx >> 3, c = idx & 7; const bf16_t* rp = PA + (tok0 + j) * PAW;
                float qf[8], kf[8]; ld8bf(rp + C_RQ + h * 64 + c * 8, qf); ld8bf(rp + C_RK + h * 64 + c * 8, kf);
                *(LAS f32x4*)(Qs + j * 68 + c * 8) = (f32x4){qf[0], qf[1], qf[2], qf[3]}; *(LAS f32x4*)(Qs + j * 68 + c * 8 + 4) = (f32x4){qf[4], qf[5], qf[6], qf[7]};
                *(LAS f32x4*)(Ks + j * 68 + c * 8) = (f32x4){kf[0], kf[1], kf[2], kf[3]}; *(LAS f32x4*)(Ks + j * 68 + c * 8 + 4) = (f32x4){kf[4], kf[5], kf[6], kf[7]};
            }
            for (int idx = tid; idx < 128 * 16; idx += 512) {
                const int j = idx >> 4, c = idx & 15;
                *(LAS u32x4*)(Vs + j * 136 + c * 8) = *(const u32x4*)(PA + (tok0 + j) * PAW + C_RV + h * 128 + c * 8);
            }
            __syncthreads();
            {
                const int i = tid >> 2, part = tid & 3;
                float qreg[16];
#pragma unroll
                for (int c = 0; c < 4; ++c) { const f32x4 v = *(const LAS f32x4*)(Qs + i * 68 + 16 * part + 4 * c); qreg[4 * c] = v.x; qreg[4 * c + 1] = v.y; qreg[4 * c + 2] = v.z; qreg[4 * c + 3] = v.w; }
                float y[32];
#pragma unroll
                for (int e = 0; e < 32; ++e) y[e] = 0.f;
                const int jmax = i | 15;
                for (int j = 0; j <= jmax; ++j) {
                    float sdot = 0.f;
#pragma unroll
                    for (int c = 0; c < 4; ++c) { const f32x4 kv = *(const LAS f32x4*)(Ks + j * 68 + 16 * part + 4 * c); sdot += qreg[4 * c] * kv.x + qreg[4 * c + 1] * kv.y + qreg[4 * c + 2] * kv.z + qreg[4 * c + 3] * kv.w; }
                    sdot += __shfl_xor(sdot, 1); sdot += __shfl_xor(sdot, 2);
                    const float w = (j <= i) ? sdot * 0.125f * exp2f((float)(i - j) * lg) : 0.f;
#pragma unroll
                    for (int c = 0; c < 4; ++c) { const u32x4 vv = *(const LAS u32x4*)(Vs + j * 136 + 32 * part + 8 * c);
                        y[8 * c] += w * bflo(vv.x); y[8 * c + 1] += w * bfhi(vv.x); y[8 * c + 2] += w * bflo(vv.y); y[8 * c + 3] += w * bfhi(vv.y);
                        y[8 * c + 4] += w * bflo(vv.z); y[8 * c + 5] += w * bfhi(vv.z); y[8 * c + 6] += w * bflo(vv.w); y[8 * c + 7] += w * bfhi(vv.w); }
                }
                const float gi = exp2f((float)(i + 1) * lg);
                for (int d = 0; d < 64; ++d) {
                    const float qd = Qs[i * 68 + d] * gi;
#pragma unroll
                    for (int c = 0; c < 8; ++c) { const f32x4 sv = *(const LAS f32x4*)(Ss + d * 128 + 32 * part + 4 * c); y[4 * c] += qd * sv.x; y[4 * c + 1] += qd * sv.y; y[4 * c + 2] += qd * sv.z; y[4 * c + 3] += qd * sv.w; }
                }
                float sum = 0.f;
#pragma unroll
                for (int e = 0; e < 32; ++e) sum += y[e];
                sum += __shfl_xor(sum, 1); sum += __shfl_xor(sum, 2);
                const float mu = sum * (1.f / 128.f); float var = 0.f;
#pragma unroll
                for (int e = 0; e < 32; ++e) { y[e] -= mu; var += y[e] * y[e]; }
                var += __shfl_xor(var, 1); var += __shfl_xor(var, 2);
                const float rstd = 1.0f / sqrtf(var * (1.f / 128.f) + EPS);
                const size_t t = tok0 + i;
                const bf16_t* gp = PA + t * PAW + C_RG + h * 128 + 32 * part;
                bf16_t* op = AR + t * ARW + 512 + h * 128 + 32 * part;
#pragma unroll
                for (int c = 0; c < 4; ++c) { float g[8]; ld8bf(gp + 8 * c, g);
                    u32x4 w; w.x = pk2(y[8 * c] * rstd * g[0], y[8 * c + 1] * rstd * g[1]); w.y = pk2(y[8 * c + 2] * rstd * g[2], y[8 * c + 3] * rstd * g[3]);
                    w.z = pk2(y[8 * c + 4] * rstd * g[4], y[8 * c + 5] * rstd * g[5]); w.w = pk2(y[8 * c + 6] * rstd * g[6], y[8 * c + 7] * rstd * g[7]);
                    *(u32x4*)(op + 8 * c) = w; }
            }
            __syncthreads();
            {
                const int d = tid >> 3, eg = tid & 7;
                const float cd = exp2f(128.f * lg);
                float a[16];
#pragma unroll
                for (int c = 0; c < 4; ++c) { const f32x4 sv = *(const LAS f32x4*)(Ss + d * 128 + 16 * eg + 4 * c); a[4 * c] = sv.x * cd; a[4 * c + 1] = sv.y * cd; a[4 * c + 2] = sv.z * cd; a[4 * c + 3] = sv.w * cd; }
                for (int j = 0; j < 128; ++j) {
                    const float kd = Ks[j * 68 + d] * 0.125f * exp2f((float)(127 - j) * lg);
#pragma unroll
                    for (int c = 0; c < 2; ++c) { const u32x4 vv = *(const LAS u32x4*)(Vs + j * 136 + 16 * eg + 8 * c);
                        a[8 * c] += kd * bflo(vv.x); a[8 * c + 1] += kd * bfhi(vv.x); a[8 * c + 2] += kd * bflo(vv.y); a[8 * c + 3] += kd * bfhi(vv.y);
                        a[8 * c + 4] += kd * bflo(vv.z); a[8 * c + 5] += kd * bfhi(vv.z); a[8 * c + 6] += kd * bflo(vv.w); a[8 * c + 7] += kd * bfhi(vv.w); }
                }
#pragma unroll
                for (int c = 0; c < 4; ++c) *(LAS f32x4*)(Ss + d * 128 + 16 * eg + 4 * c) = (f32x4){a[4 * c], a[4 * c + 1], a[4 * c + 2], a[4 * c + 3]};
            }
        }
    }
}

typedef float f32x16 __attribute__((ext_vector_type(16)));
typedef short s16x4 __attribute__((ext_vector_type(4)));
__device__ __forceinline__ int crow(int r, int hi) { return (r & 3) + 8 * (r >> 2) + 4 * hi; }
__device__ __forceinline__ s16x4 ds_tr16(const LAS unsigned char* p) { return __builtin_bit_cast(s16x4, __builtin_amdgcn_ds_read_tr16_b64_v4i16((LAS s16x4*)p)); }
__device__ __forceinline__ bf16x8 pack8(const f32x16& p, int b) {
    u32x4 w; w.x = cvt_pk_bf16(p[b], p[b + 1]); w.y = cvt_pk_bf16(p[b + 2], p[b + 3]); w.z = cvt_pk_bf16(p[b + 4], p[b + 5]); w.w = cvt_pk_bf16(p[b + 6], p[b + 7]);
    return __builtin_bit_cast(bf16x8, w);
}
constexpr int AT_K = 0, AT_V = 36864, AT_WS = AT_V + 32768, AT_OST = AT_WS + 8 * 128, AT_END = AT_OST + 8 * 4096;
static_assert(AT_END <= SCRATCH_BYTES, "attention LDS");
__device__ __forceinline__ void p2_attention_mfma(Frame& F, int u0, int ustride) {
    const bf16_t* PA = (const bf16_t*)(F.ws + WS_PA); bf16_t* AR = (bf16_t*)F.outb;
    LAS unsigned char* lds = F.lds;
    const int tid = F.tid, lane = F.lane, wid = F.wave, r32 = lane & 31, hi = lane >> 5;
    const int g = wid >> 1, qhalf = wid & 1;
    constexpr float LOG2E = 1.4426950408889634f;
    for (int unit = u0; unit < NB * 16 * 2; unit += ustride) {
        const int kvh = unit & 1, n = (unit >> 1) & 15, b = unit >> 5;
        const size_t tok0 = (size_t)b * SEQ + n * 128;
        __syncthreads();
#pragma unroll
        for (int it = 0; it < 4; ++it) {
            const int idx = tid + 512 * it, j = idx >> 3, c = idx & 7;
            u32x4 kv = (u32x4){0u, 0u, 0u, 0u}, vv = (u32x4){0u, 0u, 0u, 0u};
            if (n > 0 || j >= 128) { const bf16_t* rp = PA + (tok0 - 128 + j) * PAW; kv = *(const u32x4*)(rp + C_AK + kvh * 64 + c * 8); vv = *(const u32x4*)(rp + C_AV + kvh * 64 + c * 8); }
            *(LAS u32x4*)(lds + AT_K + j * 144 + c * 16) = kv;
            *(LAS u32x4*)(lds + AT_V + (c >> 2) * 16384 + (j >> 4) * 1024 + (j & 15) * 64 + (c & 3) * 16) = vv;
        }
        __syncthreads();
        const int hd = kvh * 4 + g;
        const float SL = exp2f(-(float)(hd + 1)) * LOG2E, SC = 0.125f * LOG2E, sink2 = F.sinks[hd] * LOG2E;
#pragma unroll 1
        for (int qb = 0; qb < 2; ++qb) {
            const int m = qhalf * 2 + qb, i0 = 32 * m;
            bf16x8 qr[4];
            { const bf16_t* qp = PA + (tok0 + i0 + r32) * PAW + C_AQ + hd * 64 + hi * 8;
#pragma unroll
              for (int s = 0; s < 4; ++s) qr[s] = *(const bf16x8*)(qp + 16 * s); }
            f32x16 p[5];
#pragma unroll
            for (int c = 0; c < 5; ++c) {
                const LAS unsigned char* kp = lds + AT_K + (32 * (m + c) + r32) * 144 + hi * 16;
                f32x16 a;
#pragma unroll
                for (int r = 0; r < 16; ++r) a[r] = 0.f;
#pragma unroll
                for (int s = 0; s < 4; ++s) a = __builtin_amdgcn_mfma_f32_32x32x16_bf16(*(const LAS bf16x8*)(kp + s * 32), qr[s], a, 0, 0, 0);
                p[c] = a;
            }
            const int iq = i0 + r32;
            float mx = sink2;
#pragma unroll
            for (int c = 0; c < 5; ++c)
#pragma unroll
                for (int r = 0; r < 16; ++r) {
                    const int j = 32 * (m + c) + crow(r, hi), dist = iq + 128 - j;
                    const bool valid = dist >= 0 && dist < 128 && (n > 0 || j >= 128);
                    const float t = valid ? p[c][r] * SC - SL * (float)dist : -1e30f;
                    p[c][r] = t; mx = fmaxf(mx, t);
                }
            mx = fmaxf(mx, __shfl_xor(mx, 32));
            float sum = 0.f;
#pragma unroll
            for (int c = 0; c < 5; ++c)
#pragma unroll
                for (int r = 0; r < 16; ++r) { const float e = __builtin_amdgcn_exp2f(p[c][r] - mx); p[c][r] = e; sum += e; }
            sum += __shfl_xor(sum, 32);
            const float den = sum + __builtin_amdgcn_exp2f(sink2 - mx);
            bf16x8 pa[5][2];
#pragma unroll
            for (int c = 0; c < 5; ++c) { pa[c][0] = pack8(p[c], 0); pa[c][1] = pack8(p[c], 8); }
            f32x16 o[2];
#pragma unroll
            for (int d0 = 0; d0 < 2; ++d0) {
                f32x16 a;
#pragma unroll
                for (int r = 0; r < 16; ++r) a[r] = 0.f;
#pragma unroll
                for (int c = 0; c < 5; ++c)
#pragma unroll
                    for (int s = 0; s < 2; ++s) {
                        const LAS unsigned char* vb = lds + AT_V + d0 * 16384 + (2 * (m + c) + s) * 1024 + ((lane >> 4) & 1) * 32 + (lane & 3) * 8 + (4 * hi + ((lane & 15) >> 2)) * 64;
                        const s16x4 lo = ds_tr16(vb), h4 = ds_tr16(vb + 512);
                        const bf16x8 vf = (bf16x8){lo[0], lo[1], lo[2], lo[3], h4[0], h4[1], h4[2], h4[3]};
                        a = __builtin_amdgcn_mfma_f32_32x32x16_bf16(pa[c][s], vf, a, 0, 0, 0);
                    }
                o[d0] = a;
            }
            LAS float* wsf = (LAS float*)(lds + AT_WS + wid * 128);
            asm volatile("s_waitcnt lgkmcnt(0)" ::: "memory");
            if (hi == 0) wsf[r32] = den;
            asm volatile("s_waitcnt lgkmcnt(0)" ::: "memory");
            float rinv[16];
#pragma unroll
            for (int r = 0; r < 16; ++r) rinv[r] = 1.0f / wsf[crow(r, hi)];
            LAS bf16_t* stg = (LAS bf16_t*)(lds + AT_OST + wid * 4096);
#pragma unroll
            for (int r = 0; r < 16; ++r)
#pragma unroll
                for (int d0 = 0; d0 < 2; ++d0) stg[crow(r, hi) * 64 + d0 * 32 + r32] = (bf16_t)f2bf(o[d0][r] * rinv[r]);
            asm volatile("s_waitcnt lgkmcnt(0)" ::: "memory");
#pragma unroll
            for (int it = 0; it < 4; ++it) { const int row = it * 8 + (lane >> 3), ch = lane & 7;
                const u32x4 v = *(const LAS u32x4*)(stg + row * 64 + ch * 8);
                *(u32x4*)(AR + (tok0 + i0 + row) * ARW + hd * 64 + ch * 8) = v; }
            asm volatile("s_waitcnt lgkmcnt(0)" ::: "memory");
        }
    }
}

constexpr int RT_KR = 0, RT_KT = 18432, RT_V = RT_KT + 16384, RT_ST = RT_V + 32768, RT_RED = RT_ST + 18432, RT_OST = RT_RED + 2048, RT_END = RT_OST + 8 * 4608;
static_assert(RT_END <= SCRATCH_BYTES, "retention LDS");
__device__ __forceinline__ u32x4 scale8bf(u32x4 w, float s) {
    u32x4 o; o.x = pk2(bflo(w.x) * s, bfhi(w.x) * s); o.y = pk2(bflo(w.y) * s, bfhi(w.y) * s); o.z = pk2(bflo(w.z) * s, bfhi(w.z) * s); o.w = pk2(bflo(w.w) * s, bfhi(w.w) * s); return o;
}
__device__ __forceinline__ bf16x8 tr_frag(const LAS unsigned char* p) {
    const s16x4 lo = ds_tr16(p), h4 = ds_tr16(p + 512);
    return (bf16x8){lo[0], lo[1], lo[2], lo[3], h4[0], h4[1], h4[2], h4[3]};
}
__device__ __forceinline__ void p2_retention_mfma(Frame& F, int u0, int ustride) {
    const bf16_t* PA = (const bf16_t*)(F.ws + WS_PA); bf16_t* AR = (bf16_t*)F.outb;
    LAS unsigned char* lds = F.lds;
    const int tid = F.tid, lane = F.lane, wid = F.wave, r32 = lane & 31, hi = lane >> 5;
    const int ib = wid >> 1, eh = wid & 1;
    const int sdb = wid & 1, seb = wid >> 1;
    const int troff = ((lane >> 4) & 1) * 32 + (lane & 3) * 8 + (4 * hi + ((lane & 15) >> 2)) * 64;
    for (int unit = u0; unit < NB * 8; unit += ustride) {
        const int h = unit & 7, b = unit >> 3;
        const float lg = log2f(1.0f - exp2f(-5.0f - (float)h));
        const float fac_i = exp2f((float)(32 * ib + r32 - 127) * lg), gi1 = exp2f((float)(32 * ib + r32 + 1) * lg), cd = exp2f(128.0f * lg);
        f32x16 st;
#pragma unroll
        for (int r = 0; r < 16; ++r) st[r] = 0.f;
        __syncthreads();
        for (int idx = tid; idx < 18432 / 4; idx += 512) ((LAS unsigned*)(lds + RT_ST))[idx] = 0u;
        u32x4 kreg[2], vreg[4]; bf16x8 qn[4];
        {
            const size_t tok0 = (size_t)b * SEQ;
#pragma unroll
            for (int it = 0; it < 2; ++it) { const int idx = tid + 512 * it, j = idx >> 3, c = idx & 7; kreg[it] = *(const u32x4*)(PA + (tok0 + j) * PAW + C_RK + h * 64 + c * 8); }
#pragma unroll
            for (int it = 0; it < 4; ++it) { const int idx = tid + 512 * it, j = idx >> 4, c = idx & 15; vreg[it] = *(const u32x4*)(PA + (tok0 + j) * PAW + C_RV + h * 128 + c * 8); }
            const bf16_t* qp = PA + (tok0 + 32 * ib + r32) * PAW + C_RQ + h * 64 + hi * 8;
#pragma unroll
            for (int s = 0; s < 4; ++s) qn[s] = *(const bf16x8*)(qp + 16 * s);
        }
#pragma unroll 1
        for (int n = 0; n < 16; ++n) {
            const size_t tok0 = (size_t)b * SEQ + n * 128;
#pragma unroll
            for (int it = 0; it < 2; ++it) { const int idx = tid + 512 * it, j = idx >> 3, c = idx & 7;
                const u32x4 kk = scale8bf(kreg[it], 0.125f * exp2f((float)(127 - j) * lg));
                *(LAS u32x4*)(lds + RT_KR + j * 144 + c * 16) = kk;
                *(LAS u32x4*)(lds + RT_KT + (c >> 2) * 8192 + (j >> 4) * 1024 + (j & 15) * 64 + (c & 3) * 16) = kk; }
#pragma unroll
            for (int it = 0; it < 4; ++it) { const int idx = tid + 512 * it, j = idx >> 4, c = idx & 15;
                *(LAS u32x4*)(lds + RT_V + (c >> 2) * 8192 + (j >> 4) * 1024 + (j & 15) * 64 + (c & 3) * 16) = vreg[it]; }
            __syncthreads();
            bf16x8 pb[4][2];
#pragma unroll
            for (int jb = 0; jb < 4; ++jb) {
                if (jb <= ib) {
                    const LAS unsigned char* kp = lds + RT_KR + (32 * jb + r32) * 144 + hi * 16;
                    f32x16 a;
#pragma unroll
                    for (int r = 0; r < 16; ++r) a[r] = 0.f;
#pragma unroll
                    for (int s = 0; s < 4; ++s) a = __builtin_amdgcn_mfma_f32_32x32x16_bf16(*(const LAS bf16x8*)(kp + s * 32), qn[s], a, 0, 0, 0);
                    const bool diag = (jb == ib);
#pragma unroll
                    for (int r = 0; r < 16; ++r) a[r] = (!diag || crow(r, hi) <= r32) ? a[r] * fac_i : 0.f;
                    pb[jb][0] = pack8(a, 0); pb[jb][1] = pack8(a, 8);
                    asm volatile("" ::: "memory");
                } else { pb[jb][0] = (bf16x8){0, 0, 0, 0, 0, 0, 0, 0}; pb[jb][1] = (bf16x8){0, 0, 0, 0, 0, 0, 0, 0}; }
            }
            f32x16 y[2];
#pragma unroll
            for (int t = 0; t < 2; ++t) {
                const int eb = 2 * eh + t;
                const LAS unsigned char* sp = lds + RT_ST + (32 * eb + r32) * 144 + hi * 16;
                f32x16 a;
#pragma unroll
                for (int r = 0; r < 16; ++r) a[r] = 0.f;
#pragma unroll
                for (int s = 0; s < 4; ++s) a = __builtin_amdgcn_mfma_f32_32x32x16_bf16(*(const LAS bf16x8*)(sp + s * 32), qn[s], a, 0, 0, 0);
#pragma unroll
                for (int r = 0; r < 16; ++r) a[r] *= gi1;
#pragma unroll
                for (int jb = 0; jb < 4; ++jb) {
                    if (jb <= ib) {
#pragma unroll
                        for (int s2 = 0; s2 < 2; ++s2) {
                            const bf16x8 vf = tr_frag(lds + RT_V + eb * 8192 + (2 * jb + s2) * 1024 + troff);
                            a = __builtin_amdgcn_mfma_f32_32x32x16_bf16(vf, pb[jb][s2], a, 0, 0, 0);
                        }
                        asm volatile("" ::: "memory");
                    }
                }
                y[t] = a;
            }
            if (n < 15) {
                const size_t tokn = tok0 + 128;
#pragma unroll
                for (int it = 0; it < 2; ++it) { const int idx = tid + 512 * it, j = idx >> 3, c = idx & 7; kreg[it] = *(const u32x4*)(PA + (tokn + j) * PAW + C_RK + h * 64 + c * 8); }
#pragma unroll
                for (int it = 0; it < 4; ++it) { const int idx = tid + 512 * it, j = idx >> 4, c = idx & 15; vreg[it] = *(const u32x4*)(PA + (tokn + j) * PAW + C_RV + h * 128 + c * 8); }
                const bf16_t* qp = PA + (tokn + 32 * ib + r32) * PAW + C_RQ + h * 64 + hi * 8;
#pragma unroll
                for (int s = 0; s < 4; ++s) qn[s] = *(const bf16x8*)(qp + 16 * s);
            }
            float s1 = 0.f, s2 = 0.f;
#pragma unroll
            for (int t = 0; t < 2; ++t)
#pragma unroll
                for (int r = 0; r < 16; ++r) { s1 += y[t][r]; s2 += y[t][r] * y[t][r]; }
            s1 += __shfl_xor(s1, 32); s2 += __shfl_xor(s2, 32);
            if (hi == 0) *(LAS f32x2*)(lds + RT_RED + (wid * 32 + r32) * 8) = (f32x2){s1, s2};
#pragma unroll
            for (int r = 0; r < 16; ++r) st[r] *= cd;
#pragma unroll
            for (int sp = 0; sp < 8; ++sp) {
                const bf16x8 kf = tr_frag(lds + RT_KT + sdb * 8192 + sp * 1024 + troff);
                const bf16x8 vf = tr_frag(lds + RT_V + seb * 8192 + sp * 1024 + troff);
                st = __builtin_amdgcn_mfma_f32_32x32x16_bf16(kf, vf, st, 0, 0, 0);
                if (sp & 1) asm volatile("" ::: "memory");
            }
            __syncthreads();
            {
                const f32x2 o = *(const LAS f32x2*)(lds + RT_RED + ((wid ^ 1) * 32 + r32) * 8);
                const float mu = (s1 + o.x) * (1.f / 128.f), var = (s2 + o.y) * (1.f / 128.f) - mu * mu, rstd = 1.0f / sqrtf(fmaxf(var, 0.f) + EPS);
                LAS unsigned char* stg = lds + RT_OST + wid * 4608;
#pragma unroll
                for (int t = 0; t < 2; ++t)
#pragma unroll
                    for (int gq = 0; gq < 4; ++gq) {
                        u32x2 w; w.x = cvt_pk_bf16((y[t][4 * gq] - mu) * rstd, (y[t][4 * gq + 1] - mu) * rstd); w.y = cvt_pk_bf16((y[t][4 * gq + 2] - mu) * rstd, (y[t][4 * gq + 3] - mu) * rstd);
                        *(LAS u32x2*)(stg + r32 * 144 + (32 * t + 8 * gq + 4 * hi) * 2) = w; }
#pragma unroll
                for (int gq = 0; gq < 4; ++gq) {
                    u32x2 w; w.x = cvt_pk_bf16(st[4 * gq], st[4 * gq + 1]); w.y = cvt_pk_bf16(st[4 * gq + 2], st[4 * gq + 3]);
                    *(LAS u32x2*)(lds + RT_ST + (32 * seb + r32) * 144 + (32 * sdb + 8 * gq + 4 * hi) * 2) = w; }
                asm volatile("s_waitcnt lgkmcnt(0)" ::: "memory");
#pragma unroll
                for (int it = 0; it < 4; ++it) { const int row = it * 8 + (lane >> 3), ch = lane & 7;
                    const u32x4 v = *(const LAS u32x4*)(stg + row * 144 + ch * 16);
                    const size_t t = tok0 + 32 * ib + row;
                    const u32x4 gt = *(const u32x4*)(PA + t * PAW + C_RG + h * 128 + 64 * eh + 8 * ch);
                    u32x4 w; w.x = pk2(bflo(v.x) * bflo(gt.x), bfhi(v.x) * bfhi(gt.x)); w.y = pk2(bflo(v.y) * bflo(gt.y), bfhi(v.y) * bfhi(gt.y));
                    w.z = pk2(bflo(v.z) * bflo(gt.z), bfhi(v.z) * bfhi(gt.z)); w.w = pk2(bflo(v.w) * bflo(gt.w), bfhi(v.w) * bfhi(gt.w));
                    *(u32x4*)(AR + t * ARW + 512 + h * 128 + 64 * eh + 8 * ch) = w; }
                asm volatile("s_waitcnt lgkmcnt(0)" ::: "memory");
            }
        }
    }
}

struct TokRec { int e0, r0; float w0; int e1, r1; float w1; int pad0, pad1; };
__device__ __forceinline__ void p5_router(Frame& F) {
    LAS float* W = (LAS float*)F.lds;
    for (int idx = F.tid; idx < 1024 * 36; idx += 512) {
        const int k = idx / 36, c = idx - k * 36;
        const float v = c < 4 ? F.w_gr[k * 4 + c] : F.w_er[k * 32 + (c - 4)];
        const int rho = ((k & 3) + 4 * (k >> 8)) * 64 + ((k >> 2) & 63);
        W[rho * 36 + c] = v;
    }
    __syncthreads();
    const float* X2 = (const float*)F.outb; bf16_t* H2 = (bf16_t*)(F.ws + WS_H2); TokRec* TK = (TokRec*)(F.ws + WS_TOK);
    unsigned* cnt = F.ctl + CW_CNT;
    const int gw = F.vcu * NWAVES + F.wave, NGW = F.G * NWAVES, lane = F.lane;
    f32x4 gv[4];
#pragma unroll
    for (int j = 0; j < 4; ++j) gv[j] = ((const GAS f32x4*)F.g2)[lane + 64 * j];
    for (int p = gw; p < T / 2; p += NGW) {
        f32x4 xv[2][4]; float rstd[2];
#pragma unroll
        for (int tk = 0; tk < 2; ++tk) {
            const size_t t = (size_t)(2 * p + tk);
            const GAS f32x4* xr = (const GAS f32x4*)(X2 + t * DM) + lane; float s = 0.f;
#pragma unroll
            for (int j = 0; j < 4; ++j) { const f32x4 v = xr[64 * j]; xv[tk][j] = v; s += (v.x * v.x + v.y * v.y) + (v.z * v.z + v.w * v.w); }
            rstd[tk] = 1.0f / sqrtf(wave_sum(s) * (1.f / DM) + EPS);
            GAS u32x2* o8 = (GAS u32x2*)(H2 + t * DM) + lane;
#pragma unroll
            for (int j = 0; j < 4; ++j) { xv[tk][j] = xv[tk][j] * gv[j]; const f32x4 hv = xv[tk][j] * rstd[tk]; u32x2 w; w.x = pk2(hv.x, hv.y); w.y = pk2(hv.z, hv.w); o8[64 * j] = w; }
        }
        float acc[2][36];
#pragma unroll
        for (int c = 0; c < 36; ++c) { acc[0][c] = 0.f; acc[1][c] = 0.f; }
#pragma unroll
        for (int j = 0; j < 4; ++j)
#pragma unroll
            for (int i = 0; i < 4; ++i) {
                const LAS f32x4* wp = (const LAS f32x4*)(W + ((i + 4 * j) * 64 + lane) * 36);
                const float x0 = xv[0][j][i], x1 = xv[1][j][i];
#pragma unroll
                for (int c = 0; c < 9; ++c) { const f32x4 w = wp[c];
                    acc[0][4 * c] += x0 * w.x; acc[0][4 * c + 1] += x0 * w.y; acc[0][4 * c + 2] += x0 * w.z; acc[0][4 * c + 3] += x0 * w.w;
                    acc[1][4 * c] += x1 * w.x; acc[1][4 * c + 1] += x1 * w.y; acc[1][4 * c + 2] += x1 * w.z; acc[1][4 * c + 3] += x1 * w.w; }
                asm volatile("" ::: "memory");
            }
        float a[36];
#pragma unroll
        for (int c = 0; c < 36; ++c) { const float s0 = wave_sum(acc[0][c]), s1 = wave_sum(acc[1][c]); a[c] = (lane == 1) ? s1 * rstd[1] : s0 * rstd[0]; }
        if (lane < 2) {
            const int t = 2 * p + lane;
            float gl[4];
#pragma unroll
            for (int c = 0; c < 4; ++c) gl[c] = a[c] + F.b_gr[c];
            int g = 0; float gm = gl[0];
#pragma unroll
            for (int c = 1; c < 4; ++c) if (gl[c] > gm) { gm = gl[c]; g = c; }
            float gs = 0.f;
#pragma unroll
            for (int c = 0; c < 4; ++c) gs += __expf(gl[c] - gm);
            const float gprob = 1.0f / gs;
            float el[8];
#pragma unroll
            for (int i = 0; i < 8; ++i) el[i] = (g == 0 ? a[4 + i] : g == 1 ? a[12 + i] : g == 2 ? a[20 + i] : a[28 + i]) + F.b_er[g * 8 + i];
            int i0 = 0; float v0 = el[0];
#pragma unroll
            for (int i = 1; i < 8; ++i) if (el[i] > v0) { v0 = el[i]; i0 = i; }
            int i1 = -1; float v1 = -3.0e38f;
#pragma unroll
            for (int i = 0; i < 8; ++i) if (i != i0 && el[i] > v1) { v1 = el[i]; i1 = i; }
            const float ex = __expf(v1 - v0), w0 = gprob / (1.0f + ex), w1 = gprob * ex / (1.0f + ex);
            const int e0 = g * 8 + i0, e1 = g * 8 + i1;
            const int r0 = (int)atomicAdd(cnt + e0, 1u), r1 = (int)atomicAdd(cnt + e1, 1u);
            TokRec rec; rec.e0 = e0; rec.r0 = r0; rec.w0 = w0; rec.e1 = e1; rec.r1 = r1; rec.w1 = w1; rec.pad0 = 0; rec.pad1 = 0;
            TK[t] = rec;
        }
    }
}
__device__ __forceinline__ int expert_base_lane(Frame& F, int& total_tiles) {
    const int lane = F.lane;
    const unsigned c = (lane < NEXP) ? __hip_atomic_load(F.ctl + CW_CNT + lane, __ATOMIC_RELAXED, __HIP_MEMORY_SCOPE_AGENT) : 0u;
    const int pad = (int)((c + 255u) & ~255u);
    int incl = pad;
#pragma unroll
    for (int o = 1; o < 32; o <<= 1) { const int v = __shfl_up(incl, o); if ((lane & 31) >= o) incl += v; }
    total_tiles = __shfl(incl, 31) >> 8;
    return incl - pad;
}
__device__ __forceinline__ void p6_gather(Frame& F) {
    int ntl; const int basev = expert_base_lane(F, ntl);
    const bf16_t* H2 = (const bf16_t*)(F.ws + WS_H2); bf16_t* XG = (bf16_t*)(F.ws + WS_XG); const TokRec* TK = (const TokRec*)(F.ws + WS_TOK);
    const int gw = F.vcu * NWAVES + F.wave, NGW = F.G * NWAVES, lane = F.lane;
    for (int t = gw; t < T; t += NGW) {
        const TokRec rec = TK[t];
        const int s0 = __shfl(basev, rec.e0) + rec.r0, s1 = __shfl(basev, rec.e1) + rec.r1;
        const GAS u32x4* src = (const GAS u32x4*)(H2 + (size_t)t * DM) + lane;
        const u32x4 v0 = src[0], v1 = src[64];
        GAS u32x4* d0 = (GAS u32x4*)(XG + (size_t)s0 * DM) + lane; GAS u32x4* d1 = (GAS u32x4*)(XG + (size_t)s1 * DM) + lane;
        d0[0] = v0; d0[64] = v1; d1[0] = v0; d1[64] = v1;
    }
}
__device__ __forceinline__ int expert_tiles_to_lds(Frame& F) {
    int ntl; const int basev = expert_base_lane(F, ntl);
    __syncthreads();
    if (F.wave == 0 && F.lane < NEXP) F.MISC[16 + F.lane] = (unsigned)(basev >> 8);
    __syncthreads();
    return ntl;
}
__device__ __forceinline__ void p9_combine(Frame& F) {
    int ntl; const int basev = expert_base_lane(F, ntl);
    float* X2 = (float*)F.outb; const bf16_t* YB = (const bf16_t*)(F.ws + WS_YB); const TokRec* TK = (const TokRec*)(F.ws + WS_TOK);
    const int gw = F.vcu * NWAVES + F.wave, NGW = F.G * NWAVES, lane = F.lane;
    f32x4 gv[4];
#pragma unroll
    for (int j = 0; j < 4; ++j) gv[j] = ((const GAS f32x4*)F.gf)[lane + 64 * j];
    for (int t = gw; t < T; t += NGW) {
        const TokRec rec = TK[t];
        const int s0 = __shfl(basev, rec.e0) + rec.r0, s1 = __shfl(basev, rec.e1) + rec.r1;
        GAS f32x4* xr = (GAS f32x4*)(X2 + (size_t)t * DM) + lane;
        const GAS u32x2* y0 = (const GAS u32x2*)(YB + (size_t)s0 * DM) + lane; const GAS u32x2* y1 = (const GAS u32x2*)(YB + (size_t)s1 * DM) + lane;
        f32x4 v[4]; float s = 0.f;
#pragma unroll
        for (int j = 0; j < 4; ++j) { const f32x4 xv = xr[64 * j]; const u32x2 a = y0[64 * j], b = y1[64 * j];
            f32x4 r;
            r.x = xv.x + rec.w0 * bflo(a.x) + rec.w1 * bflo(b.x); r.y = xv.y + rec.w0 * bfhi(a.x) + rec.w1 * bfhi(b.x);
            r.z = xv.z + rec.w0 * bflo(a.y) + rec.w1 * bflo(b.y); r.w = xv.w + rec.w0 * bfhi(a.y) + rec.w1 * bfhi(b.y);
            v[j] = r; s += (r.x * r.x + r.y * r.y) + (r.z * r.z + r.w * r.w); }
        const float rstd = 1.0f / sqrtf(wave_sum(s) * (1.f / DM) + EPS);
#pragma unroll
        for (int j = 0; j < 4; ++j) xr[64 * j] = v[j] * rstd * gv[j];
    }
}

constexpr int NPHASE = 10;
struct Args { const float* in[17]; float* out; unsigned char* ws; int ph_lo, ph_hi, use_cg, pad; };
__global__ void __launch_bounds__(NWAVES * 64, 2) hybrid_fwd(Args args) {
    extern __shared__ __attribute__((aligned(16))) unsigned char lds[];
    Frame F;
    F.lds = (LAS unsigned char*)lds;
    F.MISC = (volatile LAS unsigned*)(F.lds + MISC_OFF);
    F.tid = threadIdx.x; F.lane = F.tid & 63; F.wave = __builtin_amdgcn_readfirstlane(F.tid >> 6);
    F.G = gridDim.x; { const int bx = blockIdx.x; F.vcu = (F.G % 8 == 0) ? (bx % 8) * (F.G / 8) + bx / 8 : bx; }
    F.ws = args.ws; F.outb = (unsigned char*)args.out; F.ctl = (unsigned*)(args.ws + WS_CTL);
    F.x = args.in[0]; F.g1 = args.in[1]; F.w_in = args.in[2]; F.b_in = args.in[3]; F.sinks = args.in[4]; F.w_au = args.in[5]; F.w_ru = args.in[6]; F.w_out = args.in[7];
    F.g2 = args.in[8]; F.w_gr = args.in[9]; F.b_gr = args.in[10]; F.w_er = args.in[11]; F.b_er = args.in[12]; F.w_ge = args.in[13]; F.w_ue = args.in[14]; F.w_de = args.in[15]; F.gf = args.in[16];
    for (int u = F.tid; u < (LDS_BYTES - MISC_OFF) / 4; u += NWAVES * 64) ((LAS unsigned*)(F.lds + MISC_OFF))[u] = 0u;
    __syncthreads();
    const int lo = args.ph_lo, hi = args.ph_hi;
    const bool multi = (hi - lo) > 1;
    XcdBarrier bar; bar.bar = F.ctl + CW_BAR; bar.x = 0; bar.st = nullptr;
    if (multi) bar = xcd_barrier_post(F.ctl + CW_BAR, F.MISC + 8);
    if (args.use_cg == 12345) cg::this_grid().sync();
#define IN(k) (lo <= (k) && (k) < hi)
#define SEAM(k) do { if (IN(k) && IN((k) + 1)) xcd_barrier(bar); } while (0)

#define REP(k) ((PROBE_REP >> (k)) & 1)
#define P1_BODY { DenseOrder S; S.A = (const char*)F.outb; S.Bt = (const char*)(F.ws + WS_WIN); S.nM = T / 256; S.nN = INW / 256; S.nwg = S.nM * S.nN; S.G = F.G; S.c = (int)blockIdx.x; S.ld = DM; S.nt = 16; \
        EpiProj E{(bf16_t*)(F.ws + WS_PA), (bf16_t*)(F.ws + WS_GT), F.b_in}; pg8::gemm_phase<EpiProj, DenseOrder>(F.lds, DM, S, E); }
#define P2_BODY { if (F.G >= 256) { if (F.vcu < 128) p2_retention_mfma(F, F.vcu, 128); else p2_attention_mfma(F, F.vcu - 128, F.G - 128); } \
        else { p2_retention_mfma(F, F.vcu, F.G); p2_attention_mfma(F, F.vcu, F.G); } }
#define P3_BODY { UpOrder S; S.d.A = (const char*)F.outb; S.d.Bt = (const char*)(F.ws + WS_WUP); S.d.nM = T / 256; S.d.nN = 4; S.d.nwg = S.d.nM * 4; S.d.G = F.G; S.d.c = (int)blockIdx.x; S.d.ld = ARW; S.d.nt = 0; \
        EpiUp E{(bf16_t*)(F.ws + WS_MIX), (const bf16_t*)(F.ws + WS_GT)}; pg8::gemm_phase<EpiUp, UpOrder>(F.lds, ARW, S, E); }
#define P4_BODY { DenseOrder S; S.A = (const char*)(F.ws + WS_MIX); S.Bt = (const char*)(F.ws + WS_WOUT); S.nM = T / 256; S.nN = 4; S.nwg = S.nM * 4; S.G = F.G; S.c = (int)blockIdx.x; S.ld = DM; S.nt = 16; \
        EpiOut E{F.x, (float*)F.outb}; pg8::gemm_phase<EpiOut, DenseOrder>(F.lds, DM, S, E); }
#define P7_BODY { const int ntl = expert_tiles_to_lds(F); \
        ExpertOrder S; S.A = (const char*)(F.ws + WS_XG); S.Bt = (const char*)(F.ws + WS_WGU); S.tp = (const volatile LAS int*)(F.MISC + 16); S.ntiles = ntl; S.G = F.G; S.c = (int)blockIdx.x; S.ldA = DM; S.nt = 16; \
        S.bstride = (size_t)1024 * 1024 * 2; S.bpn = (size_t)256 * 1024 * 2; EpiSwiglu E{(bf16_t*)(F.ws + WS_ACT)}; pg8::gemm_phase<EpiSwiglu, ExpertOrder>(F.lds, DM, S, E); }
#define P8_BODY { const int ntl = expert_tiles_to_lds(F); \
        ExpertOrder S; S.A = (const char*)(F.ws + WS_ACT); S.Bt = (const char*)(F.ws + WS_WD); S.tp = (const volatile LAS int*)(F.MISC + 16); S.ntiles = ntl; S.G = F.G; S.c = (int)blockIdx.x; S.ldA = DEXP; S.nt = 8; \
        S.bstride = (size_t)1024 * 512 * 2; S.bpn = (size_t)256 * 512 * 2; EpiDown E{(bf16_t*)(F.ws + WS_YB)}; pg8::gemm_phase<EpiDown, ExpertOrder>(F.lds, DEXP, S, E); }
#define RUN(k, BODY) do { if (IN(k)) { BODY; if (REP(k)) { xcd_barrier(bar); BODY; } } SEAM(k); } while (0)
    RUN(0, p0_prologue(F));
    RUN(1, P1_BODY);
#if (PROBE_REP & 0x1000)
    if (IN(2)) { if (F.vcu < 128) { p2_retention_mfma(F, F.vcu, 128); p2_retention_mfma(F, F.vcu, 128); } else p2_attention_mfma(F, F.vcu - 128, F.G - 128); } SEAM(2);
#elif (PROBE_REP & 0x2000)
    if (IN(2)) { if (F.vcu < 128) p2_retention_mfma(F, F.vcu, 128); else { p2_attention_mfma(F, F.vcu - 128, F.G - 128); p2_attention_mfma(F, F.vcu - 128, F.G - 128); } } SEAM(2);
#else
    RUN(2, P2_BODY);
#endif
    RUN(3, P3_BODY);
    RUN(4, P4_BODY);
    if (IN(5)) { p5_router(F);
        if (REP(5)) { xcd_barrier(bar); if (blockIdx.x == 0 && F.tid < NEXP) __hip_atomic_store(F.ctl + CW_CNT + F.tid, 0u, __ATOMIC_RELAXED, __HIP_MEMORY_SCOPE_AGENT); xcd_barrier(bar); p5_router(F); } } SEAM(5);
    RUN(6, p6_gather(F));
    RUN(7, P7_BODY);
    RUN(8, P8_BODY);
    if (IN(9)) { p9_combine(F); }
#undef IN
#undef SEAM
}

extern "C" void kernel_launch(void* const* d_in, const int* in_sizes, int n_in, void* d_out, int out_size, void* d_ws, size_t ws_size, hipStream_t stream) {
    static int grid = 0;
    if (grid == 0) {
        if (n_in != 17 || in_sizes[0] != T * DM || out_size != T * DM || ws_size < WS_END) {
            fprintf(stderr, "kernel_launch: unexpected shapes (n_in %d, in0 %d, out %d, ws %zu); nothing launched\n", n_in, n_in > 0 ? in_sizes[0] : -1, out_size, ws_size); grid = -1; return; }
        int dev = 0, cus = 0, per_cu = 0;
        if (hipGetDevice(&dev) != hipSuccess || hipDeviceGetAttribute(&cus, hipDeviceAttributeMultiprocessorCount, dev) != hipSuccess) { grid = -1; return; }
        if (hipFuncSetAttribute((const void*)hybrid_fwd, hipFuncAttributeMaxDynamicSharedMemorySize, LDS_BYTES) != hipSuccess) { fprintf(stderr, "kernel_launch: hipFuncSetAttribute failed\n"); grid = -1; return; }
        if (hipOccupancyMaxActiveBlocksPerMultiprocessor(&per_cu, (const void*)hybrid_fwd, NWAVES * 64, LDS_BYTES) != hipSuccess || per_cu < 1) { fprintf(stderr, "kernel_launch: occupancy query says %d blocks per CU\n", per_cu); grid = -1; (void)hipGetLastError(); return; }
        grid = cus;
    }
    if (grid < 0) return;
    if (hipMemsetAsync((char*)d_ws + WS_CTL, 0, CTL_ZERO_BYTES, stream) != hipSuccess) return;
    Args a{};
    for (int i = 0; i < 17; ++i) a.in[i] = (const float*)d_in[i];
    a.out = (float*)d_out; a.ws = (unsigned char*)d_ws; a.use_cg = 0; a.pad = 0;
    constexpr int NL = MK_N_LAUNCHES;
    if (NL == 1) {
        a.ph_lo = 0; a.ph_hi = NPHASE;
        void* kargs[] = {&a};
        hipError_t e = hipLaunchCooperativeKernel((const void*)hybrid_fwd, dim3(grid), dim3(NWAVES * 64), kargs, LDS_BYTES, stream);
        if (e != hipSuccess) fprintf(stderr, "kernel_launch: cooperative launch failed: %s (grid %d)\n", hipGetErrorString(e), grid);
    } else {
        for (int li = 0; li < NPHASE; ++li) {
            a.ph_lo = li; a.ph_hi = li + 1;
            hipLaunchKernelGGL(hybrid_fwd, dim3(grid), dim3(NWAVES * 64), LDS_BYTES, stream, a);
        }
    }
}
```

```cpp
#include <hip/hip_runtime.h>
#include <hip/hip_cooperative_groups.h>
#include <cstdio>
#include <cstdint>
namespace cg = cooperative_groups;

#ifndef PROBE_REP
#define PROBE_REP 0
#endif
#ifndef MK_N_LAUNCHES
#define MK_N_LAUNCHES 1
#endif

#define LAS __attribute__((address_space(3)))
#define GAS __attribute__((address_space(1)))
typedef unsigned short bf16_t;
typedef short bf16x8 __attribute__((ext_vector_type(8)));
typedef float f32x4 __attribute__((ext_vector_type(4)));
typedef float f32x2 __attribute__((ext_vector_type(2)));
typedef unsigned u32x4 __attribute__((ext_vector_type(4)));
typedef unsigned u32x2 __attribute__((ext_vector_type(2)));

constexpr int DM = 1024, NB = 16, SEQ = 2048, T = NB * SEQ;
constexpr int INW = 5888, PAW = 3840, GTW = 2048;
constexpr int C_AQ = 0, C_AK = 512, C_AV = 640, C_RQ = 768, C_RK = 1280, C_RV = 1792, C_RG = 2816;
constexpr int ARW = 1536;
constexpr int NEXP = 32, DEXP = 512;
constexpr int PSLOT = 65536 + 8192;
constexpr float EPS = 1e-6f;

constexpr size_t MiB = 1u << 20;
constexpr size_t WS_CTL = 0, CTL_ZERO_BYTES = 1 * MiB;
constexpr size_t WS_WIN = 2 * MiB;
constexpr size_t WS_WUP = 14 * MiB;
constexpr size_t WS_WOUT = 17 * MiB;
constexpr size_t WS_WGU = 20 * MiB;
constexpr size_t WS_WD = 84 * MiB;
constexpr size_t WS_PA = 116 * MiB;
constexpr size_t WS_GT = 356 * MiB;
constexpr size_t WS_TOK = 484 * MiB;
constexpr size_t WS_CNTG = 485 * MiB;
constexpr size_t WS_END = 486 * MiB;
constexpr size_t WS_MIX = 116 * MiB;
constexpr size_t WS_H2 = 180 * MiB;
constexpr size_t WS_XG = 244 * MiB;
constexpr size_t WS_ACT = 388 * MiB;
constexpr size_t WS_YB = 116 * MiB;
constexpr int CW_CNT = 1024;
constexpr int CW_BAR = 4096;

constexpr int RING_BYTES = 131072;
constexpr int SCRATCH_BYTES = 147456;
constexpr int MISC_OFF = SCRATCH_BYTES;
constexpr int LDS_BYTES = SCRATCH_BYTES + 1024;

__device__ __forceinline__ unsigned f2bf(float f) { unsigned u = __builtin_bit_cast(unsigned, f); return (u + 0x7fffu + ((u >> 16) & 1u)) >> 16; }
__device__ __forceinline__ unsigned pk2(float lo, float hi) { return f2bf(lo) | (f2bf(hi) << 16); }
__device__ __forceinline__ float bflo(unsigned w) { return __builtin_bit_cast(float, w << 16); }
__device__ __forceinline__ float bfhi(unsigned w) { return __builtin_bit_cast(float, w & 0xffff0000u); }
__device__ __forceinline__ float bf2f(bf16_t b) { return __builtin_bit_cast(float, (unsigned)b << 16); }
__device__ __forceinline__ unsigned cvt_pk_bf16(float lo, float hi) { unsigned r; asm volatile("v_cvt_pk_bf16_f32 %0, %1, %2" : "=v"(r) : "v"(lo), "v"(hi)); return r; }
__device__ __forceinline__ float sigmoidf_(float v) { return 1.0f / (1.0f + __expf(-v)); }
__device__ __forceinline__ float wave_sum(float v) {
#pragma unroll
    for (int o = 1; o < 64; o <<= 1) v += __shfl_xor(v, o);
    return v;
}
#define LDS_WAIT() asm volatile("s_waitcnt lgkmcnt(0)" ::: "memory")
#define VM_WAIT() asm volatile("s_waitcnt vmcnt(0)" ::: "memory")

namespace pg8 {
constexpr int BM = 256, BK = 64, HALF = 128, HTB = HALF * BK * 2, STAGE_BYTES = 8 * HTB;
__host__ __device__ __forceinline__ int lds_byte(int r, int c) { const int st = (r >> 4) * 2 + (c >> 5), rr = r & 15, cc = c & 31, ob = rr * 64 + cc * 2; return st * 1024 + (ob ^ (((ob >> 9) & 1) << 5)); }
__host__ __device__ __forceinline__ void stage_rc(int b, int& R, int& C) { const int st = b / 1024, sb = b % 1024, swz = sb ^ (((sb >> 9) & 1) << 5); R = (st >> 1) * 16 + swz / 64; C = (st & 1) * 32 + (swz % 64) / 2; }
__host__ __device__ __forceinline__ int perm32(int rho) { const int n = rho >> 4, i = rho & 15; return 8 * (i >> 2) + 4 * n + (i & 3); }

struct Unit { const char* a; const char* b; int pm, pn, nt, aux; };

template <class Epi, class Sched>
__device__ __forceinline__ void gemm_phase(LAS unsigned char* lds, const int ld  , const Sched& S, const Epi& E) {
    const int tid = threadIdx.x, wid = __builtin_amdgcn_readfirstlane(tid >> 6), lane = tid & 63, wr = wid >> 2, wc = wid & 3, fr = lane & 15, fq = lane >> 4;
    unsigned voffA[2], voffB[2];
#pragma unroll
    for (int i = 0; i < 2; ++i) { int R, C; stage_rc(tid * 16 + i * 8192, R, C); const int Rb = Epi::PERM ? ((R & ~31) + perm32(R & 31)) : R;
        voffA[i] = (unsigned)(R * ld + C) * 2u; voffB[i] = (unsigned)(Rb * ld + C) * 2u; }
    const size_t kstep = (size_t)(BK * 2);
    const size_t hstep = (size_t)HALF * ld * 2;
    const unsigned ldsw = (unsigned)wid * 1024u;
    const int aoff = lds_byte(wr * 64 + fr, fq * 8), boff = lds_byte(wc * 32 + fr, fq * 8);
#define PG8_SA(b, h) (((b) * 2 + (h)) * HTB)
#define PG8_SB(b, h) ((4 + (b) * 2 + (h)) * HTB)
#define PG8_STAGE(bufoff, gbase, voff) do { _Pragma("unroll") for (int _i = 0; _i < 2; ++_i) \
        __builtin_amdgcn_global_load_lds((const unsigned*)((const char*)(gbase) + (voff)[_i]), (LAS unsigned*)(lds + (bufoff) + ldsw + _i * 8192), 16, 0, 0); } while (0)
#define PG8_LDA(dst, b, h) do { _Pragma("unroll") for (int m = 0; m < 4; ++m) _Pragma("unroll") for (int k = 0; k < 2; ++k) dst[m][k] = *(const LAS bf16x8*)(lds + PG8_SA(b, h) + aoff + m * 2048 + k * 1024); } while (0)
#define PG8_LDB(dst, b, h) do { _Pragma("unroll") for (int n = 0; n < 2; ++n) _Pragma("unroll") for (int k = 0; k < 2; ++k) dst[n][k] = *(const LAS bf16x8*)(lds + PG8_SB(b, h) + boff + n * 2048 + k * 1024); } while (0)
#define PG8_MMA(ai, bj, At, Bt) do { __builtin_amdgcn_s_setprio(1); _Pragma("unroll") for (int m = 0; m < 4; ++m) _Pragma("unroll") for (int n = 0; n < 2; ++n) _Pragma("unroll") for (int k = 0; k < 2; ++k) \
        acc[ai][bj][m][n] = __builtin_amdgcn_mfma_f32_16x16x32_bf16(Bt[n][k], At[m][k], acc[ai][bj][m][n], 0, 0, 0); __builtin_amdgcn_s_setprio(0); } while (0)
#define PG8_WAIT_V(n) asm volatile("s_waitcnt vmcnt(" #n ")" ::: "memory")
#define PG8_WAIT_L(n) asm volatile("s_waitcnt lgkmcnt(" #n ")" ::: "memory")
#define PG8_BAR __builtin_amdgcn_s_barrier()
#define PG8_SCHED __builtin_amdgcn_sched_barrier(0)
    Unit cur, nxt; int ui = 0;
    if (!S.next(0, cur)) return;
    f32x4 acc[2][2][4][2];
#pragma unroll
    for (int a = 0; a < 2; ++a)
#pragma unroll
        for (int b = 0; b < 2; ++b)
#pragma unroll
            for (int m = 0; m < 4; ++m)
#pragma unroll
                for (int n = 0; n < 2; ++n) acc[a][b][m][n] = (f32x4){0.f, 0.f, 0.f, 0.f};
    bf16x8 At[4][2], B0[2][2], B1[2][2];
    const char* cA = cur.a; const char* cB = cur.b;
    PG8_STAGE(PG8_SB(0, 0), cB, voffB); PG8_STAGE(PG8_SB(0, 1), cB + hstep, voffB); PG8_STAGE(PG8_SA(0, 0), cA, voffA); PG8_STAGE(PG8_SA(0, 1), cA + hstep, voffA);
    if (wr == 1) PG8_BAR;
    PG8_WAIT_V(2); PG8_BAR;
    PG8_STAGE(PG8_SB(1, 0), cB + kstep, voffB); PG8_STAGE(PG8_SA(1, 0), cA + kstep, voffA); PG8_STAGE(PG8_SB(1, 1), cB + hstep + kstep, voffB);
    PG8_WAIT_V(6); PG8_BAR;
    for (;;) {
        const bool has_next = S.next(ui + 1, nxt);
        const char* nA = has_next ? nxt.a : cA; const char* nB = has_next ? nxt.b : cB;
        const int nt = cur.nt;
        for (int t = 0; t < nt; t += 2) {
            const bool last = (t == nt - 2);
            const char* a1 = cA + (size_t)(t + 1) * kstep;
            const char* a2 = last ? nA : cA + (size_t)(t + 2) * kstep; const char* b2 = last ? nB : cB + (size_t)(t + 2) * kstep;
            const char* a3 = a2 + kstep; const char* b3 = b2 + kstep;
            PG8_LDB(B0, 0, 0); PG8_LDB(B1, 0, 1); PG8_SCHED; PG8_LDA(At, 0, 0); PG8_STAGE(PG8_SA(1, 1), a1 + hstep, voffA);
            PG8_WAIT_V(8); PG8_WAIT_L(0); PG8_BAR; PG8_MMA(0, 0, At, B0); PG8_MMA(0, 1, At, B1); PG8_BAR; PG8_SCHED;
            PG8_LDA(At, 0, 1); PG8_STAGE(PG8_SB(0, 0), b2, voffB); PG8_STAGE(PG8_SB(0, 1), b2 + hstep, voffB); PG8_STAGE(PG8_SA(0, 0), a2, voffA);
            PG8_WAIT_V(8); PG8_WAIT_L(0); PG8_BAR; PG8_MMA(1, 0, At, B0); PG8_MMA(1, 1, At, B1); PG8_BAR; PG8_SCHED;
            PG8_LDB(B0, 1, 0); PG8_LDB(B1, 1, 1); PG8_SCHED; PG8_LDA(At, 1, 0); PG8_STAGE(PG8_SA(0, 1), a2 + hstep, voffA);
            PG8_WAIT_V(8); PG8_WAIT_L(0); PG8_BAR; PG8_MMA(0, 0, At, B0); PG8_MMA(0, 1, At, B1); PG8_BAR; PG8_SCHED;
            PG8_LDA(At, 1, 1); PG8_STAGE(PG8_SB(1, 0), b3, voffB); PG8_STAGE(PG8_SB(1, 1), b3 + hstep, voffB); PG8_STAGE(PG8_SA(1, 0), a3, voffA);
            PG8_WAIT_V(8); PG8_WAIT_L(0); PG8_BAR; PG8_MMA(1, 0, At, B0); PG8_MMA(1, 1, At, B1); PG8_BAR; PG8_SCHED;
        }
        if (wr == 0) PG8_BAR;
        E(acc, cur, wr, wc, fr, fq);
        if (!has_next) break;
#pragma unroll
        for (int a = 0; a < 2; ++a)
#pragma unroll
            for (int b = 0; b < 2; ++b)
#pragma unroll
                for (int m = 0; m < 4; ++m)
#pragma unroll
                    for (int n = 0; n < 2; ++n) acc[a][b][m][n] = (f32x4){0.f, 0.f, 0.f, 0.f};
        cur = nxt; cA = nA; cB = nB; ++ui;
        if (wr == 1) PG8_BAR;
    }
    PG8_WAIT_V(0);
    PG8_BAR;
#undef PG8_SA
#undef PG8_SB
#undef PG8_STAGE
#undef PG8_LDA
#undef PG8_LDB
#undef PG8_MMA
#undef PG8_WAIT_V
#undef PG8_WAIT_L
#undef PG8_BAR
#undef PG8_SCHED
}
typedef f32x4 Acc[2][2][4][2];
}

#define XB_TMO      128
#define XB_XCNT(j)  (256  + 64 * (j))
#define XB_XSUB(j)  (1280 + 64 * (j))
#define XB_XGEN(j)  (2304 + 64 * (j))
#define XB_TOP      3328
#define XB_TOPGEN   3392
#define XCD_BAR_WORDS 3456
#define XB_SPIN_CAP (1u << 18)
__device__ __forceinline__ unsigned xb_ld(unsigned* p)              { return __hip_atomic_load(p, __ATOMIC_RELAXED, __HIP_MEMORY_SCOPE_AGENT); }
__device__ __forceinline__ unsigned xb_add(unsigned* p, unsigned v) { return __hip_atomic_fetch_add(p, v, __ATOMIC_RELAXED, __HIP_MEMORY_SCOPE_AGENT); }
__device__ __forceinline__ unsigned xb_xcc_id() { return (unsigned)__builtin_amdgcn_s_getreg((3 << 11) | 20) & 0xFu; }
#define XB_SPIN(cond, bar) do { unsigned _sp = 0; while (cond) { __builtin_amdgcn_s_sleep(1); \
    if ((++_sp & 255u) == 0u) { if (xb_ld(&(bar)[XB_TMO])) break; if (_sp > XB_SPIN_CAP) { atomicAdd(&(bar)[XB_TMO], 1u); break; } } } } while (0)
struct XcdBarrier { unsigned* bar; unsigned x; volatile LAS unsigned* st; };
__device__ __forceinline__ XcdBarrier xcd_barrier_post(unsigned* bar, volatile LAS unsigned* st) {
    XcdBarrier b; b.bar = bar; b.x = xb_xcc_id(); b.st = st;
    if (threadIdx.x == 0) (void)xb_add(&bar[XB_XCNT(b.x)], 1u);
    return b;
}
__device__ __forceinline__ void xcd_barrier_complete(unsigned* bar, unsigned x, unsigned& nloc, unsigned& nx) {
    const unsigned G = gridDim.x * gridDim.y * gridDim.z;
    unsigned sum, cnt, mine, sp = 0u;
    for (;;) {
        sum = 0u; cnt = 0u; mine = 0u;
#pragma unroll
        for (unsigned j = 0; j < 16; ++j) { const unsigned c = xb_ld(&bar[XB_XCNT(j)]); sum += c; cnt += (c > 0u) ? 1u : 0u; mine = (j == x) ? c : mine; }
        if (sum == G) break;
        __builtin_amdgcn_s_sleep(1);
        if ((++sp & 255u) == 0u) { if (xb_ld(&bar[XB_TMO])) break; if (sp > XB_SPIN_CAP) { atomicAdd(&bar[XB_TMO], 1u); break; } }
    }
    nloc = mine > 0u ? mine : 1u; nx = cnt > 0u ? cnt : 1u;
}
__device__ __forceinline__ void xcd_barrier(const XcdBarrier& b) {
    asm volatile("s_waitcnt vmcnt(0)" ::: "memory");
    __syncthreads();
    if (threadIdx.x == 0) {
        unsigned* bar = b.bar;
        __builtin_amdgcn_s_waitcnt(0);
        unsigned nloc = b.st[0], nx = b.st[1];
        if (nloc == 0u) { xcd_barrier_complete(bar, b.x, nloc, nx); b.st[0] = nloc; b.st[1] = nx; }
        const unsigned old = xb_add(&bar[XB_XSUB(b.x)], 1u);
        const unsigned gen = old / nloc;
        if (old + 1u == (gen + 1u) * nloc) {
            __builtin_amdgcn_fence(__ATOMIC_RELEASE, "agent");
            asm volatile("s_waitcnt vmcnt(0)" ::: "memory");
            const unsigned og = xb_add(&bar[XB_TOP], 1u);
            const unsigned tg = og / nx;
            if (og + 1u == (tg + 1u) * nx) xb_add(&bar[XB_TOPGEN], 1u);
            else XB_SPIN(xb_ld(&bar[XB_TOPGEN]) == tg, bar);
            __builtin_amdgcn_fence(__ATOMIC_ACQUIRE, "agent");
            xb_add(&bar[XB_XGEN(b.x)], 1u);
            asm volatile("s_waitcnt vmcnt(0)" ::: "memory");
        } else {
            XB_SPIN(xb_ld(&bar[XB_XGEN(b.x)]) == gen, bar);
            __builtin_amdgcn_fence(__ATOMIC_ACQUIRE, "agent");
            asm volatile("s_waitcnt vmcnt(0)" ::: "memory");
        }
    }
    __syncthreads();
}

constexpr int NWAVES = 8;
struct Frame {
    LAS unsigned char* lds;
    volatile LAS unsigned* MISC;
    unsigned* ctl;
    int tid, lane, wave, vcu, G;
    unsigned char* ws; unsigned char* outb;
    const float *x, *g1, *w_in, *b_in, *sinks, *w_au, *w_ru, *w_out, *g2, *w_gr, *b_gr, *w_er, *b_er, *w_ge, *w_ue, *w_de, *gf;
};

__device__ __forceinline__ void p0_transpose_item(const float* W, int N, int k0, int n0, bf16_t* WT, size_t dpitch, int drow0, int dcol0, LAS float* scr, int lane) {
#pragma unroll 8
    for (int i = 0; i < 32; ++i) { const int kk = 2 * i + (lane >> 5); scr[kk * 33 + (lane & 31)] = W[(size_t)(k0 + kk) * N + n0 + (lane & 31)]; }
    LDS_WAIT(); asm volatile("" ::: "memory");
    const int c = lane & 7;
#pragma unroll
    for (int j = 0; j < 4; ++j) { const int n = (lane >> 3) + 8 * j; const LAS float* s = scr + (8 * c) * 33 + n;
        u32x4 o; o.x = pk2(s[0 * 33], s[1 * 33]); o.y = pk2(s[2 * 33], s[3 * 33]); o.z = pk2(s[4 * 33], s[5 * 33]); o.w = pk2(s[6 * 33], s[7 * 33]);
        *(GAS u32x4*)(WT + (size_t)(drow0 + n) * dpitch + dcol0 + k0 + 8 * c) = o; }
    LDS_WAIT(); asm volatile("" ::: "memory");
}
__device__ __forceinline__ void p0_prologue(Frame& F) {
    LAS float* scr = (LAS float*)(F.lds + F.wave * 16384);
    const int gw = F.vcu * NWAVES + F.wave, NGW = F.G * NWAVES;
    constexpr int I_IN = 16 * 184, I_AU = 8 * 32, I_RU = 16 * 32, I_OUT = 16 * 32, I_G = 32 * 256, I_U = 32 * 256, I_D = 32 * 256;
    constexpr int NITEMS = I_IN + I_AU + I_RU + I_OUT + I_G + I_U + I_D;
    bf16_t* WinT = (bf16_t*)(F.ws + WS_WIN); bf16_t* WupT = (bf16_t*)(F.ws + WS_WUP); bf16_t* WoutT = (bf16_t*)(F.ws + WS_WOUT);
    bf16_t* WguT = (bf16_t*)(F.ws + WS_WGU); bf16_t* WdT = (bf16_t*)(F.ws + WS_WD);
    for (int it = gw; it < NITEMS; it += NGW) {
        int r = it;
        if (r < I_IN) { const int kb = r / 184, nb = r % 184; p0_transpose_item(F.w_in, INW, 64 * kb, 32 * nb, WinT, 1024, 32 * nb, 0, scr, F.lane); continue; } r -= I_IN;
        if (r < I_AU) { const int kb = r / 32, nb = r % 32; p0_transpose_item(F.w_au, 1024, 64 * kb, 32 * nb, WupT, 1536, 32 * nb, 0, scr, F.lane); continue; } r -= I_AU;
        if (r < I_RU) { const int kb = r / 32, nb = r % 32; p0_transpose_item(F.w_ru, 1024, 64 * kb, 32 * nb, WupT, 1536, 32 * nb, 512, scr, F.lane); continue; } r -= I_RU;
        if (r < I_OUT) { const int kb = r / 32, nb = r % 32; p0_transpose_item(F.w_out, 1024, 64 * kb, 32 * nb, WoutT, 1024, 32 * nb, 0, scr, F.lane); continue; } r -= I_OUT;
        if (r < I_G) { const int e = r / 256, q = r % 256, kb = q / 16, nb = q % 16, n0 = 32 * nb;
            p0_transpose_item(F.w_ge + (size_t)e * 1024 * 512, 512, 64 * kb, n0, WguT + (size_t)e * 1024 * 1024, 1024, 256 * (n0 >> 7) + (n0 & 127), 0, scr, F.lane); continue; } r -= I_G;
        if (r < I_U) { const int e = r / 256, q = r % 256, kb = q / 16, nb = q % 16, n0 = 32 * nb;
            p0_transpose_item(F.w_ue + (size_t)e * 1024 * 512, 512, 64 * kb, n0, WguT + (size_t)e * 1024 * 1024, 1024, 256 * (n0 >> 7) + 128 + (n0 & 127), 0, scr, F.lane); continue; } r -= I_U;
        { const int e = r / 256, q = r % 256, kb = q / 32, nb = q % 32;
            p0_transpose_item(F.w_de + (size_t)e * 512 * 1024, 1024, 64 * kb, 32 * nb, WdT + (size_t)e * 1024 * 512, 512, 32 * nb, 0, scr, F.lane); }
    }
    bf16_t* XN = (bf16_t*)F.outb;
    f32x4 gv[4];
#pragma unroll
    for (int j = 0; j < 4; ++j) gv[j] = ((const GAS f32x4*)F.g1)[F.lane + 64 * j];
    for (int m = gw; m < T; m += NGW) {
        const GAS f32x4* xr = (const GAS f32x4*)(F.x + (size_t)m * DM) + F.lane;
        f32x4 v[4]; float s = 0.f;
#pragma unroll
        for (int j = 0; j < 4; ++j) { v[j] = xr[64 * j]; s += (v[j].x * v[j].x + v[j].y * v[j].y) + (v[j].z * v[j].z + v[j].w * v[j].w); }
        const float rstd = 1.0f / sqrtf(wave_sum(s) * (1.f / DM) + EPS);
        GAS u32x2* o8 = (GAS u32x2*)(XN + (size_t)m * DM) + F.lane;
#pragma unroll
        for (int j = 0; j < 4; ++j) { u32x2 w; w.x = pk2(v[j].x * rstd * gv[j].x, v[j].y * rstd * gv[j].y); w.y = pk2(v[j].z * rstd * gv[j].z, v[j].w * rstd * gv[j].w); o8[64 * j] = w; }
    }
}

struct DenseOrder {
    const char* A; const char* Bt; int nM, nN, nwg, G, c, ld, nt;
    __device__ __forceinline__ void tile(int wg, int& pm, int& pn) const {
        int wgid = wg; { const int q = nwg / 8, r = nwg % 8, xcd = wgid % 8, off = wgid / 8; wgid = (xcd < r ? xcd * (q + 1) : r * (q + 1) + (xcd - r) * q) + off; }
        const int nig = 8 * nN, gid = wgid / nig, fm = gid * 8, gsz = (nM - fm) < 8 ? (nM - fm) : 8;
        pm = fm + ((wgid % nig) % gsz); pn = (wgid % nig) / gsz;
    }
    __device__ __forceinline__ bool next(int i, pg8::Unit& u) const {
        const long L = (long)i * G + c; if (L >= nwg) return false;
        int pm, pn; tile((int)L, pm, pn);
        u.pm = pm; u.pn = pn; u.nt = nt; u.aux = 0;
        u.a = A + (size_t)pm * 256 * ld * 2; u.b = Bt + (size_t)pn * 256 * ld * 2; return true;
    }
};
struct UpOrder {
    DenseOrder d;
    __device__ __forceinline__ bool next(int i, pg8::Unit& u) const {
        const long L = (long)(i >> 1) * d.G + d.c; if (L >= d.nwg) return false;
        int pm, pn; d.tile((int)L, pm, pn);
        const int part = i & 1;
        u.pm = pm; u.pn = pn; u.aux = part; u.nt = part ? 16 : 8;
        u.a = d.A + (size_t)pm * 256 * ARW * 2 + (part ? 1024 : 0); u.b = d.Bt + (size_t)pn * 256 * ARW * 2 + (part ? 1024 : 0); return true;
    }
};
struct ExpertOrder {
    const char* A; const char* Bt; const volatile LAS int* tp; int ntiles, G, c, ldA, nt; size_t bstride  , bpn  ;
    __device__ __forceinline__ bool next(int i, pg8::Unit& u) const {
        const long L = (long)i * G + c; if (L >= (long)ntiles * 4) return false;
        const int tix = (int)(L >> 2), pn = (int)(L & 3);
        int e = 0;
        for (int k = 1; k < NEXP; ++k) e += (tix >= tp[k]) ? 1 : 0;
        u.pm = tix; u.pn = pn; u.nt = nt; u.aux = e;
        u.a = A + (size_t)tix * 256 * ldA * 2; u.b = Bt + (size_t)e * bstride + (size_t)pn * bpn; return true;
    }
};

struct EpiProj {
    static constexpr bool PERM = true;
    bf16_t* PA; bf16_t* GT; const float* bias;
    __device__ __forceinline__ void operator()(const pg8::Acc& acc, const pg8::Unit& u, int wr, int wc, int fr, int fq) const {
        const int ct = u.pn; const int mode = ct < 11 ? 0 : (ct < 15 ? 1 : 2);
        bf16_t* base; int ldc, colt;
        if (ct < 15) { base = PA; ldc = PAW; colt = ct * 256; } else { base = GT; ldc = GTW; colt = ct * 256 - PAW; }
        const int row0 = u.pm * 256 + wr * 64 + fr, col0 = colt + wc * 32 + 8 * fq, bcol0 = ct * 256 + wc * 32 + 8 * fq;
        f32x4 bv[2][2];
#pragma unroll
        for (int bj = 0; bj < 2; ++bj)
#pragma unroll
            for (int n = 0; n < 2; ++n) bv[bj][n] = *(const f32x4*)(bias + bcol0 + bj * 128 + 4 * n);
#pragma unroll
        for (int ai = 0; ai < 2; ++ai)
#pragma unroll
            for (int m = 0; m < 4; ++m) { bf16_t* rowp = base + (size_t)(row0 + ai * 128 + m * 16) * ldc + col0;
#pragma unroll
                for (int bj = 0; bj < 2; ++bj) { f32x4 v0 = acc[ai][bj][m][0] + bv[bj][0], v1 = acc[ai][bj][m][1] + bv[bj][1];
                    if (mode != 0) {
#pragma unroll
                        for (int j = 0; j < 4; ++j) { const float s0 = sigmoidf_(v0[j]), s1 = sigmoidf_(v1[j]); v0[j] = (mode == 1) ? v0[j] * s0 : s0; v1[j] = (mode == 1) ? v1[j] * s1 : s1; } }
                    u32x4 w; w.x = cvt_pk_bf16(v0[0], v0[1]); w.y = cvt_pk_bf16(v0[2], v0[3]); w.z = cvt_pk_bf16(v1[0], v1[1]); w.w = cvt_pk_bf16(v1[2], v1[3]);
                    *(u32x4*)(rowp + bj * 128) = w; } }
    }
};
struct EpiUp {
    static constexpr bool PERM = true;
    bf16_t* MIX; const bf16_t* GT;
    __device__ __forceinline__ void operator()(const pg8::Acc& acc, const pg8::Unit& u, int wr, int wc, int fr, int fq) const {
        const int part = u.aux;
        const int row0 = u.pm * 256 + wr * 64 + fr, col0 = u.pn * 256 + wc * 32 + 8 * fq;
#pragma unroll
        for (int ai = 0; ai < 2; ++ai) {
            u32x4 g[4][2], p[4][2];
#pragma unroll
            for (int m = 0; m < 4; ++m)
#pragma unroll
                for (int bj = 0; bj < 2; ++bj) { const size_t row = (size_t)(row0 + ai * 128 + m * 16);
                    g[m][bj] = __builtin_nontemporal_load((const u32x4*)(GT + row * GTW + part * 1024 + col0 + bj * 128));
                    p[m][bj] = part ? *(const u32x4*)(MIX + row * DM + col0 + bj * 128) : (u32x4){0u, 0u, 0u, 0u}; }
            asm volatile("" ::: "memory");
#pragma unroll
            for (int m = 0; m < 4; ++m)
#pragma unroll
                for (int bj = 0; bj < 2; ++bj) { const size_t row = (size_t)(row0 + ai * 128 + m * 16);
                    const f32x4 a0 = acc[ai][bj][m][0], a1 = acc[ai][bj][m][1]; const u32x4 gg = g[m][bj], pp = p[m][bj];
                    float r[8];
                    r[0] = bflo(gg.x) * a0[0] + bflo(pp.x); r[1] = bfhi(gg.x) * a0[1] + bfhi(pp.x); r[2] = bflo(gg.y) * a0[2] + bflo(pp.y); r[3] = bfhi(gg.y) * a0[3] + bfhi(pp.y);
                    r[4] = bflo(gg.z) * a1[0] + bflo(pp.z); r[5] = bfhi(gg.z) * a1[1] + bfhi(pp.z); r[6] = bflo(gg.w) * a1[2] + bflo(pp.w); r[7] = bfhi(gg.w) * a1[3] + bfhi(pp.w);
                    u32x4 w; w.x = cvt_pk_bf16(r[0], r[1]); w.y = cvt_pk_bf16(r[2], r[3]); w.z = cvt_pk_bf16(r[4], r[5]); w.w = cvt_pk_bf16(r[6], r[7]);
                    *(u32x4*)(MIX + row * DM + col0 + bj * 128) = w; }
            asm volatile("" ::: "memory");
        }
    }
};
struct EpiOut {
    static constexpr bool PERM = false;
    const float* x; float* X2;
    __device__ __forceinline__ void operator()(const pg8::Acc& acc, const pg8::Unit& u, int wr, int wc, int fr, int fq) const {
        const int row0 = u.pm * 256 + wr * 64 + fr, col0 = u.pn * 256 + wc * 32 + 4 * fq;
#pragma unroll
        for (int ai = 0; ai < 2; ++ai) {
            f32x4 xv[4][2][2];
#pragma unroll
            for (int m = 0; m < 4; ++m) { const size_t off = (size_t)(row0 + ai * 128 + m * 16) * DM + col0;
#pragma unroll
                for (int bj = 0; bj < 2; ++bj)
#pragma unroll
                    for (int n = 0; n < 2; ++n) xv[m][bj][n] = __builtin_nontemporal_load((const f32x4*)(x + off + bj * 128 + n * 16)); }
            asm volatile("" ::: "memory");
#pragma unroll
            for (int m = 0; m < 4; ++m) { const size_t off = (size_t)(row0 + ai * 128 + m * 16) * DM + col0;
#pragma unroll
                for (int bj = 0; bj < 2; ++bj)
#pragma unroll
                    for (int n = 0; n < 2; ++n) *(f32x4*)(X2 + off + bj * 128 + n * 16) = xv[m][bj][n] + acc[ai][bj][m][n]; }
            asm volatile("" ::: "memory");
        }
    }
};
struct EpiSwiglu {
    static constexpr bool PERM = true;
    bf16_t* ACT;
    __device__ __forceinline__ void operator()(const pg8::Acc& acc, const pg8::Unit& u, int wr, int wc, int fr, int fq) const {
        const int row0 = u.pm * 256 + wr * 64 + fr, col0 = u.pn * 128 + wc * 32 + 8 * fq;
#pragma unroll
        for (int ai = 0; ai < 2; ++ai)
#pragma unroll
            for (int m = 0; m < 4; ++m) { bf16_t* rowp = ACT + (size_t)(row0 + ai * 128 + m * 16) * DEXP + col0;
                float r[8];
#pragma unroll
                for (int n = 0; n < 2; ++n)
#pragma unroll
                    for (int j = 0; j < 4; ++j) { const float g = acc[ai][0][m][n][j], up = acc[ai][1][m][n][j]; r[4 * n + j] = g * sigmoidf_(g) * up; }
                u32x4 w; w.x = cvt_pk_bf16(r[0], r[1]); w.y = cvt_pk_bf16(r[2], r[3]); w.z = cvt_pk_bf16(r[4], r[5]); w.w = cvt_pk_bf16(r[6], r[7]);
                *(u32x4*)rowp = w; }
    }
};
struct EpiDown {
    static constexpr bool PERM = true;
    bf16_t* YB;
    __device__ __forceinline__ void operator()(const pg8::Acc& acc, const pg8::Unit& u, int wr, int wc, int fr, int fq) const {
        const int row0 = u.pm * 256 + wr * 64 + fr, col0 = u.pn * 256 + wc * 32 + 8 * fq;
#pragma unroll
        for (int ai = 0; ai < 2; ++ai)
#pragma unroll
            for (int m = 0; m < 4; ++m) { bf16_t* rowp = YB + (size_t)(row0 + ai * 128 + m * 16) * DM + col0;
#pragma unroll
                for (int bj = 0; bj < 2; ++bj) { const f32x4 v0 = acc[ai][bj][m][0], v1 = acc[ai][bj][m][1];
                    u32x4 w; w.x = cvt_pk_bf16(v0[0], v0[1]); w.y = cvt_pk_bf16(v0[2], v0[3]); w.z = cvt_pk_bf16(v1[0], v1[1]); w.w = cvt_pk_bf16(v1[2], v1[3]);
                    *(u32x4*)(rowp + bj * 128) = w; } }
    }
};

__device__ __forceinline__ void ld8bf(const bf16_t* p, float* o) { const u32x4 w = *(const u32x4*)p; o[0] = bflo(w.x); o[1] = bfhi(w.x); o[2] = bflo(w.y); o[3] = bfhi(w.y); o[4] = bflo(w.z); o[5] = bfhi(w.z); o[6] = bflo(w.w); o[7] = bfhi(w.w); }
__device__ __forceinline__ void p2_attention_naive(Frame& F, int u0, int ustride) {
    LAS float* Ks = (LAS float*)F.lds;
    LAS float* Vs = Ks + 256 * 68;
    const bf16_t* PA = (const bf16_t*)(F.ws + WS_PA); bf16_t* AR = (bf16_t*)F.outb;
    const int tid = F.tid, part = tid & 7;
    for (int unit = u0; unit < NB * 16 * 8; unit += ustride) {
        const int h = unit & 7, n = (unit >> 3) & 15, b = unit >> 7, kvh = h >> 2;
        const size_t tok0 = (size_t)b * SEQ + n * 128;
        __syncthreads();
        for (int idx = tid; idx < 256 * 8; idx += 512) {
            const int j = idx >> 3, c = idx & 7;
            float kf[8], vf[8];
            if (n == 0 && j < 128) {
#pragma unroll
                for (int i = 0; i < 8; ++i) { kf[i] = 0.f; vf[i] = 0.f; }
            } else {
                const bf16_t* rp = PA + (tok0 - 128 + j) * PAW;
                ld8bf(rp + C_AK + kvh * 64 + c * 8, kf); ld8bf(rp + C_AV + kvh * 64 + c * 8, vf);
            }
            *(LAS f32x4*)(Ks + j * 68 + c * 8) = (f32x4){kf[0], kf[1], kf[2], kf[3]}; *(LAS f32x4*)(Ks + j * 68 + c * 8 + 4) = (f32x4){kf[4], kf[5], kf[6], kf[7]};
            *(LAS f32x4*)(Vs + j * 68 + c * 8) = (f32x4){vf[0], vf[1], vf[2], vf[3]}; *(LAS f32x4*)(Vs + j * 68 + c * 8 + 4) = (f32x4){vf[4], vf[5], vf[6], vf[7]};
        }
        __syncthreads();
        const float slope = exp2f(-(float)(h + 1)), sink = F.sinks[h];
        for (int qh = 0; qh < 2; ++qh) {
            const int q = qh * 64 + (tid >> 3);
            const size_t tq = tok0 + q;
            float qr[64];
#pragma unroll
            for (int c = 0; c < 8; ++c) ld8bf(PA + tq * PAW + C_AQ + h * 64 + c * 8, qr + 8 * c);
            float o[64];
#pragma unroll
            for (int d = 0; d < 64; ++d) o[d] = 0.f;
            float mx = sink, den = (part == 0) ? 1.0f : 0.0f;
#pragma unroll 1
            for (int jj = 0; jj < 32; ++jj) {
                const int j = part + 8 * jj, dist = q + 128 - j;
                const bool valid = dist >= 0 && dist < 128 && (n > 0 || j >= 128);
                if (valid) {
                    float d = 0.f;
                    const LAS f32x4* kp = (const LAS f32x4*)(Ks + j * 68);
#pragma unroll
                    for (int c = 0; c < 16; ++c) { const f32x4 kv = kp[c]; d += qr[4 * c] * kv.x + qr[4 * c + 1] * kv.y + qr[4 * c + 2] * kv.z + qr[4 * c + 3] * kv.w; }
                    const float sc = d * 0.125f - slope * (float)dist;
                    const float mn = fmaxf(mx, sc), f = __expf(mx - mn), p = __expf(sc - mn);
                    mx = mn; den = den * f + p;
                    const LAS f32x4* vp = (const LAS f32x4*)(Vs + j * 68);
#pragma unroll
                    for (int c = 0; c < 16; ++c) { const f32x4 vv = vp[c]; o[4 * c] = o[4 * c] * f + p * vv.x; o[4 * c + 1] = o[4 * c + 1] * f + p * vv.y; o[4 * c + 2] = o[4 * c + 2] * f + p * vv.z; o[4 * c + 3] = o[4 * c + 3] * f + p * vv.w; }
                }
            }
            float ma = fmaxf(mx, __shfl_xor(mx, 1)); ma = fmaxf(ma, __shfl_xor(ma, 2)); ma = fmaxf(ma, __shfl_xor(ma, 4));
            const float fs = __expf(mx - ma);
            den *= fs; den += __shfl_xor(den, 1); den += __shfl_xor(den, 2); den += __shfl_xor(den, 4);
            const float inv = 1.0f / den;
#pragma unroll
            for (int d = 0; d < 64; ++d) { o[d] *= fs; o[d] += __shfl_xor(o[d], 1); o[d] += __shfl_xor(o[d], 2); o[d] += __shfl_xor(o[d], 4); }
            if (part == 0) {
                bf16_t* op = AR + tq * ARW + h * 64;
#pragma unroll
                for (int c = 0; c < 8; ++c) { u32x4 w0; w0.x = pk2(o[8 * c] * inv, o[8 * c + 1] * inv); w0.y = pk2(o[8 * c + 2] * inv, o[8 * c + 3] * inv); w0.z = pk2(o[8 * c + 4] * inv, o[8 * c + 5] * inv); w0.w = pk2(o[8 * c + 6] * inv, o[8 * c + 7] * inv);
                    *(u32x4*)(op + 8 * c) = w0; }
            }
        }
    }
}
__device__ __forceinline__ void p2_retention_naive(Frame& F, int u0, int ustride) {
    LAS float* Qs = (LAS float*)F.lds;
    LAS float* Ks = Qs + 128 * 68;
    LAS bf16_t* Vs = (LAS bf16_t*)(Ks + 128 * 68);
    LAS float* Ss = (LAS float*)(Vs + 128 * 136);
    const bf16_t* PA = (const bf16_t*)(F.ws + WS_PA); bf16_t* AR = (bf16_t*)F.outb;
    const int tid = F.tid;
    for (int unit = u0; unit < NB * 8; unit += ustride) {
        const int h = unit & 7, b = unit >> 3;
        const float lg = log2f(1.0f - exp2f(-5.0f - (float)h));
        __syncthreads();
        for (int idx = tid; idx < 64 * 128; idx += 512) Ss[idx] = 0.f;
        for (int n = 0; n < 16; ++n) {
            const size_t tok0 = (size_t)b * SEQ + n * 128;
            __syncthreads();
            for (int idx = tid; idx < 128 * 8; idx += 512) {
                const int j = idx >> 3, c = idx & 7; const bf16_t* rp = PA + (tok0 + j) * PAW;
                float qf[8], kf[8]; ld8bf(rp + C_RQ + h * 64 + c * 8, qf); ld8bf(rp + C_RK + h * 64 + c * 8, kf);
                *(LAS f32x4*)(Qs + j * 68 + c * 8) = (f32x4){qf[0], qf[1], qf[2], qf[3]}; *(LAS f32x4*)(Qs + j * 68 + c * 8 + 4) = (f32x4){qf[4], qf[5], qf[6], qf[7]};
                *(LAS f32x4*)(Ks + j * 68 + c * 8) = (f32x4){kf[0], kf[1], kf[2], kf[3]}; *(LAS f32x4*)(Ks + j * 68 + c * 8 + 4) = (f32x4){kf[4], kf[5], kf[6], kf[7]};
            }
            for (int idx = tid; idx < 128 * 16; idx += 512) {
                const int j = idx >> 4, c = idx & 15;
                *(LAS u32x4*)(Vs + j * 136 + c * 8) = *(const u32x4*)(PA + (tok0 + j) * PAW + C_RV + h * 128 + c * 8);
            }
            __syncthreads();
            {
                const int i = tid >> 2, part = tid & 3;
                float qreg[16];
#pragma unroll
                for (int c = 0; c < 4; ++c) { const f32x4 v = *(const LAS f32x4*)(Qs + i * 68 + 16 * part + 4 * c); qreg[4 * c] = v.x; qreg[4 * c + 1] = v.y; qreg[4 * c + 2] = v.z; qreg[4 * c + 3] = v.w; }
                float y[32];
#pragma unroll
                for (int e = 0; e < 32; ++e) y[e] = 0.f;
                const int jmax = i | 15;
                for (int j = 0; j <= jmax; ++j) {
                    float sdot = 0.f;
#pragma unroll
                    for (int c = 0; c < 4; ++c) { const f32x4 kv = *(const LAS f32x4*)(Ks + j * 68 + 16 * part + 4 * c); sdot += qreg[4 * c] * kv.x + qreg[4 * c + 1] * kv.y + qreg[4 * c + 2] * kv.z + qreg[4 * c + 3] * kv.w; }
                    sdot += __shfl_xor(sdot, 1); sdot += __shfl_xor(sdot, 2);
                    const float w = (j <= i) ? sdot * 0.125f * exp2f((float)(i - j) * lg) : 0.f;
#pragma unroll
                    for (int c = 0; c < 4; ++c) { const u32x4 vv = *(const LAS u32x4*)(Vs + j * 136 + 32 * part + 8 * c);
                        y[8 * c] += w * bflo(vv.x); y[8 * c + 1] += w * bfhi(vv.x); y[8 * c + 2] += w * bflo(vv.y); y[8 * c + 3] += w * bfhi(vv.y);
                        y[8 * c + 4] += w * bflo(vv.z); y[8 * c + 5] += w * bfhi(vv.z); y[8 * c + 6] += w * bflo(vv.w); y[8 * c + 7] += w * bfhi(vv.w); }
                }
                const float gi = exp2f((float)(i + 1) * lg);
                for (int d = 0; d < 64; ++d) {
                    const float qd = Qs[i * 68 + d] * gi;
#pragma unroll
                    for (int c = 0; c < 8; ++c) { const f32x4 sv = *(const LAS f32x4*)(Ss + d * 128 + 32 * part + 4 * c); y[4 * c] += qd * sv.x; y[4 * c + 1] += qd * sv.y; y[4 * c + 2] += qd * sv.z; y[4 * c + 3] += qd * sv.w; }
                }
                float sum = 0.f;
#pragma unroll
                for (int e = 0; e < 32; ++e) sum += y[e];
                sum += __shfl_xor(sum, 1); sum += __shfl_xor(sum, 2);
                const float mu = sum * (1.f / 128.f); float var = 0.f;
#pragma unroll
                for (int e = 0; e < 32; ++e) { y[e] -= mu; var += y[e] * y[e]; }
                var += __shfl_xor(var, 1); var += __shfl_xor(var, 2);
                const float rstd = 1.0f / sqrtf(var * (1.f / 128.f) + EPS);
                const size_t t = tok0 + i;
                const bf16_t* gp = PA + t * PAW + C_RG + h * 128 + 32 * part;
                bf16_t* op = AR + t * ARW + 512 + h * 128 + 32 * part;
#pragma unroll
                for (int c = 0; c < 4; ++c) { float g[8]; ld8bf(gp + 8 * c, g);
                    u32x4 w; w.x = pk2(y[8 * c] * rstd * g[0], y[8 * c + 1] * rstd * g[1]); w.y = pk2(y[8 * c + 2] * rstd * g[2], y[8 * c + 3] * rstd * g[3]);
                    w.z = pk2(y[8 * c + 4] * rstd * g[4], y[8 * c + 5] * rstd * g[5]); w.w = pk2(y[8 * c + 6] * rstd * g[6], y[8 * c + 7] * rstd * g[7]);
                    *(u32x4*)(op + 8 * c) = w; }
            }
            __syncthreads();
            {
                const int d = tid >> 3, eg = tid & 7;
                const float cd = exp2f(128.f * lg);
                float a[16];
#pragma unroll
                for (int c = 0; c < 4; ++c) { const f32x4 sv = *(const LAS f32x4*)(Ss + d * 128 + 16 * eg + 4 * c); a[4 * c] = sv.x * cd; a[4 * c + 1] = sv.y * cd; a[4 * c + 2] = sv.z * cd; a[4 * c + 3] = sv.w * cd; }
                for (int j = 0; j < 128; ++j) {
                    const float kd = Ks[j * 68 + d] * 0.125f * exp2f((float)(127 - j) * lg);
#pragma unroll
                    for (int c = 0; c < 2; ++c) { const u32x4 vv = *(const LAS u32x4*)(Vs + j * 136 + 16 * eg + 8 * c);
                        a[8 * c] += kd * bflo(vv.x); a[8 * c + 1] += kd * bfhi(vv.x); a[8 * c + 2] += kd * bflo(vv.y); a[8 * c + 3] += kd * bfhi(vv.y);
                        a[8 * c + 4] += kd * bflo(vv.z); a[8 * c + 5] += kd * bfhi(vv.z); a[8 * c + 6] += kd * bflo(vv.w); a[8 * c + 7] += kd * bfhi(vv.w); }
                }
#pragma unroll
                for (int c = 0; c < 4; ++c) *(LAS f32x4*)(Ss + d * 128 + 16 * eg + 4 * c) = (f32x4){a[4 * c], a[4 * c + 1], a[4 * c + 2], a[4 * c + 3]};
            }
        }
    }
}

typedef float f32x16 __attribute__((ext_vector_type(16)));
typedef short s16x4 __attribute__((ext_vector_type(4)));
__device__ __forceinline__ int crow(int r, int hi) { return (r & 3) + 8 * (r >> 2) + 4 * hi; }
__device__ __forceinline__ s16x4 ds_tr16(const LAS unsigned char* p) { return __builtin_bit_cast(s16x4, __builtin_amdgcn_ds_read_tr16_b64_v4i16((LAS s16x4*)p)); }
__device__ __forceinline__ bf16x8 pack8(const f32x16& p, int b) {
    u32x4 w; w.x = cvt_pk_bf16(p[b], p[b + 1]); w.y = cvt_pk_bf16(p[b + 2], p[b + 3]); w.z = cvt_pk_bf16(p[b + 4], p[b + 5]); w.w = cvt_pk_bf16(p[b + 6], p[b + 7]);
    return __builtin_bit_cast(bf16x8, w);
}
constexpr int AT_K = 0, AT_V = 36864, AT_WS = AT_V + 32768, AT_OST = AT_WS + 8 * 128, AT_END = AT_OST + 8 * 4096;
static_assert(AT_END <= SCRATCH_BYTES, "attention LDS");
__device__ __forceinline__ void p2_attention_mfma(Frame& F, int u0, int ustride) {
    const bf16_t* PA = (const bf16_t*)(F.ws + WS_PA); bf16_t* AR = (bf16_t*)F.outb;
    LAS unsigned char* lds = F.lds;
    const int tid = F.tid, lane = F.lane, wid = F.wave, r32 = lane & 31, hi = lane >> 5;
    const int g = wid >> 1, qhalf = wid & 1;
    constexpr float LOG2E = 1.4426950408889634f;
    for (int unit = u0; unit < NB * 16 * 2; unit += ustride) {
        const int kvh = unit & 1, n = (unit >> 1) & 15, b = unit >> 5;
        const size_t tok0 = (size_t)b * SEQ + n * 128;
        __syncthreads();
#pragma unroll
        for (int it = 0; it < 4; ++it) {
            const int idx = tid + 512 * it, j = idx >> 3, c = idx & 7;
            u32x4 kv = (u32x4){0u, 0u, 0u, 0u}, vv = (u32x4){0u, 0u, 0u, 0u};
            if (n > 0 || j >= 128) { const bf16_t* rp = PA + (tok0 - 128 + j) * PAW; kv = *(const u32x4*)(rp + C_AK + kvh * 64 + c * 8); vv = *(const u32x4*)(rp + C_AV + kvh * 64 + c * 8); }
            *(LAS u32x4*)(lds + AT_K + j * 144 + c * 16) = kv;
            *(LAS u32x4*)(lds + AT_V + (c >> 2) * 16384 + (j >> 4) * 1024 + (j & 15) * 64 + (c & 3) * 16) = vv;
        }
        __syncthreads();
        const int hd = kvh * 4 + g;
        const float SL = exp2f(-(float)(hd + 1)) * LOG2E, SC = 0.125f * LOG2E, sink2 = F.sinks[hd] * LOG2E;
#pragma unroll 1
        for (int qb = 0; qb < 2; ++qb) {
            const int m = qhalf * 2 + qb, i0 = 32 * m;
            bf16x8 qr[4];
            { const bf16_t* qp = PA + (tok0 + i0 + r32) * PAW + C_AQ + hd * 64 + hi * 8;
#pragma unroll
              for (int s = 0; s < 4; ++s) qr[s] = *(const bf16x8*)(qp + 16 * s); }
            f32x16 p[5];
#pragma unroll
            for (int c = 0; c < 5; ++c) {
                const LAS unsigned char* kp = lds + AT_K + (32 * (m + c) + r32) * 144 + hi * 16;
                f32x16 a;
#pragma unroll
                for (int r = 0; r < 16; ++r) a[r] = 0.f;
#pragma unroll
                for (int s = 0; s < 4; ++s) a = __builtin_amdgcn_mfma_f32_32x32x16_bf16(*(const LAS bf16x8*)(kp + s * 32), qr[s], a, 0, 0, 0);
                p[c] = a;
            }
            const int iq = i0 + r32;
            float mx = sink2;
#pragma unroll
            for (int c = 0; c < 5; ++c)
#pragma unroll
                for (int r = 0; r < 16; ++r) {
                    const int j = 32 * (m + c) + crow(r, hi), dist = iq + 128 - j;
                    const bool valid = dist >= 0 && dist < 128 && (n > 0 || j >= 128);
                    const float t = valid ? p[c][r] * SC - SL * (float)dist : -1e30f;
                    p[c][r] = t; mx = fmaxf(mx, t);
                }
            mx = fmaxf(mx, __shfl_xor(mx, 32));
            float sum = 0.f;
#pragma unroll
            for (int c = 0; c < 5; ++c)
#pragma unroll
                for (int r = 0; r < 16; ++r) { const float e = __builtin_amdgcn_exp2f(p[c][r] - mx); p[c][r] = e; sum += e; }
            sum += __shfl_xor(sum, 32);
            const float den = sum + __builtin_amdgcn_exp2f(sink2 - mx);
            bf16x8 pa[5][2];
#pragma unroll
            for (int c = 0; c < 5; ++c) { pa[c][0] = pack8(p[c], 0); pa[c][1] = pack8(p[c], 8); }
            f32x16 o[2];
#pragma unroll
            for (int d0 = 0; d0 < 2; ++d0) {
                f32x16 a;
#pragma unroll
                for (int r = 0; r < 16; ++r) a[r] = 0.f;
#pragma unroll
                for (int c = 0; c < 5; ++c)
#pragma unroll
                    for (int s = 0; s < 2; ++s) {
                        const LAS unsigned char* vb = lds + AT_V + d0 * 16384 + (2 * (m + c) + s) * 1024 + ((lane >> 4) & 1) * 32 + (lane & 3) * 8 + (4 * hi + ((lane & 15) >> 2)) * 64;
                        const s16x4 lo = ds_tr16(vb), h4 = ds_tr16(vb + 512);
                        const bf16x8 vf = (bf16x8){lo[0], lo[1], lo[2], lo[3], h4[0], h4[1], h4[2], h4[3]};
                        a = __builtin_amdgcn_mfma_f32_32x32x16_bf16(pa[c][s], vf, a, 0, 0, 0);
                    }
                o[d0] = a;
            }
            LAS float* wsf = (LAS float*)(lds + AT_WS + wid * 128);
            asm volatile("s_waitcnt lgkmcnt(0)" ::: "memory");
            if (hi == 0) wsf[r32] = den;
            asm volatile("s_waitcnt lgkmcnt(0)" ::: "memory");
            float rinv[16];
#pragma unroll
            for (int r = 0; r < 16; ++r) rinv[r] = 1.0f / wsf[crow(r, hi)];
            LAS bf16_t* stg = (LAS bf16_t*)(lds + AT_OST + wid * 4096);
#pragma unroll
            for (int r = 0; r < 16; ++r)
#pragma unroll
                for (int d0 = 0; d0 < 2; ++d0) stg[crow(r, hi) * 64 + d0 * 32 + r32] = (bf16_t)f2bf(o[d0][r] * rinv[r]);
            asm volatile("s_waitcnt lgkmcnt(0)" ::: "memory");
#pragma unroll
            for (int it = 0; it < 4; ++it) { const int row = it * 8 + (lane >> 3), ch = lane & 7;
                const u32x4 v = *(const LAS u32x4*)(stg + row * 64 + ch * 8);
                *(u32x4*)(AR + (tok0 + i0 + row) * ARW + hd * 64 + ch * 8) = v; }
            asm volatile("s_waitcnt lgkmcnt(0)" ::: "memory");
        }
    }
}

constexpr int RT_KR = 0, RT_KT = 18432, RT_V = RT_KT + 16384, RT_ST = RT_V + 32768, RT_RED = RT_ST + 18432, RT_OST = RT_RED + 2048, RT_END = RT_OST + 8 * 4608;
static_assert(RT_END <= SCRATCH_BYTES, "retention LDS");
__device__ __forceinline__ u32x4 scale8bf(u32x4 w, float s) {
    u32x4 o; o.x = pk2(bflo(w.x) * s, bfhi(w.x) * s); o.y = pk2(bflo(w.y) * s, bfhi(w.y) * s); o.z = pk2(bflo(w.z) * s, bfhi(w.z) * s); o.w = pk2(bflo(w.w) * s, bfhi(w.w) * s); return o;
}
__device__ __forceinline__ bf16x8 tr_frag(const LAS unsigned char* p) {
    const s16x4 lo = ds_tr16(p), h4 = ds_tr16(p + 512);
    return (bf16x8){lo[0], lo[1], lo[2], lo[3], h4[0], h4[1], h4[2], h4[3]};
}
__device__ __forceinline__ void p2_retention_mfma(Frame& F, int u0, int ustride) {
    const bf16_t* PA = (const bf16_t*)(F.ws + WS_PA); bf16_t* AR = (bf16_t*)F.outb;
    LAS unsigned char* lds = F.lds;
    const int tid = F.tid, lane = F.lane, wid = F.wave, r32 = lane & 31, hi = lane >> 5;
    const int ib = wid >> 1, eh = wid & 1;
    const int sdb = wid & 1, seb = wid >> 1;
    const int troff = ((lane >> 4) & 1) * 32 + (lane & 3) * 8 + (4 * hi + ((lane & 15) >> 2)) * 64;
    for (int unit = u0; unit < NB * 8; unit += ustride) {
        const int h = unit & 7, b = unit >> 3;
        const float lg = log2f(1.0f - exp2f(-5.0f - (float)h));
        const float fac_i = exp2f((float)(32 * ib + r32 - 127) * lg), gi1 = exp2f((float)(32 * ib + r32 + 1) * lg), cd = exp2f(128.0f * lg);
        f32x16 st;
#pragma unroll
        for (int r = 0; r < 16; ++r) st[r] = 0.f;
        __syncthreads();
        for (int idx = tid; idx < 18432 / 4; idx += 512) ((LAS unsigned*)(lds + RT_ST))[idx] = 0u;
        u32x4 kreg[2], vreg[4]; bf16x8 qn[4];
        {
            const size_t tok0 = (size_t)b * SEQ;
#pragma unroll
            for (int it = 0; it < 2; ++it) { const int idx = tid + 512 * it, j = idx >> 3, c = idx & 7; kreg[it] = *(const u32x4*)(PA + (tok0 + j) * PAW + C_RK + h * 64 + c * 8); }
#pragma unroll
            for (int it = 0; it < 4; ++it) { const int idx = tid + 512 * it, j = idx >> 4, c = idx & 15; vreg[it] = *(const u32x4*)(PA + (tok0 + j) * PAW + C_RV + h * 128 + c * 8); }
            const bf16_t* qp = PA + (tok0 + 32 * ib + r32) * PAW + C_RQ + h * 64 + hi * 8;
#pragma unroll
            for (int s = 0; s < 4; ++s) qn[s] = *(const bf16x8*)(qp + 16 * s);
        }
#pragma unroll 1
        for (int n = 0; n < 16; ++n) {
            const size_t tok0 = (size_t)b * SEQ + n * 128;
#pragma unroll
            for (int it = 0; it < 2; ++it) { const int idx = tid + 512 * it, j = idx >> 3, c = idx & 7;
                const u32x4 kk = scale8bf(kreg[it], 0.125f * exp2f((float)(127 - j) * lg));
                *(LAS u32x4*)(lds + RT_KR + j * 144 + c * 16) = kk;
                *(LAS u32x4*)(lds + RT_KT + (c >> 2) * 8192 + (j >> 4) * 1024 + (j & 15) * 64 + (c & 3) * 16) = kk; }
#pragma unroll
            for (int it = 0; it < 4; ++it) { const int idx = tid + 512 * it, j = idx >> 4, c = idx & 15;
                *(LAS u32x4*)(lds + RT_V + (c >> 2) * 8192 + (j >> 4) * 1024 + (j & 15) * 64 + (c & 3) * 16) = vreg[it]; }
            __syncthreads();
            bf16x8 pb[4][2];
#pragma unroll
            for (int jb = 0; jb < 4; ++jb) {
                if (jb <= ib) {
                    const LAS unsigned char* kp = lds + RT_KR + (32 * jb + r32) * 144 + hi * 16;
                    f32x16 a;
#pragma unroll
                    for (int r = 0; r < 16; ++r) a[r] = 0.f;
#pragma unroll
                    for (int s = 0; s < 4; ++s) a = __builtin_amdgcn_mfma_f32_32x32x16_bf16(*(const LAS bf16x8*)(kp + s * 32), qn[s], a, 0, 0, 0);
                    const bool diag = (jb == ib);
#pragma unroll
                    for (int r = 0; r < 16; ++r) a[r] = (!diag || crow(r, hi) <= r32) ? a[r] * fac_i : 0.f;
                    pb[jb][0] = pack8(a, 0); pb[jb][1] = pack8(a, 8);
                    asm volatile("" ::: "memory");
                } else { pb[jb][0] = (bf16x8){0, 0, 0, 0, 0, 0, 0, 0}; pb[jb][1] = (bf16x8){0, 0, 0, 0, 0, 0, 0, 0}; }
            }
            f32x16 y[2];
#pragma unroll
            for (int t = 0; t < 2; ++t) {
                const int eb = 2 * eh + t;
                const LAS unsigned char* sp = lds + RT_ST + (32 * eb + r32) * 144 + hi * 16;
                f32x16 a;
#pragma unroll
                for (int r = 0; r < 16; ++r) a[r] = 0.f;
#pragma unroll
                for (int s = 0; s < 4; ++s) a = __builtin_amdgcn_mfma_f32_32x32x16_bf16(*(const LAS bf16x8*)(sp + s * 32), qn[s], a, 0, 0, 0);
#pragma unroll
                for (int r = 0; r < 16; ++r) a[r] *= gi1;
#pragma unroll
                for (int jb = 0; jb < 4; ++jb) {
                    if (jb <= ib) {
#pragma unroll
                        for (int s2 = 0; s2 < 2; ++s2) {
                            const bf16x8 vf = tr_frag(lds + RT_V + eb * 8192 + (2 * jb + s2) * 1024 + troff);
                            a = __builtin_amdgcn_mfma_f32_32x32x16_bf16(vf, pb[jb][s2], a, 0, 0, 0);
                        }
                        asm volatile("" ::: "memory");
                    }
                }
                y[t] = a;
            }
            if (n < 15) {
                const size_t tokn = tok0 + 128;
#pragma unroll
                for (int it = 0; it < 2; ++it) { const int idx = tid + 512 * it, j = idx >> 3, c = idx & 7; kreg[it] = *(const u32x4*)(PA + (tokn + j) * PAW + C_RK + h * 64 + c * 8); }
#pragma unroll
                for (int it = 0; it < 4; ++it) { const int idx = tid + 512 * it, j = idx >> 4, c = idx & 15; vreg[it] = *(const u32x4*)(PA + (tokn + j) * PAW + C_RV + h * 128 + c * 8); }
                const bf16_t* qp = PA + (tokn + 32 * ib + r32) * PAW + C_RQ + h * 64 + hi * 8;
#pragma unroll
                for (int s = 0; s < 4; ++s) qn[s] = *(const bf16x8*)(qp + 16 * s);
            }
            float s1 = 0.f, s2 = 0.f;
#pragma unroll
            for (int t = 0; t < 2; ++t)
#pragma unroll
                for (int r = 0; r < 16; ++r) { s1 += y[t][r]; s2 += y[t][r] * y[t][r]; }
            s1 += __shfl_xor(s1, 32); s2 += __shfl_xor(s2, 32);
            if (hi == 0) *(LAS f32x2*)(lds + RT_RED + (wid * 32 + r32) * 8) = (f32x2){s1, s2};
#pragma unroll
            for (int r = 0; r < 16; ++r) st[r] *= cd;
#pragma unroll
            for (int sp = 0; sp < 8; ++sp) {
                const bf16x8 kf = tr_frag(lds + RT_KT + sdb * 8192 + sp * 1024 + troff);
                const bf16x8 vf = tr_frag(lds + RT_V + seb * 8192 + sp * 1024 + troff);
                st = __builtin_amdgcn_mfma_f32_32x32x16_bf16(kf, vf, st, 0, 0, 0);
                if (sp & 1) asm volatile("" ::: "memory");
            }
            __syncthreads();
            {
                const f32x2 o = *(const LAS f32x2*)(lds + RT_RED + ((wid ^ 1) * 32 + r32) * 8);
                const float mu = (s1 + o.x) * (1.f / 128.f), var = (s2 + o.y) * (1.f / 128.f) - mu * mu, rstd = 1.0f / sqrtf(fmaxf(var, 0.f) + EPS);
                LAS unsigned char* stg = lds + RT_OST + wid * 4608;
#pragma unroll
                for (int t = 0; t < 2; ++t)
#pragma unroll
                    for (int gq = 0; gq < 4; ++gq) {
                        u32x2 w; w.x = cvt_pk_bf16((y[t][4 * gq] - mu) * rstd, (y[t][4 * gq + 1] - mu) * rstd); w.y = cvt_pk_bf16((y[t][4 * gq + 2] - mu) * rstd, (y[t][4 * gq + 3] - mu) * rstd);
                        *(LAS u32x2*)(stg + r32 * 144 + (32 * t + 8 * gq + 4 * hi) * 2) = w; }
#pragma unroll
                for (int gq = 0; gq < 4; ++gq) {
                    u32x2 w; w.x = cvt_pk_bf16(st[4 * gq], st[4 * gq + 1]); w.y = cvt_pk_bf16(st[4 * gq + 2], st[4 * gq + 3]);
                    *(LAS u32x2*)(lds + RT_ST + (32 * seb + r32) * 144 + (32 * sdb + 8 * gq + 4 * hi) * 2) = w; }
                asm volatile("s_waitcnt lgkmcnt(0)" ::: "memory");
#pragma unroll
                for (int it = 0; it < 4; ++it) { const int row = it * 8 + (lane >> 3), ch = lane & 7;
                    const u32x4 v = *(const LAS u32x4*)(stg + row * 144 + ch * 16);
                    const size_t t = tok0 + 32 * ib + row;
                    const u32x4 gt = *(const u32x4*)(PA + t * PAW + C_RG + h * 128 + 64 * eh + 8 * ch);
                    u32x4 w; w.x = pk2(bflo(v.x) * bflo(gt.x), bfhi(v.x) * bfhi(gt.x)); w.y = pk2(bflo(v.y) * bflo(gt.y), bfhi(v.y) * bfhi(gt.y));
                    w.z = pk2(bflo(v.z) * bflo(gt.z), bfhi(v.z) * bfhi(gt.z)); w.w = pk2(bflo(v.w) * bflo(gt.w), bfhi(v.w) * bfhi(gt.w));
                    *(u32x4*)(AR + t * ARW + 512 + h * 128 + 64 * eh + 8 * ch) = w; }
                asm volatile("s_waitcnt lgkmcnt(0)" ::: "memory");
            }
        }
    }
}

struct TokRec { int e0, r0; float w0; int e1, r1; float w1; int pad0, pad1; };
constexpr int NGROUP = T / 128;
__device__ __forceinline__ void p5_router(Frame& F) {
    LAS float* W = (LAS float*)F.lds;
    LAS float* BIAS = (LAS float*)(F.lds + MISC_OFF + 4 * 128);
    volatile LAS unsigned* lcnt = F.MISC + 192;
    {
        const float* w_gr = F.w_gr; const float* w_er = F.w_er;
#pragma unroll 4
        for (int idx = F.tid; idx < 1024 * 32; idx += 512) { const int k = idx >> 5, c = idx & 31; W[(((k & 3) + 4 * (k >> 8)) * 64 + ((k >> 2) & 63)) * 36 + 4 + c] = w_er[idx]; }
#pragma unroll 4
        for (int idx = F.tid; idx < 1024 * 4; idx += 512) { const int k = idx >> 2, c = idx & 3; W[(((k & 3) + 4 * (k >> 8)) * 64 + ((k >> 2) & 63)) * 36 + c] = w_gr[idx]; }
        if (F.tid < 4) BIAS[F.tid] = F.b_gr[F.tid]; else if (F.tid < 36) BIAS[F.tid] = F.b_er[F.tid - 4];
    }
    const float* X2 = (const float*)F.outb; bf16_t* H2 = (bf16_t*)(F.ws + WS_H2); TokRec* TK = (TokRec*)(F.ws + WS_TOK); unsigned* CNTG = (unsigned*)(F.ws + WS_CNTG);
    const int lane = F.lane;
    f32x4 gv[4];
#pragma unroll
    for (int j = 0; j < 4; ++j) gv[j] = ((const GAS f32x4*)F.g2)[lane + 64 * j];
    for (int gi = F.vcu; gi < NGROUP; gi += F.G) {
        __syncthreads();
        if (F.tid < NEXP) lcnt[F.tid] = 0u;
        __syncthreads();
#pragma unroll 1
        for (int pp = 0; pp < 8; ++pp) {
            const int tb = gi * 128 + F.wave * 16 + 2 * pp;
            f32x4 xv[2][4]; float rstd[2];
#pragma unroll
            for (int tk = 0; tk < 2; ++tk) {
                const size_t t = (size_t)(tb + tk);
                const GAS f32x4* xr = (const GAS f32x4*)(X2 + t * DM) + lane; float s = 0.f;
#pragma unroll
                for (int j = 0; j < 4; ++j) { const f32x4 v = xr[64 * j]; xv[tk][j] = v; s += (v.x * v.x + v.y * v.y) + (v.z * v.z + v.w * v.w); }
                rstd[tk] = 1.0f / sqrtf(wave_sum(s) * (1.f / DM) + EPS);
                GAS u32x2* o8 = (GAS u32x2*)(H2 + t * DM) + lane;
#pragma unroll
                for (int j = 0; j < 4; ++j) { xv[tk][j] = xv[tk][j] * gv[j]; const f32x4 hv = xv[tk][j] * rstd[tk]; u32x2 w; w.x = pk2(hv.x, hv.y); w.y = pk2(hv.z, hv.w); o8[64 * j] = w; }
            }
            float a[36];
#pragma unroll
            for (int half = 0; half < 2; ++half) {
                constexpr int NQ0 = 5;
                const int c0 = half ? NQ0 : 0;
                float acc[2][20];
#pragma unroll
                for (int c = 0; c < 20; ++c) { acc[0][c] = 0.f; acc[1][c] = 0.f; }
#pragma unroll
                for (int j = 0; j < 4; ++j)
#pragma unroll
                    for (int i = 0; i < 4; ++i) {
                        const LAS f32x4* wp = (const LAS f32x4*)(W + ((i + 4 * j) * 64 + lane) * 36) + c0;
                        const float x0 = xv[0][j][i], x1 = xv[1][j][i];
#pragma unroll
                        for (int c = 0; c < 5; ++c) { if (half && c == 4) continue; const f32x4 w = wp[c];
                            acc[0][4 * c] += x0 * w.x; acc[0][4 * c + 1] += x0 * w.y; acc[0][4 * c + 2] += x0 * w.z; acc[0][4 * c + 3] += x0 * w.w;
                            acc[1][4 * c] += x1 * w.x; acc[1][4 * c + 1] += x1 * w.y; acc[1][4 * c + 2] += x1 * w.z; acc[1][4 * c + 3] += x1 * w.w; }
                        asm volatile("" ::: "memory");
                    }
#pragma unroll
                for (int c = 0; c < 20; ++c) { if (half && c >= 16) continue;
                    const float s0 = wave_sum(acc[0][c]), s1 = wave_sum(acc[1][c]); a[4 * c0 + c] = ((lane == 1) ? s1 * rstd[1] : s0 * rstd[0]) + BIAS[4 * c0 + c]; }
            }
            if (lane < 2) {
                const int t = tb + lane;
                int g = 0; float gm = a[0];
#pragma unroll
                for (int c = 1; c < 4; ++c) if (a[c] > gm) { gm = a[c]; g = c; }
                float gs = 0.f;
#pragma unroll
                for (int c = 0; c < 4; ++c) gs += __expf(a[c] - gm);
                const float gprob = 1.0f / gs;
                float el[8];
#pragma unroll
                for (int i = 0; i < 8; ++i) el[i] = (g == 0 ? a[4 + i] : g == 1 ? a[12 + i] : g == 2 ? a[20 + i] : a[28 + i]);
                int i0 = 0; float v0 = el[0];
#pragma unroll
                for (int i = 1; i < 8; ++i) if (el[i] > v0) { v0 = el[i]; i0 = i; }
                int i1 = -1; float v1 = -3.0e38f;
#pragma unroll
                for (int i = 0; i < 8; ++i) if (i != i0 && el[i] > v1) { v1 = el[i]; i1 = i; }
                const float ex = __expf(v1 - v0), w0 = gprob / (1.0f + ex), w1 = gprob * ex / (1.0f + ex);
                const int e0 = g * 8 + i0, e1 = g * 8 + i1;
                const int r0 = (int)__hip_atomic_fetch_add((LAS unsigned*)(lcnt + e0), 1u, __ATOMIC_RELAXED, __HIP_MEMORY_SCOPE_WORKGROUP);
                const int r1 = (int)__hip_atomic_fetch_add((LAS unsigned*)(lcnt + e1), 1u, __ATOMIC_RELAXED, __HIP_MEMORY_SCOPE_WORKGROUP);
                TokRec rec; rec.e0 = e0; rec.r0 = r0; rec.w0 = w0; rec.e1 = e1; rec.r1 = r1; rec.w1 = w1; rec.pad0 = 0; rec.pad1 = 0;
                TK[t] = rec;
            }
        }
        __syncthreads();
        if (F.tid < NEXP) CNTG[gi * NEXP + F.tid] = lcnt[F.tid];
    }
}
__device__ __forceinline__ void build_offsets(Frame& F) {
    LAS int* OFF = (LAS int*)F.lds; LAS int* SEG = (LAS int*)(F.lds + 32768);
    const unsigned* CNTG = (const unsigned*)(F.ws + WS_CNTG);
    __syncthreads();
    for (int idx = F.tid; idx < NGROUP * NEXP; idx += 512) OFF[idx] = (int)__builtin_nontemporal_load(CNTG + idx);
    __syncthreads();
    const int e = F.tid & 31, seg = F.tid >> 5;
    constexpr int GS = NGROUP / 16;
    { int s = 0;
      for (int g = 0; g < GS; ++g) s += OFF[(seg * GS + g) * NEXP + e];
      SEG[seg * NEXP + e] = s; }
    __syncthreads();
    int before = 0, total = 0;
    for (int s2 = 0; s2 < 16; ++s2) { const int v = SEG[s2 * NEXP + e]; total += v; if (s2 < seg) before += v; }
    const int pad = (total + 255) & ~255;
    int incl = pad;
#pragma unroll
    for (int o = 1; o < 32; o <<= 1) { const int v = __shfl_up(incl, o, 32); if (e >= o) incl += v; }
    const int ebase = incl - pad;
    if (F.tid < NEXP) { F.MISC[16 + e] = (unsigned)(ebase >> 8); if (e == 31) F.MISC[48] = (unsigned)(incl >> 8); }
    int run = ebase + before;
    for (int g = 0; g < GS; ++g) { const int i = (seg * GS + g) * NEXP + e; const int c = OFF[i]; OFF[i] = run; run += c; }
    __syncthreads();
}
__device__ __forceinline__ void p6_gather(Frame& F) {
    build_offsets(F);
    const LAS int* OFF = (const LAS int*)F.lds;
    const bf16_t* H2 = (const bf16_t*)(F.ws + WS_H2); bf16_t* XG = (bf16_t*)(F.ws + WS_XG); const TokRec* TK = (const TokRec*)(F.ws + WS_TOK);
    if (blockIdx.x == 0 && F.tid < 33) F.ctl[CW_CNT + F.tid] = F.MISC[16 + F.tid];
    const int gw = F.vcu * NWAVES + F.wave, NGW = F.G * NWAVES, lane = F.lane;
    for (int t = gw; t < T; t += NGW) {
        const TokRec rec = TK[t];
        const int gi = t >> 7;
        const int s0 = OFF[gi * NEXP + rec.e0] + rec.r0, s1 = OFF[gi * NEXP + rec.e1] + rec.r1;
        const GAS u32x4* src = (const GAS u32x4*)(H2 + (size_t)t * DM) + lane;
        const u32x4 v0 = src[0], v1 = src[64];
        GAS u32x4* d0 = (GAS u32x4*)(XG + (size_t)s0 * DM) + lane; GAS u32x4* d1 = (GAS u32x4*)(XG + (size_t)s1 * DM) + lane;
        d0[0] = v0; d0[64] = v1; d1[0] = v0; d1[64] = v1;
    }
}
__device__ __forceinline__ int expert_tiles_to_lds(Frame& F) {
    __syncthreads();
    if (F.tid < 33) F.MISC[16 + F.tid] = __hip_atomic_load(F.ctl + CW_CNT + F.tid, __ATOMIC_RELAXED, __HIP_MEMORY_SCOPE_AGENT);
    __syncthreads();
    return (int)F.MISC[48];
}
__device__ __forceinline__ void p9_combine(Frame& F) {
    build_offsets(F);
    const LAS int* OFF = (const LAS int*)F.lds;
    float* X2 = (float*)F.outb; const bf16_t* YB = (const bf16_t*)(F.ws + WS_YB); const TokRec* TK = (const TokRec*)(F.ws + WS_TOK);
    const int gw = F.vcu * NWAVES + F.wave, NGW = F.G * NWAVES, lane = F.lane;
    f32x4 gv[4];
#pragma unroll
    for (int j = 0; j < 4; ++j) gv[j] = ((const GAS f32x4*)F.gf)[lane + 64 * j];
    for (int t = gw; t < T; t += NGW) {
        const TokRec rec = TK[t];
        const int gi = t >> 7;
        const int s0 = OFF[gi * NEXP + rec.e0] + rec.r0, s1 = OFF[gi * NEXP + rec.e1] + rec.r1;
        GAS f32x4* xr = (GAS f32x4*)(X2 + (size_t)t * DM) + lane;
        const GAS u32x2* y0 = (const GAS u32x2*)(YB + (size_t)s0 * DM) + lane; const GAS u32x2* y1 = (const GAS u32x2*)(YB + (size_t)s1 * DM) + lane;
        f32x4 v[4]; float s = 0.f;
#pragma unroll
        for (int j = 0; j < 4; ++j) { const f32x4 xv = xr[64 * j]; const u32x2 a = y0[64 * j], b = y1[64 * j];
            f32x4 r;
            r.x = xv.x + rec.w0 * bflo(a.x) + rec.w1 * bflo(b.x); r.y = xv.y + rec.w0 * bfhi(a.x) + rec.w1 * bfhi(b.x);
            r.z = xv.z + rec.w0 * bflo(a.y) + rec.w1 * bflo(b.y); r.w = xv.w + rec.w0 * bfhi(a.y) + rec.w1 * bfhi(b.y);
            v[j] = r; s += (r.x * r.x + r.y * r.y) + (r.z * r.z + r.w * r.w); }
        const float rstd = 1.0f / sqrtf(wave_sum(s) * (1.f / DM) + EPS);
#pragma unroll
        for (int j = 0; j < 4; ++j) xr[64 * j] = v[j] * rstd * gv[j];
    }
}

constexpr int NPHASE = 10;
struct Args { const float* in[17]; float* out; unsigned char* ws; int ph_lo, ph_hi, use_cg, pad; };
__global__ void __launch_bounds__(NWAVES * 64, 2) hybrid_fwd(Args args) {
    extern __shared__ __attribute__((aligned(16))) unsigned char lds[];
    Frame F;
    F.lds = (LAS unsigned char*)lds;
    F.MISC = (volatile LAS unsigned*)(F.lds + MISC_OFF);
    F.tid = threadIdx.x; F.lane = F.tid & 63; F.wave = __builtin_amdgcn_readfirstlane(F.tid >> 6);
    F.G = gridDim.x; { const int bx = blockIdx.x; F.vcu = (F.G % 8 == 0) ? (bx % 8) * (F.G / 8) + bx / 8 : bx; }
    F.ws = args.ws; F.outb = (unsigned char*)args.out; F.ctl = (unsigned*)(args.ws + WS_CTL);
    F.x = args.in[0]; F.g1 = args.in[1]; F.w_in = args.in[2]; F.b_in = args.in[3]; F.sinks = args.in[4]; F.w_au = args.in[5]; F.w_ru = args.in[6]; F.w_out = args.in[7];
    F.g2 = args.in[8]; F.w_gr = args.in[9]; F.b_gr = args.in[10]; F.w_er = args.in[11]; F.b_er = args.in[12]; F.w_ge = args.in[13]; F.w_ue = args.in[14]; F.w_de = args.in[15]; F.gf = args.in[16];
    for (int u = F.tid; u < (LDS_BYTES - MISC_OFF) / 4; u += NWAVES * 64) ((LAS unsigned*)(F.lds + MISC_OFF))[u] = 0u;
    __syncthreads();
    const int lo = args.ph_lo, hi = args.ph_hi;
    const bool multi = (hi - lo) > 1;
    XcdBarrier bar; bar.bar = F.ctl + CW_BAR; bar.x = 0; bar.st = nullptr;
    if (multi) bar = xcd_barrier_post(F.ctl + CW_BAR, F.MISC + 8);
    if (args.use_cg == 12345) cg::this_grid().sync();
#define IN(k) (lo <= (k) && (k) < hi)
#define SEAM(k) do { if (IN(k) && IN((k) + 1)) xcd_barrier(bar); } while (0)

#define REP(k) ((PROBE_REP >> (k)) & 1)
#define P1_BODY { DenseOrder S; S.A = (const char*)F.outb; S.Bt = (const char*)(F.ws + WS_WIN); S.nM = T / 256; S.nN = INW / 256; S.nwg = S.nM * S.nN; S.G = F.G; S.c = (int)blockIdx.x; S.ld = DM; S.nt = 16; \
        EpiProj E{(bf16_t*)(F.ws + WS_PA), (bf16_t*)(F.ws + WS_GT), F.b_in}; pg8::gemm_phase<EpiProj, DenseOrder>(F.lds, DM, S, E); }
#define P2_BODY { if (F.G >= 256) { if (F.vcu < 128) p2_retention_mfma(F, F.vcu, 128); else p2_attention_mfma(F, F.vcu - 128, F.G - 128); } \
        else { p2_retention_mfma(F, F.vcu, F.G); p2_attention_mfma(F, F.vcu, F.G); } }
#define P3_BODY { UpOrder S; S.d.A = (const char*)F.outb; S.d.Bt = (const char*)(F.ws + WS_WUP); S.d.nM = T / 256; S.d.nN = 4; S.d.nwg = S.d.nM * 4; S.d.G = F.G; S.d.c = (int)blockIdx.x; S.d.ld = ARW; S.d.nt = 0; \
        EpiUp E{(bf16_t*)(F.ws + WS_MIX), (const bf16_t*)(F.ws + WS_GT)}; pg8::gemm_phase<EpiUp, UpOrder>(F.lds, ARW, S, E); }
#define P4_BODY { DenseOrder S; S.A = (const char*)(F.ws + WS_MIX); S.Bt = (const char*)(F.ws + WS_WOUT); S.nM = T / 256; S.nN = 4; S.nwg = S.nM * 4; S.G = F.G; S.c = (int)blockIdx.x; S.ld = DM; S.nt = 16; \
        EpiOut E{F.x, (float*)F.outb}; pg8::gemm_phase<EpiOut, DenseOrder>(F.lds, DM, S, E); }
#define P7_BODY { const int ntl = expert_tiles_to_lds(F); \
        ExpertOrder S; S.A = (const char*)(F.ws + WS_XG); S.Bt = (const char*)(F.ws + WS_WGU); S.tp = (const volatile LAS int*)(F.MISC + 16); S.ntiles = ntl; S.G = F.G; S.c = (int)blockIdx.x; S.ldA = DM; S.nt = 16; \
        S.bstride = (size_t)1024 * 1024 * 2; S.bpn = (size_t)256 * 1024 * 2; EpiSwiglu E{(bf16_t*)(F.ws + WS_ACT)}; pg8::gemm_phase<EpiSwiglu, ExpertOrder>(F.lds, DM, S, E); }
#define P8_BODY { const int ntl = expert_tiles_to_lds(F); \
        ExpertOrder S; S.A = (const char*)(F.ws + WS_ACT); S.Bt = (const char*)(F.ws + WS_WD); S.tp = (const volatile LAS int*)(F.MISC + 16); S.ntiles = ntl; S.G = F.G; S.c = (int)blockIdx.x; S.ldA = DEXP; S.nt = 8; \
        S.bstride = (size_t)1024 * 512 * 2; S.bpn = (size_t)256 * 512 * 2; EpiDown E{(bf16_t*)(F.ws + WS_YB)}; pg8::gemm_phase<EpiDown, ExpertOrder>(F.lds, DEXP, S, E); }
#define RUN(k, BODY) do { if (IN(k)) { BODY; if (REP(k)) { xcd_barrier(bar); BODY; } } SEAM(k); } while (0)
    RUN(0, p0_prologue(F));
    RUN(1, P1_BODY);
#if (PROBE_REP & 0x1000)
    if (IN(2)) { if (F.vcu < 128) { p2_retention_mfma(F, F.vcu, 128); p2_retention_mfma(F, F.vcu, 128); } else p2_attention_mfma(F, F.vcu - 128, F.G - 128); } SEAM(2);
#elif (PROBE_REP & 0x2000)
    if (IN(2)) { if (F.vcu < 128) p2_retention_mfma(F, F.vcu, 128); else { p2_attention_mfma(F, F.vcu - 128, F.G - 128); p2_attention_mfma(F, F.vcu - 128, F.G - 128); } } SEAM(2);
#else
    RUN(2, P2_BODY);
#endif
    RUN(3, P3_BODY);
    RUN(4, P4_BODY);
    RUN(5, p5_router(F));
    RUN(6, p6_gather(F));
    RUN(7, P7_BODY);
    RUN(8, P8_BODY);
    if (IN(9)) { p9_combine(F); }
#undef IN
#undef SEAM
}

extern "C" void kernel_launch(void* const* d_in, const int* in_sizes, int n_in, void* d_out, int out_size, void* d_ws, size_t ws_size, hipStream_t stream) {
    static int grid = 0;
    if (grid == 0) {
        if (n_in != 17 || in_sizes[0] != T * DM || out_size != T * DM || ws_size < WS_END) {
            fprintf(stderr, "kernel_launch: unexpected shapes (n_in %d, in0 %d, out %d, ws %zu); nothing launched\n", n_in, n_in > 0 ? in_sizes[0] : -1, out_size, ws_size); grid = -1; return; }
        int dev = 0, cus = 0, per_cu = 0;
        if (hipGetDevice(&dev) != hipSuccess || hipDeviceGetAttribute(&cus, hipDeviceAttributeMultiprocessorCount, dev) != hipSuccess) { grid = -1; return; }
        if (hipFuncSetAttribute((const void*)hybrid_fwd, hipFuncAttributeMaxDynamicSharedMemorySize, LDS_BYTES) != hipSuccess) { fprintf(stderr, "kernel_launch: hipFuncSetAttribute failed\n"); grid = -1; return; }
        if (hipOccupancyMaxActiveBlocksPerMultiprocessor(&per_cu, (const void*)hybrid_fwd, NWAVES * 64, LDS_BYTES) != hipSuccess || per_cu < 1) { fprintf(stderr, "kernel_launch: occupancy query says %d blocks per CU\n", per_cu); grid = -1; (void)hipGetLastError(); return; }
        grid = cus;
    }
    if (grid < 0) return;
    if (hipMemsetAsync((char*)d_ws + WS_CTL, 0, CTL_ZERO_BYTES, stream) != hipSuccess) return;
    Args a{};
    for (int i = 0; i < 17; ++i) a.in[i] = (const float*)d_in[i];
    a.out = (float*)d_out; a.ws = (unsigned char*)d_ws; a.use_cg = 0; a.pad = 0;
    constexpr int NL = MK_N_LAUNCHES;
    if (NL == 1) {
        a.ph_lo = 0; a.ph_hi = NPHASE;
        void* kargs[] = {&a};
        hipError_t e = hipLaunchCooperativeKernel((const void*)hybrid_fwd, dim3(grid), dim3(NWAVES * 64), kargs, LDS_BYTES, stream);
        if (e != hipSuccess) fprintf(stderr, "kernel_launch: cooperative launch failed: %s (grid %d)\n", hipGetErrorString(e), grid);
    } else {
        for (int li = 0; li < NPHASE; ++li) {
            a.ph_lo = li; a.ph_hi = li + 1;
            hipLaunchKernelGGL(hybrid_fwd, dim3(grid), dim3(NWAVES * 64), LDS_BYTES, stream, a);
        }
    }
}
```

```cpp
#include <hip/hip_runtime.h>
#include <hip/hip_cooperative_groups.h>
#include <cstdio>
#include <cstdint>
namespace cg = cooperative_groups;

#ifndef PROBE_REP
#define PROBE_REP 0
#endif
#ifndef MK_N_LAUNCHES
#define MK_N_LAUNCHES 1
#endif

#define LAS __attribute__((address_space(3)))
#define GAS __attribute__((address_space(1)))
typedef unsigned short bf16_t;
typedef short bf16x8 __attribute__((ext_vector_type(8)));
typedef float f32x4 __attribute__((ext_vector_type(4)));
typedef float f32x2 __attribute__((ext_vector_type(2)));
typedef unsigned u32x4 __attribute__((ext_vector_type(4)));
typedef unsigned u32x2 __attribute__((ext_vector_type(2)));

constexpr int DM = 1024, NB = 16, SEQ = 2048, T = NB * SEQ;
constexpr int INW = 5888, PAW = 3840, GTW = 2048;
constexpr int C_AQ = 0, C_AK = 512, C_AV = 640, C_RQ = 768, C_RK = 1280, C_RV = 1792, C_RG = 2816;
constexpr int ARW = 1536;
constexpr int NEXP = 32, DEXP = 512;
constexpr int PSLOT = 65536 + 8192;
constexpr float EPS = 1e-6f;

constexpr size_t MiB = 1u << 20;
constexpr size_t WS_CTL = 0, CTL_ZERO_BYTES = 1 * MiB;
constexpr size_t WS_WIN = 2 * MiB;
constexpr size_t WS_WUP = 14 * MiB;
constexpr size_t WS_WOUT = 17 * MiB;
constexpr size_t WS_WGU = 20 * MiB;
constexpr size_t WS_WD = 84 * MiB;
constexpr size_t WS_PA = 116 * MiB;
constexpr size_t WS_GT = 356 * MiB;
constexpr size_t WS_TOK = 484 * MiB;
constexpr size_t WS_CNTG = 485 * MiB;
constexpr size_t WS_END = 486 * MiB;
constexpr size_t WS_MIX = 116 * MiB;
constexpr size_t WS_H2 = 180 * MiB;
constexpr size_t WS_XG = 244 * MiB;
constexpr size_t WS_ACT = 388 * MiB;
constexpr size_t WS_YB = 116 * MiB;
constexpr int CW_CNT = 1024;
constexpr int CW_BAR = 4096;

constexpr int RING_BYTES = 131072;
constexpr int SCRATCH_BYTES = 147456;
constexpr int MISC_OFF = SCRATCH_BYTES;
constexpr int LDS_BYTES = SCRATCH_BYTES + 1024;

__device__ __forceinline__ unsigned f2bf(float f) { unsigned u = __builtin_bit_cast(unsigned, f); return (u + 0x7fffu + ((u >> 16) & 1u)) >> 16; }
__device__ __forceinline__ unsigned pk2(float lo, float hi) { return f2bf(lo) | (f2bf(hi) << 16); }
__device__ __forceinline__ float bflo(unsigned w) { return __builtin_bit_cast(float, w << 16); }
__device__ __forceinline__ float bfhi(unsigned w) { return __builtin_bit_cast(float, w & 0xffff0000u); }
__device__ __forceinline__ float bf2f(bf16_t b) { return __builtin_bit_cast(float, (unsigned)b << 16); }
__device__ __forceinline__ unsigned cvt_pk_bf16(float lo, float hi) { unsigned r; asm volatile("v_cvt_pk_bf16_f32 %0, %1, %2" : "=v"(r) : "v"(lo), "v"(hi)); return r; }
__device__ __forceinline__ float sigmoidf_(float v) { return 1.0f / (1.0f + __expf(-v)); }
__device__ __forceinline__ float wave_sum(float v) {
#pragma unroll
    for (int o = 1; o < 64; o <<= 1) v += __shfl_xor(v, o);
    return v;
}
#define LDS_WAIT() asm volatile("s_waitcnt lgkmcnt(0)" ::: "memory")
#define VM_WAIT() asm volatile("s_waitcnt vmcnt(0)" ::: "memory")

namespace pg8 {
constexpr int BM = 256, BK = 64, HALF = 128, HTB = HALF * BK * 2, STAGE_BYTES = 8 * HTB;
__host__ __device__ __forceinline__ int lds_byte(int r, int c) { const int st = (r >> 4) * 2 + (c >> 5), rr = r & 15, cc = c & 31, ob = rr * 64 + cc * 2; return st * 1024 + (ob ^ (((ob >> 9) & 1) << 5)); }
__host__ __device__ __forceinline__ void stage_rc(int b, int& R, int& C) { const int st = b / 1024, sb = b % 1024, swz = sb ^ (((sb >> 9) & 1) << 5); R = (st >> 1) * 16 + swz / 64; C = (st & 1) * 32 + (swz % 64) / 2; }
__host__ __device__ __forceinline__ int perm32(int rho) { const int n = rho >> 4, i = rho & 15; return 8 * (i >> 2) + 4 * n + (i & 3); }

struct Unit { const char* a; const char* b; int pm, pn, nt, aux; };

template <class Epi, class Sched>
__device__ __forceinline__ void gemm_phase(LAS unsigned char* lds, const int ld  , const Sched& S, const Epi& E) {
    const int tid = threadIdx.x, wid = __builtin_amdgcn_readfirstlane(tid >> 6), lane = tid & 63, wr = wid >> 2, wc = wid & 3, fr = lane & 15, fq = lane >> 4;
    unsigned voffA[2], voffB[2];
#pragma unroll
    for (int i = 0; i < 2; ++i) { int R, C; stage_rc(tid * 16 + i * 8192, R, C); const int Rb = Epi::PERM ? ((R & ~31) + perm32(R & 31)) : R;
        voffA[i] = (unsigned)(R * ld + C) * 2u; voffB[i] = (unsigned)(Rb * ld + C) * 2u; }
    const size_t kstep = (size_t)(BK * 2);
    const size_t hstep = (size_t)HALF * ld * 2;
    const unsigned ldsw = (unsigned)wid * 1024u;
    const int aoff = lds_byte(wr * 64 + fr, fq * 8), boff = lds_byte(wc * 32 + fr, fq * 8);
#define PG8_SA(b, h) (((b) * 2 + (h)) * HTB)
#define PG8_SB(b, h) ((4 + (b) * 2 + (h)) * HTB)
#define PG8_STAGE(bufoff, gbase, voff) do { _Pragma("unroll") for (int _i = 0; _i < 2; ++_i) \
        __builtin_amdgcn_global_load_lds((const unsigned*)((const char*)(gbase) + (voff)[_i]), (LAS unsigned*)(lds + (bufoff) + ldsw + _i * 8192), 16, 0, 0); } while (0)
#define PG8_LDA(dst, b, h) do { _Pragma("unroll") for (int m = 0; m < 4; ++m) _Pragma("unroll") for (int k = 0; k < 2; ++k) dst[m][k] = *(const LAS bf16x8*)(lds + PG8_SA(b, h) + aoff + m * 2048 + k * 1024); } while (0)
#define PG8_LDB(dst, b, h) do { _Pragma("unroll") for (int n = 0; n < 2; ++n) _Pragma("unroll") for (int k = 0; k < 2; ++k) dst[n][k] = *(const LAS bf16x8*)(lds + PG8_SB(b, h) + boff + n * 2048 + k * 1024); } while (0)
#define PG8_MMA(ai, bj, At, Bt) do { __builtin_amdgcn_s_setprio(1); _Pragma("unroll") for (int m = 0; m < 4; ++m) _Pragma("unroll") for (int n = 0; n < 2; ++n) _Pragma("unroll") for (int k = 0; k < 2; ++k) \
        acc[ai][bj][m][n] = __builtin_amdgcn_mfma_f32_16x16x32_bf16(Bt[n][k], At[m][k], acc[ai][bj][m][n], 0, 0, 0); __builtin_amdgcn_s_setprio(0); } while (0)
#define PG8_WAIT_V(n) asm volatile("s_waitcnt vmcnt(" #n ")" ::: "memory")
#define PG8_WAIT_L(n) asm volatile("s_waitcnt lgkmcnt(" #n ")" ::: "memory")
#define PG8_BAR __builtin_amdgcn_s_barrier()
#define PG8_SCHED __builtin_amdgcn_sched_barrier(0)
    Unit cur, nxt; int ui = 0;
    if (!S.next(0, cur)) return;
    f32x4 acc[2][2][4][2];
#pragma unroll
    for (int a = 0; a < 2; ++a)
#pragma unroll
        for (int b = 0; b < 2; ++b)
#pragma unroll
            for (int m = 0; m < 4; ++m)
#pragma unroll
                for (int n = 0; n < 2; ++n) acc[a][b][m][n] = (f32x4){0.f, 0.f, 0.f, 0.f};
    bf16x8 At[4][2], B0[2][2], B1[2][2];
    const char* cA = cur.a; const char* cB = cur.b;
    PG8_STAGE(PG8_SB(0, 0), cB, voffB); PG8_STAGE(PG8_SB(0, 1), cB + hstep, voffB); PG8_STAGE(PG8_SA(0, 0), cA, voffA); PG8_STAGE(PG8_SA(0, 1), cA + hstep, voffA);
    if (wr == 1) PG8_BAR;
    PG8_WAIT_V(2); PG8_BAR;
    PG8_STAGE(PG8_SB(1, 0), cB + kstep, voffB); PG8_STAGE(PG8_SA(1, 0), cA + kstep, voffA); PG8_STAGE(PG8_SB(1, 1), cB + hstep + kstep, voffB);
    PG8_WAIT_V(6); PG8_BAR;
    for (;;) {
        const bool has_next = S.next(ui + 1, nxt);
        const char* nA = has_next ? nxt.a : cA; const char* nB = has_next ? nxt.b : cB;
        const int nt = cur.nt;
        for (int t = 0; t < nt; t += 2) {
            const bool last = (t == nt - 2);
            const char* a1 = cA + (size_t)(t + 1) * kstep;
            const char* a2 = last ? nA : cA + (size_t)(t + 2) * kstep; const char* b2 = last ? nB : cB + (size_t)(t + 2) * kstep;
            const char* a3 = a2 + kstep; const char* b3 = b2 + kstep;
            PG8_LDB(B0, 0, 0); PG8_LDB(B1, 0, 1); PG8_SCHED; PG8_LDA(At, 0, 0); PG8_STAGE(PG8_SA(1, 1), a1 + hstep, voffA);
            PG8_WAIT_V(8); PG8_WAIT_L(0); PG8_BAR; PG8_MMA(0, 0, At, B0); PG8_MMA(0, 1, At, B1); PG8_BAR; PG8_SCHED;
            PG8_LDA(At, 0, 1); PG8_STAGE(PG8_SB(0, 0), b2, voffB); PG8_STAGE(PG8_SB(0, 1), b2 + hstep, voffB); PG8_STAGE(PG8_SA(0, 0), a2, voffA);
            PG8_WAIT_V(8); PG8_WAIT_L(0); PG8_BAR; PG8_MMA(1, 0, At, B0); PG8_MMA(1, 1, At, B1); PG8_BAR; PG8_SCHED;
            PG8_LDB(B0, 1, 0); PG8_LDB(B1, 1, 1); PG8_SCHED; PG8_LDA(At, 1, 0); PG8_STAGE(PG8_SA(0, 1), a2 + hstep, voffA);
            PG8_WAIT_V(8); PG8_WAIT_L(0); PG8_BAR; PG8_MMA(0, 0, At, B0); PG8_MMA(0, 1, At, B1); PG8_BAR; PG8_SCHED;
            PG8_LDA(At, 1, 1); PG8_STAGE(PG8_SB(1, 0), b3, voffB); PG8_STAGE(PG8_SB(1, 1), b3 + hstep, voffB); PG8_STAGE(PG8_SA(1, 0), a3, voffA);
            PG8_WAIT_V(8); PG8_WAIT_L(0); PG8_BAR; PG8_MMA(1, 0, At, B0); PG8_MMA(1, 1, At, B1); PG8_BAR; PG8_SCHED;
        }
        if (wr == 0) PG8_BAR;
        E(acc, cur, wr, wc, fr, fq);
        if (!has_next) break;
#pragma unroll
        for (int a = 0; a < 2; ++a)
#pragma unroll
            for (int b = 0; b < 2; ++b)
#pragma unroll
                for (int m = 0; m < 4; ++m)
#pragma unroll
                    for (int n = 0; n < 2; ++n) acc[a][b][m][n] = (f32x4){0.f, 0.f, 0.f, 0.f};
        cur = nxt; cA = nA; cB = nB; ++ui;
        if (wr == 1) PG8_BAR;
    }
    PG8_WAIT_V(0);
    PG8_BAR;
#undef PG8_SA
#undef PG8_SB
#undef PG8_STAGE
#undef PG8_LDA
#undef PG8_LDB
#undef PG8_MMA
#undef PG8_WAIT_V
#undef PG8_WAIT_L
#undef PG8_BAR
#undef PG8_SCHED
}
typedef f32x4 Acc[2][2][4][2];
}

#define XB_TMO      128
#define XB_XCNT(j)  (256  + 64 * (j))
#define XB_XSUB(j)  (1280 + 64 * (j))
#define XB_XGEN(j)  (2304 + 64 * (j))
#define XB_TOP      3328
#define XB_TOPGEN   3392
#define XCD_BAR_WORDS 3456
#define XB_SPIN_CAP (1u << 18)
__device__ __forceinline__ unsigned xb_ld(unsigned* p)              { return __hip_atomic_load(p, __ATOMIC_RELAXED, __HIP_MEMORY_SCOPE_AGENT); }
__device__ __forceinline__ unsigned xb_add(unsigned* p, unsigned v) { return __hip_atomic_fetch_add(p, v, __ATOMIC_RELAXED, __HIP_MEMORY_SCOPE_AGENT); }
__device__ __forceinline__ unsigned xb_xcc_id() { return (unsigned)__builtin_amdgcn_s_getreg((3 << 11) | 20) & 0xFu; }
#define XB_SPIN(cond, bar) do { unsigned _sp = 0; while (cond) { __builtin_amdgcn_s_sleep(1); \
    if ((++_sp & 255u) == 0u) { if (xb_ld(&(bar)[XB_TMO])) break; if (_sp > XB_SPIN_CAP) { atomicAdd(&(bar)[XB_TMO], 1u); break; } } } } while (0)
struct XcdBarrier { unsigned* bar; unsigned x; volatile LAS unsigned* st; };
__device__ __forceinline__ XcdBarrier xcd_barrier_post(unsigned* bar, volatile LAS unsigned* st) {
    XcdBarrier b; b.bar = bar; b.x = xb_xcc_id(); b.st = st;
    if (threadIdx.x == 0) (void)xb_add(&bar[XB_XCNT(b.x)], 1u);
    return b;
}
__device__ __forceinline__ void xcd_barrier_complete(unsigned* bar, unsigned x, unsigned& nloc, unsigned& nx) {
    const unsigned G = gridDim.x * gridDim.y * gridDim.z;
    unsigned sum, cnt, mine, sp = 0u;
    for (;;) {
        sum = 0u; cnt = 0u; mine = 0u;
#pragma unroll
        for (unsigned j = 0; j < 16; ++j) { const unsigned c = xb_ld(&bar[XB_XCNT(j)]); sum += c; cnt += (c > 0u) ? 1u : 0u; mine = (j == x) ? c : mine; }
        if (sum == G) break;
        __builtin_amdgcn_s_sleep(1);
        if ((++sp & 255u) == 0u) { if (xb_ld(&bar[XB_TMO])) break; if (sp > XB_SPIN_CAP) { atomicAdd(&bar[XB_TMO], 1u); break; } }
    }
    nloc = mine > 0u ? mine : 1u; nx = cnt > 0u ? cnt : 1u;
}
__device__ __forceinline__ void xcd_barrier(const XcdBarrier& b) {
    asm volatile("s_waitcnt vmcnt(0)" ::: "memory");
    __syncthreads();
    if (threadIdx.x == 0) {
        unsigned* bar = b.bar;
        __builtin_amdgcn_s_waitcnt(0);
        unsigned nloc = b.st[0], nx = b.st[1];
        if (nloc == 0u) { xcd_barrier_complete(bar, b.x, nloc, nx); b.st[0] = nloc; b.st[1] = nx; }
        const unsigned old = xb_add(&bar[XB_XSUB(b.x)], 1u);
        const unsigned gen = old / nloc;
        if (old + 1u == (gen + 1u) * nloc) {
            __builtin_amdgcn_fence(__ATOMIC_RELEASE, "agent");
            asm volatile("s_waitcnt vmcnt(0)" ::: "memory");
            const unsigned og = xb_add(&bar[XB_TOP], 1u);
            const unsigned tg = og / nx;
            if (og + 1u == (tg + 1u) * nx) xb_add(&bar[XB_TOPGEN], 1u);
            else XB_SPIN(xb_ld(&bar[XB_TOPGEN]) == tg, bar);
            __builtin_amdgcn_fence(__ATOMIC_ACQUIRE, "agent");
            xb_add(&bar[XB_XGEN(b.x)], 1u);
            asm volatile("s_waitcnt vmcnt(0)" ::: "memory");
        } else {
            XB_SPIN(xb_ld(&bar[XB_XGEN(b.x)]) == gen, bar);
            __builtin_amdgcn_fence(__ATOMIC_ACQUIRE, "agent");
            asm volatile("s_waitcnt vmcnt(0)" ::: "memory");
        }
    }
    __syncthreads();
}

constexpr int NWAVES = 8;
struct Frame {
    LAS unsigned char* lds;
    volatile LAS unsigned* MISC;
    unsigned* ctl;
    int tid, lane, wave, vcu, G;
    unsigned char* ws; unsigned char* outb;
    const float *x, *g1, *w_in, *b_in, *sinks, *w_au, *w_ru, *w_out, *g2, *w_gr, *b_gr, *w_er, *b_er, *w_ge, *w_ue, *w_de, *gf;
};

__device__ __forceinline__ void p0_transpose_item(const float* W, int N, int k0, int n0, bf16_t* WT, size_t dpitch, int drow0, int dcol0, LAS float* scr, int lane) {
#pragma unroll 8
    for (int i = 0; i < 32; ++i) { const int kk = 2 * i + (lane >> 5); scr[kk * 33 + (lane & 31)] = W[(size_t)(k0 + kk) * N + n0 + (lane & 31)]; }
    LDS_WAIT(); asm volatile("" ::: "memory");
    const int c = lane & 7;
#pragma unroll
    for (int j = 0; j < 4; ++j) { const int n = (lane >> 3) + 8 * j; const LAS float* s = scr + (8 * c) * 33 + n;
        u32x4 o; o.x = pk2(s[0 * 33], s[1 * 33]); o.y = pk2(s[2 * 33], s[3 * 33]); o.z = pk2(s[4 * 33], s[5 * 33]); o.w = pk2(s[6 * 33], s[7 * 33]);
        *(GAS u32x4*)(WT + (size_t)(drow0 + n) * dpitch + dcol0 + k0 + 8 * c) = o; }
    LDS_WAIT(); asm volatile("" ::: "memory");
}
__device__ __forceinline__ void p0_prologue(Frame& F) {
    LAS float* scr = (LAS float*)(F.lds + F.wave * 16384);
    const int gw = F.vcu * NWAVES + F.wave, NGW = F.G * NWAVES;
    constexpr int I_IN = 16 * 184, I_AU = 8 * 32, I_RU = 16 * 32, I_OUT = 16 * 32, I_G = 32 * 256, I_U = 32 * 256, I_D = 32 * 256;
    constexpr int NITEMS = I_IN + I_AU + I_RU + I_OUT + I_G + I_U + I_D;
    bf16_t* WinT = (bf16_t*)(F.ws + WS_WIN); bf16_t* WupT = (bf16_t*)(F.ws + WS_WUP); bf16_t* WoutT = (bf16_t*)(F.ws + WS_WOUT);
    bf16_t* WguT = (bf16_t*)(F.ws + WS_WGU); bf16_t* WdT = (bf16_t*)(F.ws + WS_WD);
    for (int it = gw; it < NITEMS; it += NGW) {
        int r = it;
        if (r < I_IN) { const int kb = r / 184, nb = r % 184; p0_transpose_item(F.w_in, INW, 64 * kb, 32 * nb, WinT, 1024, 32 * nb, 0, scr, F.lane); continue; } r -= I_IN;
        if (r < I_AU) { const int kb = r / 32, nb = r % 32; p0_transpose_item(F.w_au, 1024, 64 * kb, 32 * nb, WupT, 1536, 32 * nb, 0, scr, F.lane); continue; } r -= I_AU;
        if (r < I_RU) { const int kb = r / 32, nb = r % 32; p0_transpose_item(F.w_ru, 1024, 64 * kb, 32 * nb, WupT, 1536, 32 * nb, 512, scr, F.lane); continue; } r -= I_RU;
        if (r < I_OUT) { const int kb = r / 32, nb = r % 32; p0_transpose_item(F.w_out, 1024, 64 * kb, 32 * nb, WoutT, 1024, 32 * nb, 0, scr, F.lane); continue; } r -= I_OUT;
        if (r < I_G) { const int e = r / 256, q = r % 256, kb = q / 16, nb = q % 16, n0 = 32 * nb;
            p0_transpose_item(F.w_ge + (size_t)e * 1024 * 512, 512, 64 * kb, n0, WguT + (size_t)e * 1024 * 1024, 1024, 256 * (n0 >> 7) + (n0 & 127), 0, scr, F.lane); continue; } r -= I_G;
        if (r < I_U) { const int e = r / 256, q = r % 256, kb = q / 16, nb = q % 16, n0 = 32 * nb;
            p0_transpose_item(F.w_ue + (size_t)e * 1024 * 512, 512, 64 * kb, n0, WguT + (size_t)e * 1024 * 1024, 1024, 256 * (n0 >> 7) + 128 + (n0 & 127), 0, scr, F.lane); continue; } r -= I_U;
        { const int e = r / 256, q = r % 256, kb = q / 32, nb = q % 32;
            p0_transpose_item(F.w_de + (size_t)e * 512 * 1024, 1024, 64 * kb, 32 * nb, WdT + (size_t)e * 1024 * 512, 512, 32 * nb, 0, scr, F.lane); }
    }
    bf16_t* XN = (bf16_t*)F.outb;
    f32x4 gv[4];
#pragma unroll
    for (int j = 0; j < 4; ++j) gv[j] = ((const GAS f32x4*)F.g1)[F.lane + 64 * j];
    for (int m = gw; m < T; m += NGW) {
        const GAS f32x4* xr = (const GAS f32x4*)(F.x + (size_t)m * DM) + F.lane;
        f32x4 v[4]; float s = 0.f;
#pragma unroll
        for (int j = 0; j < 4; ++j) { v[j] = xr[64 * j]; s += (v[j].x * v[j].x + v[j].y * v[j].y) + (v[j].z * v[j].z + v[j].w * v[j].w); }
        const float rstd = 1.0f / sqrtf(wave_sum(s) * (1.f / DM) + EPS);
        GAS u32x2* o8 = (GAS u32x2*)(XN + (size_t)m * DM) + F.lane;
#pragma unroll
        for (int j = 0; j < 4; ++j) { u32x2 w; w.x = pk2(v[j].x * rstd * gv[j].x, v[j].y * rstd * gv[j].y); w.y = pk2(v[j].z * rstd * gv[j].z, v[j].w * rstd * gv[j].w); o8[64 * j] = w; }
    }
}

struct DenseOrder {
    const char* A; const char* Bt; int nM, nN, nwg, G, c, ld, nt;
    __device__ __forceinline__ void tile(int wg, int& pm, int& pn) const {
        int wgid = wg; { const int q = nwg / 8, r = nwg % 8, xcd = wgid % 8, off = wgid / 8; wgid = (xcd < r ? xcd * (q + 1) : r * (q + 1) + (xcd - r) * q) + off; }
        const int nig = 8 * nN, gid = wgid / nig, fm = gid * 8, gsz = (nM - fm) < 8 ? (nM - fm) : 8;
        pm = fm + ((wgid % nig) % gsz); pn = (wgid % nig) / gsz;
    }
    __device__ __forceinline__ bool next(int i, pg8::Unit& u) const {
        const long L = (long)i * G + c; if (L >= nwg) return false;
        int pm, pn; tile((int)L, pm, pn);
        u.pm = pm; u.pn = pn; u.nt = nt; u.aux = 0;
        u.a = A + (size_t)pm * 256 * ld * 2; u.b = Bt + (size_t)pn * 256 * ld * 2; return true;
    }
};
struct UpOrder {
    DenseOrder d;
    __device__ __forceinline__ bool next(int i, pg8::Unit& u) const {
        const long L = (long)(i >> 1) * d.G + d.c; if (L >= d.nwg) return false;
        int pm, pn; d.tile((int)L, pm, pn);
        const int part = i & 1;
        u.pm = pm; u.pn = pn; u.aux = part; u.nt = part ? 16 : 8;
        u.a = d.A + (size_t)pm * 256 * ARW * 2 + (part ? 1024 : 0); u.b = d.Bt + (size_t)pn * 256 * ARW * 2 + (part ? 1024 : 0); return true;
    }
};
struct ExpertOrder {
    const char* A; const char* Bt; const volatile LAS int* tp; int ntiles, G, c, ldA, nt; size_t bstride  , bpn  ;
    __device__ __forceinline__ bool next(int i, pg8::Unit& u) const {
        const long L = (long)i * G + c; if (L >= (long)ntiles * 4) return false;
        const int tix = (int)(L >> 2), pn = (int)(L & 3);
        int e = 0;
        for (int k = 1; k < NEXP; ++k) e += (tix >= tp[k]) ? 1 : 0;
        u.pm = tix; u.pn = pn; u.nt = nt; u.aux = e;
        u.a = A + (size_t)tix * 256 * ldA * 2; u.b = Bt + (size_t)e * bstride + (size_t)pn * bpn; return true;
    }
};

struct EpiProj {
    static constexpr bool PERM = true;
    bf16_t* PA; bf16_t* GT; const float* bias;
    __device__ __forceinline__ void operator()(const pg8::Acc& acc, const pg8::Unit& u, int wr, int wc, int fr, int fq) const {
        const int ct = u.pn; const int mode = ct < 11 ? 0 : (ct < 15 ? 1 : 2);
        bf16_t* base; int ldc, colt;
        if (ct < 15) { base = PA; ldc = PAW; colt = ct * 256; } else { base = GT; ldc = GTW; colt = ct * 256 - PAW; }
        const int row0 = u.pm * 256 + wr * 64 + fr, col0 = colt + wc * 32 + 8 * fq, bcol0 = ct * 256 + wc * 32 + 8 * fq;
        f32x4 bv[2][2];
#pragma unroll
        for (int bj = 0; bj < 2; ++bj)
#pragma unroll
            for (int n = 0; n < 2; ++n) bv[bj][n] = *(const f32x4*)(bias + bcol0 + bj * 128 + 4 * n);
#pragma unroll
        for (int ai = 0; ai < 2; ++ai)
#pragma unroll
            for (int m = 0; m < 4; ++m) { bf16_t* rowp = base + (size_t)(row0 + ai * 128 + m * 16) * ldc + col0;
#pragma unroll
                for (int bj = 0; bj < 2; ++bj) { f32x4 v0 = acc[ai][bj][m][0] + bv[bj][0], v1 = acc[ai][bj][m][1] + bv[bj][1];
                    if (ct == 5 || ct == 6) {
                        const int hh = (bcol0 + bj * 128 - C_RK) >> 6, pos = (row0 + ai * 128 + m * 16) & 127;
                        const float ks = 0.125f * exp2f((float)(127 - pos) * log2f(1.0f - exp2f(-5.0f - (float)hh)));
                        v0 = v0 * ks; v1 = v1 * ks; }
                    if (mode != 0) {
#pragma unroll
                        for (int j = 0; j < 4; ++j) { const float s0 = sigmoidf_(v0[j]), s1 = sigmoidf_(v1[j]); v0[j] = (mode == 1) ? v0[j] * s0 : s0; v1[j] = (mode == 1) ? v1[j] * s1 : s1; } }
                    u32x4 w; w.x = cvt_pk_bf16(v0[0], v0[1]); w.y = cvt_pk_bf16(v0[2], v0[3]); w.z = cvt_pk_bf16(v1[0], v1[1]); w.w = cvt_pk_bf16(v1[2], v1[3]);
                    *(u32x4*)(rowp + bj * 128) = w; } }
    }
};
struct EpiUp {
    static constexpr bool PERM = true;
    bf16_t* MIX; const bf16_t* GT;
    __device__ __forceinline__ void operator()(const pg8::Acc& acc, const pg8::Unit& u, int wr, int wc, int fr, int fq) const {
        const int part = u.aux;
        const int row0 = u.pm * 256 + wr * 64 + fr, col0 = u.pn * 256 + wc * 32 + 8 * fq;
#pragma unroll
        for (int ai = 0; ai < 2; ++ai) {
            u32x4 g[4][2], p[4][2];
#pragma unroll
            for (int m = 0; m < 4; ++m)
#pragma unroll
                for (int bj = 0; bj < 2; ++bj) { const size_t row = (size_t)(row0 + ai * 128 + m * 16);
                    g[m][bj] = __builtin_nontemporal_load((const u32x4*)(GT + row * GTW + part * 1024 + col0 + bj * 128));
                    p[m][bj] = part ? *(const u32x4*)(MIX + row * DM + col0 + bj * 128) : (u32x4){0u, 0u, 0u, 0u}; }
            asm volatile("" ::: "memory");
#pragma unroll
            for (int m = 0; m < 4; ++m)
#pragma unroll
                for (int bj = 0; bj < 2; ++bj) { const size_t row = (size_t)(row0 + ai * 128 + m * 16);
                    const f32x4 a0 = acc[ai][bj][m][0], a1 = acc[ai][bj][m][1]; const u32x4 gg = g[m][bj], pp = p[m][bj];
                    float r[8];
                    r[0] = bflo(gg.x) * a0[0] + bflo(pp.x); r[1] = bfhi(gg.x) * a0[1] + bfhi(pp.x); r[2] = bflo(gg.y) * a0[2] + bflo(pp.y); r[3] = bfhi(gg.y) * a0[3] + bfhi(pp.y);
                    r[4] = bflo(gg.z) * a1[0] + bflo(pp.z); r[5] = bfhi(gg.z) * a1[1] + bfhi(pp.z); r[6] = bflo(gg.w) * a1[2] + bflo(pp.w); r[7] = bfhi(gg.w) * a1[3] + bfhi(pp.w);
                    u32x4 w; w.x = cvt_pk_bf16(r[0], r[1]); w.y = cvt_pk_bf16(r[2], r[3]); w.z = cvt_pk_bf16(r[4], r[5]); w.w = cvt_pk_bf16(r[6], r[7]);
                    *(u32x4*)(MIX + row * DM + col0 + bj * 128) = w; }
            asm volatile("" ::: "memory");
        }
    }
};
struct EpiOut {
    static constexpr bool PERM = false;
    const float* x; float* X2;
    __device__ __forceinline__ void operator()(const pg8::Acc& acc, const pg8::Unit& u, int wr, int wc, int fr, int fq) const {
        const int row0 = u.pm * 256 + wr * 64 + fr, col0 = u.pn * 256 + wc * 32 + 4 * fq;
#pragma unroll
        for (int ai = 0; ai < 2; ++ai) {
            f32x4 xv[4][2][2];
#pragma unroll
            for (int m = 0; m < 4; ++m) { const size_t off = (size_t)(row0 + ai * 128 + m * 16) * DM + col0;
#pragma unroll
                for (int bj = 0; bj < 2; ++bj)
#pragma unroll
                    for (int n = 0; n < 2; ++n) xv[m][bj][n] = __builtin_nontemporal_load((const f32x4*)(x + off + bj * 128 + n * 16)); }
            asm volatile("" ::: "memory");
#pragma unroll
            for (int m = 0; m < 4; ++m) { const size_t off = (size_t)(row0 + ai * 128 + m * 16) * DM + col0;
#pragma unroll
                for (int bj = 0; bj < 2; ++bj)
#pragma unroll
                    for (int n = 0; n < 2; ++n) *(f32x4*)(X2 + off + bj * 128 + n * 16) = xv[m][bj][n] + acc[ai][bj][m][n]; }
            asm volatile("" ::: "memory");
        }
    }
};
struct EpiSwiglu {
    static constexpr bool PERM = true;
    bf16_t* ACT;
    __device__ __forceinline__ void operator()(const pg8::Acc& acc, const pg8::Unit& u, int wr, int wc, int fr, int fq) const {
        const int row0 = u.pm * 256 + wr * 64 + fr, col0 = u.pn * 128 + wc * 32 + 8 * fq;
#pragma unroll
        for (int ai = 0; ai < 2; ++ai)
#pragma unroll
            for (int m = 0; m < 4; ++m) { bf16_t* rowp = ACT + (size_t)(row0 + ai * 128 + m * 16) * DEXP + col0;
                float r[8];
#pragma unroll
                for (int n = 0; n < 2; ++n)
#pragma unroll
                    for (int j = 0; j < 4; ++j) { const float g = acc[ai][0][m][n][j], up = acc[ai][1][m][n][j]; r[4 * n + j] = g * sigmoidf_(g) * up; }
                u32x4 w; w.x = cvt_pk_bf16(r[0], r[1]); w.y = cvt_pk_bf16(r[2], r[3]); w.z = cvt_pk_bf16(r[4], r[5]); w.w = cvt_pk_bf16(r[6], r[7]);
                *(u32x4*)rowp = w; }
    }
};
struct EpiDown {
    static constexpr bool PERM = true;
    bf16_t* YB;
    __device__ __forceinline__ void operator()(const pg8::Acc& acc, const pg8::Unit& u, int wr, int wc, int fr, int fq) const {
        const int row0 = u.pm * 256 + wr * 64 + fr, col0 = u.pn * 256 + wc * 32 + 8 * fq;
#pragma unroll
        for (int ai = 0; ai < 2; ++ai)
#pragma unroll
            for (int m = 0; m < 4; ++m) { bf16_t* rowp = YB + (size_t)(row0 + ai * 128 + m * 16) * DM + col0;
#pragma unroll
                for (int bj = 0; bj < 2; ++bj) { const f32x4 v0 = acc[ai][bj][m][0], v1 = acc[ai][bj][m][1];
                    u32x4 w; w.x = cvt_pk_bf16(v0[0], v0[1]); w.y = cvt_pk_bf16(v0[2], v0[3]); w.z = cvt_pk_bf16(v1[0], v1[1]); w.w = cvt_pk_bf16(v1[2], v1[3]);
                    *(u32x4*)(rowp + bj * 128) = w; } }
    }
};

__device__ __forceinline__ void ld8bf(const bf16_t* p, float* o) { const u32x4 w = *(const u32x4*)p; o[0] = bflo(w.x); o[1] = bfhi(w.x); o[2] = bflo(w.y); o[3] = bfhi(w.y); o[4] = bflo(w.z); o[5] = bfhi(w.z); o[6] = bflo(w.w); o[7] = bfhi(w.w); }
__device__ __forceinline__ void p2_attention_naive(Frame& F, int u0, int ustride) {
    LAS float* Ks = (LAS float*)F.lds;
    LAS float* Vs = Ks + 256 * 68;
    const bf16_t* PA = (const bf16_t*)(F.ws + WS_PA); bf16_t* AR = (bf16_t*)F.outb;
    const int tid = F.tid, part = tid & 7;
    for (int unit = u0; unit < NB * 16 * 8; unit += ustride) {
        const int h = unit & 7, n = (unit >> 3) & 15, b = unit >> 7, kvh = h >> 2;
        const size_t tok0 = (size_t)b * SEQ + n * 128;
        __syncthreads();
        for (int idx = tid; idx < 256 * 8; idx += 512) {
            const int j = idx >> 3, c = idx & 7;
            float kf[8], vf[8];
            if (n == 0 && j < 128) {
#pragma unroll
                for (int i = 0; i < 8; ++i) { kf[i] = 0.f; vf[i] = 0.f; }
            } else {
                const bf16_t* rp = PA + (tok0 - 128 + j) * PAW;
                ld8bf(rp + C_AK + kvh * 64 + c * 8, kf); ld8bf(rp + C_AV + kvh * 64 + c * 8, vf);
            }
            *(LAS f32x4*)(Ks + j * 68 + c * 8) = (f32x4){kf[0], kf[1], kf[2], kf[3]}; *(LAS f32x4*)(Ks + j * 68 + c * 8 + 4) = (f32x4){kf[4], kf[5], kf[6], kf[7]};
            *(LAS f32x4*)(Vs + j * 68 + c * 8) = (f32x4){vf[0], vf[1], vf[2], vf[3]}; *(LAS f32x4*)(Vs + j * 68 + c * 8 + 4) = (f32x4){vf[4], vf[5], vf[6], vf[7]};
        }
        __syncthreads();
        const float slope = exp2f(-(float)(h + 1)), sink = F.sinks[h];
        for (int qh = 0; qh < 2; ++qh) {
            const int q = qh * 64 + (tid >> 3);
            const size_t tq = tok0 + q;
            float qr[64];
#pragma unroll
            for (int c = 0; c < 8; ++c) ld8bf(PA + tq * PAW + C_AQ + h * 64 + c * 8, qr + 8 * c);
            float o[64];
#pragma unroll
            for (int d = 0; d < 64; ++d) o[d] = 0.f;
            float mx = sink, den = (part == 0) ? 1.0f : 0.0f;
#pragma unroll 1
            for (int jj = 0; jj < 32; ++jj) {
                const int j = part + 8 * jj, dist = q + 128 - j;
                const bool valid = dist >= 0 && dist < 128 && (n > 0 || j >= 128);
                if (valid) {
                    float d = 0.f;
                    const LAS f32x4* kp = (const LAS f32x4*)(Ks + j * 68);
#pragma unroll
                    for (int c = 0; c < 16; ++c) { const f32x4 kv = kp[c]; d += qr[4 * c] * kv.x + qr[4 * c + 1] * kv.y + qr[4 * c + 2] * kv.z + qr[4 * c + 3] * kv.w; }
                    const float sc = d * 0.125f - slope * (float)dist;
                    const float mn = fmaxf(mx, sc), f = __expf(mx - mn), p = __expf(sc - mn);
                    mx = mn; den = den * f + p;
                    const LAS f32x4* vp = (const LAS f32x4*)(Vs + j * 68);
#pragma unroll
                    for (int c = 0; c < 16; ++c) { const f32x4 vv = vp[c]; o[4 * c] = o[4 * c] * f + p * vv.x; o[4 * c + 1] = o[4 * c + 1] * f + p * vv.y; o[4 * c + 2] = o[4 * c + 2] * f + p * vv.z; o[4 * c + 3] = o[4 * c + 3] * f + p * vv.w; }
                }
            }
            float ma = fmaxf(mx, __shfl_xor(mx, 1)); ma = fmaxf(ma, __shfl_xor(ma, 2)); ma = fmaxf(ma, __shfl_xor(ma, 4));
            const float fs = __expf(mx - ma);
            den *= fs; den += __shfl_xor(den, 1); den += __shfl_xor(den, 2); den += __shfl_xor(den, 4);
            const float inv = 1.0f / den;
#pragma unroll
            for (int d = 0; d < 64; ++d) { o[d] *= fs; o[d] += __shfl_xor(o[d], 1); o[d] += __shfl_xor(o[d], 2); o[d] += __shfl_xor(o[d], 4); }
            if (part == 0) {
                bf16_t* op = AR + tq * ARW + h * 64;
#pragma unroll
                for (int c = 0; c < 8; ++c) { u32x4 w0; w0.x = pk2(o[8 * c] * inv, o[8 * c + 1] * inv); w0.y = pk2(o[8 * c + 2] * inv, o[8 * c + 3] * inv); w0.z = pk2(o[8 * c + 4] * inv, o[8 * c + 5] * inv); w0.w = pk2(o[8 * c + 6] * inv, o[8 * c + 7] * inv);
                    *(u32x4*)(op + 8 * c) = w0; }
            }
        }
    }
}
__device__ __forceinline__ void p2_retention_naive(Frame& F, int u0, int ustride) {
    LAS float* Qs = (LAS float*)F.lds;
    LAS float* Ks = Qs + 128 * 68;
    LAS bf16_t* Vs = (LAS bf16_t*)(Ks + 128 * 68);
    LAS float* Ss = (LAS float*)(Vs + 128 * 136);
    const bf16_t* PA = (const bf16_t*)(F.ws + WS_PA); bf16_t* AR = (bf16_t*)F.outb;
    const int tid = F.tid;
    for (int unit = u0; unit < NB * 8; unit += ustride) {
        const int h = unit & 7, b = unit >> 3;
        const float lg = log2f(1.0f - exp2f(-5.0f - (float)h));
        __syncthreads();
        for (int idx = tid; idx < 64 * 128; idx += 512) Ss[idx] = 0.f;
        for (int n = 0; n < 16; ++n) {
            const size_t tok0 = (size_t)b * SEQ + n * 128;
            __syncthreads();
            for (int idx = tid; idx < 128 * 8; idx += 512) {
                const int j = idx >> 3, c = idx & 7; const bf16_t* rp = PA + (tok0 + j) * PAW;
                float qf[8], kf[8]; ld8bf(rp + C_RQ + h * 64 + c * 8, qf); ld8bf(rp + C_RK + h * 64 + c * 8, kf);
                *(LAS f32x4*)(Qs + j * 68 + c * 8) = (f32x4){qf[0], qf[1], qf[2], qf[3]}; *(LAS f32x4*)(Qs + j * 68 + c * 8 + 4) = (f32x4){qf[4], qf[5], qf[6], qf[7]};
                *(LAS f32x4*)(Ks + j * 68 + c * 8) = (f32x4){kf[0], kf[1], kf[2], kf[3]}; *(LAS f32x4*)(Ks + j * 68 + c * 8 + 4) = (f32x4){kf[4], kf[5], kf[6], kf[7]};
            }
            for (int idx = tid; idx < 128 * 16; idx += 512) {
                const int j = idx >> 4, c = idx & 15;
                *(LAS u32x4*)(Vs + j * 136 + c * 8) = *(const u32x4*)(PA + (tok0 + j) * PAW + C_RV + h * 128 + c * 8);
            }
            __syncthreads();
            {
                const int i = tid >> 2, part = tid & 3;
                float qreg[16];
#pragma unroll
                for (int c = 0; c < 4; ++c) { const f32x4 v = *(const LAS f32x4*)(Qs + i * 68 + 16 * part + 4 * c); qreg[4 * c] = v.x; qreg[4 * c + 1] = v.y; qreg[4 * c + 2] = v.z; qreg[4 * c + 3] = v.w; }
                float y[32];
#pragma unroll
                for (int e = 0; e < 32; ++e) y[e] = 0.f;
                const int jmax = i | 15;
                for (int j = 0; j <= jmax; ++j) {
                    float sdot = 0.f;
#pragma unroll
                    for (int c = 0; c < 4; ++c) { const f32x4 kv = *(const LAS f32x4*)(Ks + j * 68 + 16 * part + 4 * c); sdot += qreg[4 * c] * kv.x + qreg[4 * c + 1] * kv.y + qreg[4 * c + 2] * kv.z + qreg[4 * c + 3] * kv.w; }
                    sdot += __shfl_xor(sdot, 1); sdot += __shfl_xor(sdot, 2);
                    const float w = (j <= i) ? sdot * 0.125f * exp2f((float)(i - j) * lg) : 0.f;
#pragma unroll
                    for (int c = 0; c < 4; ++c) { const u32x4 vv = *(const LAS u32x4*)(Vs + j * 136 + 32 * part + 8 * c);
                        y[8 * c] += w * bflo(vv.x); y[8 * c + 1] += w * bfhi(vv.x); y[8 * c + 2] += w * bflo(vv.y); y[8 * c + 3] += w * bfhi(vv.y);
                        y[8 * c + 4] += w * bflo(vv.z); y[8 * c + 5] += w * bfhi(vv.z); y[8 * c + 6] += w * bflo(vv.w); y[8 * c + 7] += w * bfhi(vv.w); }
                }
                const float gi = exp2f((float)(i + 1) * lg);
                for (int d = 0; d < 64; ++d) {
                    const float qd = Qs[i * 68 + d] * gi;
#pragma unroll
                    for (int c = 0; c < 8; ++c) { const f32x4 sv = *(const LAS f32x4*)(Ss + d * 128 + 32 * part + 4 * c); y[4 * c] += qd * sv.x; y[4 * c + 1] += qd * sv.y; y[4 * c + 2] += qd * sv.z; y[4 * c + 3] += qd * sv.w; }
                }
                float sum = 0.f;
#pragma unroll
                for (int e = 0; e < 32; ++e) sum += y[e];
                sum += __shfl_xor(sum, 1); sum += __shfl_xor(sum, 2);
                const float mu = sum * (1.f / 128.f); float var = 0.f;
#pragma unroll
                for (int e = 0; e < 32; ++e) { y[e] -= mu; var += y[e] * y[e]; }
                var += __shfl_xor(var, 1); var += __shfl_xor(var, 2);
                const float rstd = 1.0f / sqrtf(var * (1.f / 128.f) + EPS);
                const size_t t = tok0 + i;
                const bf16_t* gp = PA + t * PAW + C_RG + h * 128 + 32 * part;
                bf16_t* op = AR + t * ARW + 512 + h * 128 + 32 * part;
#pragma unroll
                for (int c = 0; c < 4; ++c) { float g[8]; ld8bf(gp + 8 * c, g);
                    u32x4 w; w.x = pk2(y[8 * c] * rstd * g[0], y[8 * c + 1] * rstd * g[1]); w.y = pk2(y[8 * c + 2] * rstd * g[2], y[8 * c + 3] * rstd * g[3]);
                    w.z = pk2(y[8 * c + 4] * rstd * g[4], y[8 * c + 5] * rstd * g[5]); w.w = pk2(y[8 * c + 6] * rstd * g[6], y[8 * c + 7] * rstd * g[7]);
                    *(u32x4*)(op + 8 * c) = w; }
            }
            __syncthreads();
            {
                const int d = tid >> 3, eg = tid & 7;
                const float cd = exp2f(128.f * lg);
                float a[16];
#pragma unroll
                for (int c = 0; c < 4; ++c) { const f32x4 sv = *(const LAS f32x4*)(Ss + d * 128 + 16 * eg + 4 * c); a[4 * c] = sv.x * cd; a[4 * c + 1] = sv.y * cd; a[4 * c + 2] = sv.z * cd; a[4 * c + 3] = sv.w * cd; }
                for (int j = 0; j < 128; ++j) {
                    const float kd = Ks[j * 68 + d] * 0.125f * exp2f((float)(127 - j) * lg);
#pragma unroll
                    for (int c = 0; c < 2; ++c) { const u32x4 vv = *(const LAS u32x4*)(Vs + j * 136 + 16 * eg + 8 * c);
                        a[8 * c] += kd * bflo(vv.x); a[8 * c + 1] += kd * bfhi(vv.x); a[8 * c + 2] += kd * bflo(vv.y); a[8 * c + 3] += kd * bfhi(vv.y);
                        a[8 * c + 4] += kd * bflo(vv.z); a[8 * c + 5] += kd * bfhi(vv.z); a[8 * c + 6] += kd * bflo(vv.w); a[8 * c + 7] += kd * bfhi(vv.w); }
                }
#pragma unroll
                for (int c = 0; c < 4; ++c) *(LAS f32x4*)(Ss + d * 128 + 16 * eg + 4 * c) = (f32x4){a[4 * c], a[4 * c + 1], a[4 * c + 2], a[4 * c + 3]};
            }
        }
    }
}

typedef float f32x16 __attribute__((ext_vector_type(16)));
typedef short s16x4 __attribute__((ext_vector_type(4)));
__device__ __forceinline__ int crow(int r, int hi) { return (r & 3) + 8 * (r >> 2) + 4 * hi; }
__device__ __forceinline__ s16x4 ds_tr16(const LAS unsigned char* p) { return __builtin_bit_cast(s16x4, __builtin_amdgcn_ds_read_tr16_b64_v4i16((LAS s16x4*)p)); }
__device__ __forceinline__ bf16x8 pack8(const f32x16& p, int b) {
    u32x4 w; w.x = cvt_pk_bf16(p[b], p[b + 1]); w.y = cvt_pk_bf16(p[b + 2], p[b + 3]); w.z = cvt_pk_bf16(p[b + 4], p[b + 5]); w.w = cvt_pk_bf16(p[b + 6], p[b + 7]);
    return __builtin_bit_cast(bf16x8, w);
}
constexpr int AT_K = 0, AT_V = 36864, AT_WS = AT_V + 32768, AT_OST = AT_WS + 8 * 128, AT_END = AT_OST + 8 * 4096;
static_assert(AT_END <= SCRATCH_BYTES, "attention LDS");
__device__ __forceinline__ void p2_attention_mfma(Frame& F, int u0, int ustride) {
    const bf16_t* PA = (const bf16_t*)(F.ws + WS_PA); bf16_t* AR = (bf16_t*)F.outb;
    LAS unsigned char* lds = F.lds;
    const int tid = F.tid, lane = F.lane, wid = F.wave, r32 = lane & 31, hi = lane >> 5;
    const int g = wid >> 1, qhalf = wid & 1;
    constexpr float LOG2E = 1.4426950408889634f;
    for (int unit = u0; unit < NB * 16 * 2; unit += ustride) {
        const int kvh = unit & 1, n = (unit >> 1) & 15, b = unit >> 5;
        const size_t tok0 = (size_t)b * SEQ + n * 128;
        __syncthreads();
#pragma unroll
        for (int it = 0; it < 4; ++it) {
            const int idx = tid + 512 * it, j = idx >> 3, c = idx & 7;
            u32x4 kv = (u32x4){0u, 0u, 0u, 0u}, vv = (u32x4){0u, 0u, 0u, 0u};
            if (n > 0 || j >= 128) { const bf16_t* rp = PA + (tok0 - 128 + j) * PAW; kv = *(const u32x4*)(rp + C_AK + kvh * 64 + c * 8); vv = *(const u32x4*)(rp + C_AV + kvh * 64 + c * 8); }
            *(LAS u32x4*)(lds + AT_K + j * 144 + c * 16) = kv;
            *(LAS u32x4*)(lds + AT_V + (c >> 2) * 16384 + (j >> 4) * 1024 + (j & 15) * 64 + (c & 3) * 16) = vv;
        }
        __syncthreads();
        const int hd = kvh * 4 + g;
        const float SL = exp2f(-(float)(hd + 1)) * LOG2E, SC = 0.125f * LOG2E, sink2 = F.sinks[hd] * LOG2E;
#pragma unroll 1
        for (int qb = 0; qb < 2; ++qb) {
            const int m = qhalf * 2 + qb, i0 = 32 * m;
            bf16x8 qr[4];
            { const bf16_t* qp = PA + (tok0 + i0 + r32) * PAW + C_AQ + hd * 64 + hi * 8;
#pragma unroll
              for (int s = 0; s < 4; ++s) qr[s] = *(const bf16x8*)(qp + 16 * s); }
            f32x16 p[5];
#pragma unroll
            for (int c = 0; c < 5; ++c) {
                const LAS unsigned char* kp = lds + AT_K + (32 * (m + c) + r32) * 144 + hi * 16;
                f32x16 a;
#pragma unroll
                for (int r = 0; r < 16; ++r) a[r] = 0.f;
#pragma unroll
                for (int s = 0; s < 4; ++s) a = __builtin_amdgcn_mfma_f32_32x32x16_bf16(*(const LAS bf16x8*)(kp + s * 32), qr[s], a, 0, 0, 0);
                p[c] = a;
            }
            const int iq = i0 + r32;
            float mx = sink2;
#pragma unroll
            for (int c = 0; c < 5; ++c)
#pragma unroll
                for (int r = 0; r < 16; ++r) {
                    const int j = 32 * (m + c) + crow(r, hi), dist = iq + 128 - j;
                    const bool valid = dist >= 0 && dist < 128 && (n > 0 || j >= 128);
                    const float t = valid ? p[c][r] * SC - SL * (float)dist : -1e30f;
                    p[c][r] = t; mx = fmaxf(mx, t);
                }
            mx = fmaxf(mx, __shfl_xor(mx, 32));
            float sum = 0.f;
#pragma unroll
            for (int c = 0; c < 5; ++c)
#pragma unroll
                for (int r = 0; r < 16; ++r) { const float e = __builtin_amdgcn_exp2f(p[c][r] - mx); p[c][r] = e; sum += e; }
            sum += __shfl_xor(sum, 32);
            const float den = sum + __builtin_amdgcn_exp2f(sink2 - mx);
            bf16x8 pa[5][2];
#pragma unroll
            for (int c = 0; c < 5; ++c) { pa[c][0] = pack8(p[c], 0); pa[c][1] = pack8(p[c], 8); }
            f32x16 o[2];
#pragma unroll
            for (int d0 = 0; d0 < 2; ++d0) {
                f32x16 a;
#pragma unroll
                for (int r = 0; r < 16; ++r) a[r] = 0.f;
#pragma unroll
                for (int c = 0; c < 5; ++c)
#pragma unroll
                    for (int s = 0; s < 2; ++s) {
                        const LAS unsigned char* vb = lds + AT_V + d0 * 16384 + (2 * (m + c) + s) * 1024 + ((lane >> 4) & 1) * 32 + (lane & 3) * 8 + (4 * hi + ((lane & 15) >> 2)) * 64;
                        const s16x4 lo = ds_tr16(vb), h4 = ds_tr16(vb + 512);
                        const bf16x8 vf = (bf16x8){lo[0], lo[1], lo[2], lo[3], h4[0], h4[1], h4[2], h4[3]};
                        a = __builtin_amdgcn_mfma_f32_32x32x16_bf16(pa[c][s], vf, a, 0, 0, 0);
                    }
                o[d0] = a;
            }
            LAS float* wsf = (LAS float*)(lds + AT_WS + wid * 128);
            asm volatile("s_waitcnt lgkmcnt(0)" ::: "memory");
            if (hi == 0) wsf[r32] = den;
            asm volatile("s_waitcnt lgkmcnt(0)" ::: "memory");
            float rinv[16];
#pragma unroll
            for (int r = 0; r < 16; ++r) rinv[r] = 1.0f / wsf[crow(r, hi)];
            LAS bf16_t* stg = (LAS bf16_t*)(lds + AT_OST + wid * 4096);
#pragma unroll
            for (int r = 0; r < 16; ++r)
#pragma unroll
                for (int d0 = 0; d0 < 2; ++d0) stg[crow(r, hi) * 64 + d0 * 32 + r32] = (bf16_t)f2bf(o[d0][r] * rinv[r]);
            asm volatile("s_waitcnt lgkmcnt(0)" ::: "memory");
#pragma unroll
            for (int it = 0; it < 4; ++it) { const int row = it * 8 + (lane >> 3), ch = lane & 7;
                const u32x4 v = *(const LAS u32x4*)(stg + row * 64 + ch * 8);
                *(u32x4*)(AR + (tok0 + i0 + row) * ARW + hd * 64 + ch * 8) = v; }
            asm volatile("s_waitcnt lgkmcnt(0)" ::: "memory");
        }
    }
}

constexpr int RT_KR = 0, RT_KT = 18432, RT_V = RT_KT + 16384, RT_ST = RT_V + 32768, RT_RED = RT_ST + 18432, RT_OST = RT_RED + 2048, RT_Q = RT_OST + 8 * 4608, RT_END = RT_Q + 18432;
static_assert(RT_END <= SCRATCH_BYTES, "retention LDS");
__device__ __forceinline__ u32x4 scale8bf(u32x4 w, float s) {
    u32x4 o; o.x = pk2(bflo(w.x) * s, bfhi(w.x) * s); o.y = pk2(bflo(w.y) * s, bfhi(w.y) * s); o.z = pk2(bflo(w.z) * s, bfhi(w.z) * s); o.w = pk2(bflo(w.w) * s, bfhi(w.w) * s); return o;
}
__device__ __forceinline__ bf16x8 tr_frag(const LAS unsigned char* p) {
    const s16x4 lo = ds_tr16(p), h4 = ds_tr16(p + 512);
    return (bf16x8){lo[0], lo[1], lo[2], lo[3], h4[0], h4[1], h4[2], h4[3]};
}
__device__ __forceinline__ void p2_retention_mfma(Frame& F, int u0, int ustride) {
    const bf16_t* PA = (const bf16_t*)(F.ws + WS_PA); bf16_t* AR = (bf16_t*)F.outb;
    LAS unsigned char* lds = F.lds;
    const int tid = F.tid, lane = F.lane, wid = F.wave, r32 = lane & 31, hi = lane >> 5;
    const int ib = wid >> 1, eh = wid & 1;
    const int sdb = wid & 1, seb = wid >> 1;
    const int troff = ((lane >> 4) & 1) * 32 + (lane & 3) * 8 + (4 * hi + ((lane & 15) >> 2)) * 64;
    for (int unit = u0; unit < NB * 8; unit += ustride) {
        const int h = unit & 7, b = unit >> 3;
        const float lg = log2f(1.0f - exp2f(-5.0f - (float)h));
        const float fac_i = exp2f((float)(32 * ib + r32 - 127) * lg), gi1 = exp2f((float)(32 * ib + r32 + 1) * lg), cd = exp2f(128.0f * lg);
        f32x16 st;
#pragma unroll
        for (int r = 0; r < 16; ++r) st[r] = 0.f;
        __syncthreads();
        for (int idx = tid; idx < 18432 / 4; idx += 512) ((LAS unsigned*)(lds + RT_ST))[idx] = 0u;
        u32x4 kreg[2], vreg[4], qreg[2];
        {
            const size_t tok0 = (size_t)b * SEQ;
#pragma unroll
            for (int it = 0; it < 2; ++it) { const int idx = tid + 512 * it, j = idx >> 3, c = idx & 7; kreg[it] = *(const u32x4*)(PA + (tok0 + j) * PAW + C_RK + h * 64 + c * 8); }
#pragma unroll
            for (int it = 0; it < 4; ++it) { const int idx = tid + 512 * it, j = idx >> 4, c = idx & 15; vreg[it] = *(const u32x4*)(PA + (tok0 + j) * PAW + C_RV + h * 128 + c * 8); }
#pragma unroll
            for (int it = 0; it < 2; ++it) { const int idx = tid + 512 * it, j = idx >> 3, c = idx & 7; qreg[it] = *(const u32x4*)(PA + (tok0 + j) * PAW + C_RQ + h * 64 + c * 8); }
        }
#pragma unroll 1
        for (int n = 0; n < 16; ++n) {
            const size_t tok0 = (size_t)b * SEQ + n * 128;
#pragma unroll
            for (int it = 0; it < 2; ++it) { const int idx = tid + 512 * it, j = idx >> 3, c = idx & 7;
                const u32x4 kk = kreg[it];
                *(LAS u32x4*)(lds + RT_KR + j * 144 + c * 16) = kk;
                *(LAS u32x4*)(lds + RT_KT + (c >> 2) * 8192 + (j >> 4) * 1024 + (j & 15) * 64 + (c & 3) * 16) = kk;
                *(LAS u32x4*)(lds + RT_Q + j * 144 + c * 16) = qreg[it]; }
#pragma unroll
            for (int it = 0; it < 4; ++it) { const int idx = tid + 512 * it, j = idx >> 4, c = idx & 15;
                *(LAS u32x4*)(lds + RT_V + (c >> 2) * 8192 + (j >> 4) * 1024 + (j & 15) * 64 + (c & 3) * 16) = vreg[it]; }
            __syncthreads();
            if (n < 15) {
                const size_t tokn = tok0 + 128;
#pragma unroll
                for (int it = 0; it < 2; ++it) { const int idx = tid + 512 * it, j = idx >> 3, c = idx & 7; kreg[it] = *(const u32x4*)(PA + (tokn + j) * PAW + C_RK + h * 64 + c * 8); }
#pragma unroll
                for (int it = 0; it < 4; ++it) { const int idx = tid + 512 * it, j = idx >> 4, c = idx & 15; vreg[it] = *(const u32x4*)(PA + (tokn + j) * PAW + C_RV + h * 128 + c * 8); }
#pragma unroll
                for (int it = 0; it < 2; ++it) { const int idx = tid + 512 * it, j = idx >> 3, c = idx & 7; qreg[it] = *(const u32x4*)(PA + (tokn + j) * PAW + C_RQ + h * 64 + c * 8); }
            }
            u32x4 rgreg[4];
#pragma unroll
            for (int it = 0; it < 4; ++it) { const int row = it * 8 + (lane >> 3), ch = lane & 7; rgreg[it] = *(const u32x4*)(PA + (tok0 + 32 * ib + row) * PAW + C_RG + h * 128 + 64 * eh + 8 * ch); }
            bf16x8 qr[4];
#pragma unroll
            for (int s = 0; s < 4; ++s) qr[s] = *(const LAS bf16x8*)(lds + RT_Q + (32 * ib + r32) * 144 + s * 32 + hi * 16);
            bf16x8 pb[4][2];
#pragma unroll
            for (int jb = 0; jb < 4; ++jb) {
                if (jb <= ib) {
                    const LAS unsigned char* kp = lds + RT_KR + (32 * jb + r32) * 144 + hi * 16;
                    f32x16 a;
#pragma unroll
                    for (int r = 0; r < 16; ++r) a[r] = 0.f;
#pragma unroll
                    for (int s = 0; s < 4; ++s) a = __builtin_amdgcn_mfma_f32_32x32x16_bf16(*(const LAS bf16x8*)(kp + s * 32), qr[s], a, 0, 0, 0);
                    const bool diag = (jb == ib);
#pragma unroll
                    for (int r = 0; r < 16; ++r) a[r] = (!diag || crow(r, hi) <= r32) ? a[r] * fac_i : 0.f;
                    pb[jb][0] = pack8(a, 0); pb[jb][1] = pack8(a, 8);
                    asm volatile("" ::: "memory");
                } else { pb[jb][0] = (bf16x8){0, 0, 0, 0, 0, 0, 0, 0}; pb[jb][1] = (bf16x8){0, 0, 0, 0, 0, 0, 0, 0}; }
            }
            f32x16 y[2];
#pragma unroll
            for (int t = 0; t < 2; ++t) {
                const int eb = 2 * eh + t;
                const LAS unsigned char* sp = lds + RT_ST + (32 * eb + r32) * 144 + hi * 16;
                f32x16 a;
#pragma unroll
                for (int r = 0; r < 16; ++r) a[r] = 0.f;
#pragma unroll
                for (int s = 0; s < 4; ++s) a = __builtin_amdgcn_mfma_f32_32x32x16_bf16(*(const LAS bf16x8*)(sp + s * 32), qr[s], a, 0, 0, 0);
#pragma unroll
                for (int r = 0; r < 16; ++r) a[r] *= gi1;
#pragma unroll
                for (int jb = 0; jb < 4; ++jb) {
                    if (jb <= ib) {
#pragma unroll
                        for (int s2 = 0; s2 < 2; ++s2) {
                            const bf16x8 vf = tr_frag(lds + RT_V + eb * 8192 + (2 * jb + s2) * 1024 + troff);
                            a = __builtin_amdgcn_mfma_f32_32x32x16_bf16(vf, pb[jb][s2], a, 0, 0, 0);
                        }
                        asm volatile("" ::: "memory");
                    }
                }
                y[t] = a;
            }
            float s1 = 0.f, s2 = 0.f;
#pragma unroll
            for (int t = 0; t < 2; ++t)
#pragma unroll
                for (int r = 0; r < 16; ++r) { s1 += y[t][r]; s2 += y[t][r] * y[t][r]; }
            s1 += __shfl_xor(s1, 32); s2 += __shfl_xor(s2, 32);
            if (hi == 0) *(LAS f32x2*)(lds + RT_RED + (wid * 32 + r32) * 8) = (f32x2){s1, s2};
#pragma unroll
            for (int r = 0; r < 16; ++r) st[r] *= cd;
#pragma unroll
            for (int sp = 0; sp < 8; ++sp) {
                const bf16x8 kf = tr_frag(lds + RT_KT + sdb * 8192 + sp * 1024 + troff);
                const bf16x8 vf = tr_frag(lds + RT_V + seb * 8192 + sp * 1024 + troff);
                st = __builtin_amdgcn_mfma_f32_32x32x16_bf16(kf, vf, st, 0, 0, 0);
                if (sp & 1) asm volatile("" ::: "memory");
            }
            __syncthreads();
            {
                const f32x2 o = *(const LAS f32x2*)(lds + RT_RED + ((wid ^ 1) * 32 + r32) * 8);
                const float mu = (s1 + o.x) * (1.f / 128.f), var = (s2 + o.y) * (1.f / 128.f) - mu * mu, rstd = 1.0f / sqrtf(fmaxf(var, 0.f) + EPS);
                LAS unsigned char* stg = lds + RT_OST + wid * 4608;
#pragma unroll
                for (int t = 0; t < 2; ++t)
#pragma unroll
                    for (int gq = 0; gq < 4; ++gq) {
                        u32x2 w; w.x = cvt_pk_bf16((y[t][4 * gq] - mu) * rstd, (y[t][4 * gq + 1] - mu) * rstd); w.y = cvt_pk_bf16((y[t][4 * gq + 2] - mu) * rstd, (y[t][4 * gq + 3] - mu) * rstd);
                        *(LAS u32x2*)(stg + r32 * 144 + (32 * t + 8 * gq + 4 * hi) * 2) = w; }
#pragma unroll
                for (int gq = 0; gq < 4; ++gq) {
                    u32x2 w; w.x = cvt_pk_bf16(st[4 * gq], st[4 * gq + 1]); w.y = cvt_pk_bf16(st[4 * gq + 2], st[4 * gq + 3]);
                    *(LAS u32x2*)(lds + RT_ST + (32 * seb + r32) * 144 + (32 * sdb + 8 * gq + 4 * hi) * 2) = w; }
                asm volatile("s_waitcnt lgkmcnt(0)" ::: "memory");
#pragma unroll
                for (int it = 0; it < 4; ++it) { const int row = it * 8 + (lane >> 3), ch = lane & 7;
                    const u32x4 v = *(const LAS u32x4*)(stg + row * 144 + ch * 16);
                    const size_t t = tok0 + 32 * ib + row;
                    const u32x4 gt = rgreg[it];
                    u32x4 w; w.x = pk2(bflo(v.x) * bflo(gt.x), bfhi(v.x) * bfhi(gt.x)); w.y = pk2(bflo(v.y) * bflo(gt.y), bfhi(v.y) * bfhi(gt.y));
                    w.z = pk2(bflo(v.z) * bflo(gt.z), bfhi(v.z) * bfhi(gt.z)); w.w = pk2(bflo(v.w) * bflo(gt.w), bfhi(v.w) * bfhi(gt.w));
                    *(u32x4*)(AR + t * ARW + 512 + h * 128 + 64 * eh + 8 * ch) = w; }
                asm volatile("s_waitcnt lgkmcnt(0)" ::: "memory");
            }
        }
    }
}

struct TokRec { int e0, r0; float w0; int e1, r1; float w1; int pad0, pad1; };
constexpr int NGROUP = T / 128;
__device__ __forceinline__ void p5_router(Frame& F) {
    LAS float* W = (LAS float*)F.lds;
    LAS float* BIAS = (LAS float*)(F.lds + MISC_OFF + 4 * 128);
    volatile LAS unsigned* lcnt = F.MISC + 192;
    {
        const float* w_gr = F.w_gr; const float* w_er = F.w_er;
#pragma unroll 4
        for (int idx = F.tid; idx < 1024 * 32; idx += 512) { const int k = idx >> 5, c = idx & 31; W[(((k & 3) + 4 * (k >> 8)) * 64 + ((k >> 2) & 63)) * 36 + 4 + c] = w_er[idx]; }
#pragma unroll 4
        for (int idx = F.tid; idx < 1024 * 4; idx += 512) { const int k = idx >> 2, c = idx & 3; W[(((k & 3) + 4 * (k >> 8)) * 64 + ((k >> 2) & 63)) * 36 + c] = w_gr[idx]; }
        if (F.tid < 4) BIAS[F.tid] = F.b_gr[F.tid]; else if (F.tid < 36) BIAS[F.tid] = F.b_er[F.tid - 4];
    }
    const float* X2 = (const float*)F.outb; bf16_t* H2 = (bf16_t*)(F.ws + WS_H2); TokRec* TK = (TokRec*)(F.ws + WS_TOK); unsigned* CNTG = (unsigned*)(F.ws + WS_CNTG);
    const int lane = F.lane;
    f32x4 gv[4];
#pragma unroll
    for (int j = 0; j < 4; ++j) gv[j] = ((const GAS f32x4*)F.g2)[lane + 64 * j];
    for (int gi = F.vcu; gi < NGROUP; gi += F.G) {
        __syncthreads();
        if (F.tid < NEXP) lcnt[F.tid] = 0u;
        __syncthreads();
#pragma unroll 1
        for (int pp = 0; pp < 8; ++pp) {
            const int tb = gi * 128 + F.wave * 16 + 2 * pp;
            f32x4 xv[2][4]; float rstd[2];
#pragma unroll
            for (int tk = 0; tk < 2; ++tk) {
                const size_t t = (size_t)(tb + tk);
                const GAS f32x4* xr = (const GAS f32x4*)(X2 + t * DM) + lane; float s = 0.f;
#pragma unroll
                for (int j = 0; j < 4; ++j) { const f32x4 v = xr[64 * j]; xv[tk][j] = v; s += (v.x * v.x + v.y * v.y) + (v.z * v.z + v.w * v.w); }
                rstd[tk] = 1.0f / sqrtf(wave_sum(s) * (1.f / DM) + EPS);
                GAS u32x2* o8 = (GAS u32x2*)(H2 + t * DM) + lane;
#pragma unroll
                for (int j = 0; j < 4; ++j) { xv[tk][j] = xv[tk][j] * gv[j]; const f32x4 hv = xv[tk][j] * rstd[tk]; u32x2 w; w.x = pk2(hv.x, hv.y); w.y = pk2(hv.z, hv.w); o8[64 * j] = w; }
            }
            float a[36];
#pragma unroll
            for (int half = 0; half < 2; ++half) {
                constexpr int NQ0 = 5;
                const int c0 = half ? NQ0 : 0;
                float acc[2][20];
#pragma unroll
                for (int c = 0; c < 20; ++c) { acc[0][c] = 0.f; acc[1][c] = 0.f; }
#pragma unroll
                for (int j = 0; j < 4; ++j)
#pragma unroll
                    for (int i = 0; i < 4; ++i) {
                        const LAS f32x4* wp = (const LAS f32x4*)(W + ((i + 4 * j) * 64 + lane) * 36) + c0;
                        const float x0 = xv[0][j][i], x1 = xv[1][j][i];
#pragma unroll
                        for (int c = 0; c < 5; ++c) { if (half && c == 4) continue; const f32x4 w = wp[c];
                            acc[0][4 * c] += x0 * w.x; acc[0][4 * c + 1] += x0 * w.y; acc[0][4 * c + 2] += x0 * w.z; acc[0][4 * c + 3] += x0 * w.w;
                            acc[1][4 * c] += x1 * w.x; acc[1][4 * c + 1] += x1 * w.y; acc[1][4 * c + 2] += x1 * w.z; acc[1][4 * c + 3] += x1 * w.w; }
                        asm volatile("" ::: "memory");
                    }
#pragma unroll
                for (int c = 0; c < 20; ++c) { if (half && c >= 16) continue;
                    const float s0 = wave_sum(acc[0][c]), s1 = wave_sum(acc[1][c]); a[4 * c0 + c] = ((lane == 1) ? s1 * rstd[1] : s0 * rstd[0]) + BIAS[4 * c0 + c]; }
            }
            if (lane < 2) {
                const int t = tb + lane;
                int g = 0; float gm = a[0];
#pragma unroll
                for (int c = 1; c < 4; ++c) if (a[c] > gm) { gm = a[c]; g = c; }
                float gs = 0.f;
#pragma unroll
                for (int c = 0; c < 4; ++c) gs += __expf(a[c] - gm);
                const float gprob = 1.0f / gs;
                float el[8];
#pragma unroll
                for (int i = 0; i < 8; ++i) el[i] = (g == 0 ? a[4 + i] : g == 1 ? a[12 + i] : g == 2 ? a[20 + i] : a[28 + i]);
                int i0 = 0; float v0 = el[0];
#pragma unroll
                for (int i = 1; i < 8; ++i) if (el[i] > v0) { v0 = el[i]; i0 = i; }
                int i1 = -1; float v1 = -3.0e38f;
#pragma unroll
                for (int i = 0; i < 8; ++i) if (i != i0 && el[i] > v1) { v1 = el[i]; i1 = i; }
                const float ex = __expf(v1 - v0), w0 = gprob / (1.0f + ex), w1 = gprob * ex / (1.0f + ex);
                const int e0 = g * 8 + i0, e1 = g * 8 + i1;
                const int r0 = (int)__hip_atomic_fetch_add((LAS unsigned*)(lcnt + e0), 1u, __ATOMIC_RELAXED, __HIP_MEMORY_SCOPE_WORKGROUP);
                const int r1 = (int)__hip_atomic_fetch_add((LAS unsigned*)(lcnt + e1), 1u, __ATOMIC_RELAXED, __HIP_MEMORY_SCOPE_WORKGROUP);
                TokRec rec; rec.e0 = e0; rec.r0 = r0; rec.w0 = w0; rec.e1 = e1; rec.r1 = r1; rec.w1 = w1; rec.pad0 = 0; rec.pad1 = 0;
                TK[t] = rec;
            }
        }
        __syncthreads();
        if (F.tid < NEXP) CNTG[gi * NEXP + F.tid] = lcnt[F.tid];
    }
}
__device__ __forceinline__ void build_offsets(Frame& F) {
    LAS int* OFF = (LAS int*)F.lds; LAS int* SEG = (LAS int*)(F.lds + 32768);
    const unsigned* CNTG = (const unsigned*)(F.ws + WS_CNTG);
    __syncthreads();
    for (int idx = F.tid; idx < NGROUP * NEXP; idx += 512) OFF[idx] = (int)__builtin_nontemporal_load(CNTG + idx);
    __syncthreads();
    const int e = F.tid & 31, seg = F.tid >> 5;
    constexpr int GS = NGROUP / 16;
    { int s = 0;
      for (int g = 0; g < GS; ++g) s += OFF[(seg * GS + g) * NEXP + e];
      SEG[seg * NEXP + e] = s; }
    __syncthreads();
    int before = 0, total = 0;
    for (int s2 = 0; s2 < 16; ++s2) { const int v = SEG[s2 * NEXP + e]; total += v; if (s2 < seg) before += v; }
    const int pad = (total + 255) & ~255;
    int incl = pad;
#pragma unroll
    for (int o = 1; o < 32; o <<= 1) { const int v = __shfl_up(incl, o, 32); if (e >= o) incl += v; }
    const int ebase = incl - pad;
    if (F.tid < NEXP) { F.MISC[16 + e] = (unsigned)(ebase >> 8); if (e == 31) F.MISC[48] = (unsigned)(incl >> 8); }
    int run = ebase + before;
    for (int g = 0; g < GS; ++g) { const int i = (seg * GS + g) * NEXP + e; const int c = OFF[i]; OFF[i] = run; run += c; }
    __syncthreads();
}
__device__ __forceinline__ void p6_gather(Frame& F) {
    build_offsets(F);
    const LAS int* OFF = (const LAS int*)F.lds;
    const bf16_t* H2 = (const bf16_t*)(F.ws + WS_H2); bf16_t* XG = (bf16_t*)(F.ws + WS_XG); const TokRec* TK = (const TokRec*)(F.ws + WS_TOK);
    if (blockIdx.x == 0 && F.tid < 33) F.ctl[CW_CNT + F.tid] = F.MISC[16 + F.tid];
    const int gw = F.vcu * NWAVES + F.wave, NGW = F.G * NWAVES, lane = F.lane;
    for (int t = gw; t < T; t += NGW) {
        const TokRec rec = TK[t];
        const int gi = t >> 7;
        const int s0 = OFF[gi * NEXP + rec.e0] + rec.r0, s1 = OFF[gi * NEXP + rec.e1] + rec.r1;
        const GAS u32x4* src = (const GAS u32x4*)(H2 + (size_t)t * DM) + lane;
        const u32x4 v0 = src[0], v1 = src[64];
        GAS u32x4* d0 = (GAS u32x4*)(XG + (size_t)s0 * DM) + lane; GAS u32x4* d1 = (GAS u32x4*)(XG + (size_t)s1 * DM) + lane;
        d0[0] = v0; d0[64] = v1; d1[0] = v0; d1[64] = v1;
    }
}
__device__ __forceinline__ int expert_tiles_to_lds(Frame& F) {
    __syncthreads();
    if (F.tid < 33) F.MISC[16 + F.tid] = __hip_atomic_load(F.ctl + CW_CNT + F.tid, __ATOMIC_RELAXED, __HIP_MEMORY_SCOPE_AGENT);
    __syncthreads();
    return (int)F.MISC[48];
}
__device__ __forceinline__ void p9_combine(Frame& F) {
    build_offsets(F);
    const LAS int* OFF = (const LAS int*)F.lds;
    float* X2 = (float*)F.outb; const bf16_t* YB = (const bf16_t*)(F.ws + WS_YB); const TokRec* TK = (const TokRec*)(F.ws + WS_TOK);
    const int gw = F.vcu * NWAVES + F.wave, NGW = F.G * NWAVES, lane = F.lane;
    f32x4 gv[4];
#pragma unroll
    for (int j = 0; j < 4; ++j) gv[j] = ((const GAS f32x4*)F.gf)[lane + 64 * j];
    for (int t = gw; t < T; t += NGW) {
        const TokRec rec = TK[t];
        const int gi = t >> 7;
        const int s0 = OFF[gi * NEXP + rec.e0] + rec.r0, s1 = OFF[gi * NEXP + rec.e1] + rec.r1;
        GAS f32x4* xr = (GAS f32x4*)(X2 + (size_t)t * DM) + lane;
        const GAS u32x2* y0 = (const GAS u32x2*)(YB + (size_t)s0 * DM) + lane; const GAS u32x2* y1 = (const GAS u32x2*)(YB + (size_t)s1 * DM) + lane;
        f32x4 v[4]; float s = 0.f;
#pragma unroll
        for (int j = 0; j < 4; ++j) { const f32x4 xv = xr[64 * j]; const u32x2 a = y0[64 * j], b = y1[64 * j];
            f32x4 r;
            r.x = xv.x + rec.w0 * bflo(a.x) + rec.w1 * bflo(b.x); r.y = xv.y + rec.w0 * bfhi(a.x) + rec.w1 * bfhi(b.x);
            r.z = xv.z + rec.w0 * bflo(a.y) + rec.w1 * bflo(b.y); r.w = xv.w + rec.w0 * bfhi(a.y) + rec.w1 * bfhi(b.y);
            v[j] = r; s += (r.x * r.x + r.y * r.y) + (r.z * r.z + r.w * r.w); }
        const float rstd = 1.0f / sqrtf(wave_sum(s) * (1.f / DM) + EPS);
#pragma unroll
        for (int j = 0; j < 4; ++j) xr[64 * j] = v[j] * rstd * gv[j];
    }
}

constexpr int NPHASE = 10;
struct Args { const float* in[17]; float* out; unsigned char* ws; int ph_lo, ph_hi, use_cg, pad; };
__global__ void __launch_bounds__(NWAVES * 64, 2) hybrid_fwd(Args args) {
    extern __shared__ __attribute__((aligned(16))) unsigned char lds[];
    Frame F;
    F.lds = (LAS unsigned char*)lds;
    F.MISC = (volatile LAS unsigned*)(F.lds + MISC_OFF);
    F.tid = threadIdx.x; F.lane = F.tid & 63; F.wave = __builtin_amdgcn_readfirstlane(F.tid >> 6);
    F.G = gridDim.x; { const int bx = blockIdx.x; F.vcu = (F.G % 8 == 0) ? (bx % 8) * (F.G / 8) + bx / 8 : bx; }
    F.ws = args.ws; F.outb = (unsigned char*)args.out; F.ctl = (unsigned*)(args.ws + WS_CTL);
    F.x = args.in[0]; F.g1 = args.in[1]; F.w_in = args.in[2]; F.b_in = args.in[3]; F.sinks = args.in[4]; F.w_au = args.in[5]; F.w_ru = args.in[6]; F.w_out = args.in[7];
    F.g2 = args.in[8]; F.w_gr = args.in[9]; F.b_gr = args.in[10]; F.w_er = args.in[11]; F.b_er = args.in[12]; F.w_ge = args.in[13]; F.w_ue = args.in[14]; F.w_de = args.in[15]; F.gf = args.in[16];
    for (int u = F.tid; u < (LDS_BYTES - MISC_OFF) / 4; u += NWAVES * 64) ((LAS unsigned*)(F.lds + MISC_OFF))[u] = 0u;
    __syncthreads();
    const int lo = args.ph_lo, hi = args.ph_hi;
    const bool multi = (hi - lo) > 1;
    XcdBarrier bar; bar.bar = F.ctl + CW_BAR; bar.x = 0; bar.st = nullptr;
    if (multi) bar = xcd_barrier_post(F.ctl + CW_BAR, F.MISC + 8);
    if (args.use_cg == 12345) cg::this_grid().sync();
#define IN(k) (lo <= (k) && (k) < hi)
#define SEAM(k) do { if (IN(k) && IN((k) + 1)) xcd_barrier(bar); } while (0)

#define REP(k) ((PROBE_REP >> (k)) & 1)
#define P1_BODY { DenseOrder S; S.A = (const char*)F.outb; S.Bt = (const char*)(F.ws + WS_WIN); S.nM = T / 256; S.nN = INW / 256; S.nwg = S.nM * S.nN; S.G = F.G; S.c = (int)blockIdx.x; S.ld = DM; S.nt = 16; \
        EpiProj E{(bf16_t*)(F.ws + WS_PA), (bf16_t*)(F.ws + WS_GT), F.b_in}; pg8::gemm_phase<EpiProj, DenseOrder>(F.lds, DM, S, E); }
#define P2_BODY { if (F.G >= 256) { if (F.vcu < 128) p2_retention_mfma(F, F.vcu, 128); else p2_attention_mfma(F, F.vcu - 128, F.G - 128); } \
        else { p2_retention_mfma(F, F.vcu, F.G); p2_attention_mfma(F, F.vcu, F.G); } }
#define P3_BODY { UpOrder S; S.d.A = (const char*)F.outb; S.d.Bt = (const char*)(F.ws + WS_WUP); S.d.nM = T / 256; S.d.nN = 4; S.d.nwg = S.d.nM * 4; S.d.G = F.G; S.d.c = (int)blockIdx.x; S.d.ld = ARW; S.d.nt = 0; \
        EpiUp E{(bf16_t*)(F.ws + WS_MIX), (const bf16_t*)(F.ws + WS_GT)}; pg8::gemm_phase<EpiUp, UpOrder>(F.lds, ARW, S, E); }
#define P4_BODY { DenseOrder S; S.A = (const char*)(F.ws + WS_MIX); S.Bt = (const char*)(F.ws + WS_WOUT); S.nM = T / 256; S.nN = 4; S.nwg = S.nM * 4; S.G = F.G; S.c = (int)blockIdx.x; S.ld = DM; S.nt = 16; \
        EpiOut E{F.x, (float*)F.outb}; pg8::gemm_phase<EpiOut, DenseOrder>(F.lds, DM, S, E); }
#define P7_BODY { const int ntl = expert_tiles_to_lds(F); \
        ExpertOrder S; S.A = (const char*)(F.ws + WS_XG); S.Bt = (const char*)(F.ws + WS_WGU); S.tp = (const volatile LAS int*)(F.MISC + 16); S.ntiles = ntl; S.G = F.G; S.c = (int)blockIdx.x; S.ldA = DM; S.nt = 16; \
        S.bstride = (size_t)1024 * 1024 * 2; S.bpn = (size_t)256 * 1024 * 2; EpiSwiglu E{(bf16_t*)(F.ws + WS_ACT)}; pg8::gemm_phase<EpiSwiglu, ExpertOrder>(F.lds, DM, S, E); }
#define P8_BODY { const int ntl = expert_tiles_to_lds(F); \
        ExpertOrder S; S.A = (const char*)(F.ws + WS_ACT); S.Bt = (const char*)(F.ws + WS_WD); S.tp = (const volatile LAS int*)(F.MISC + 16); S.ntiles = ntl; S.G = F.G; S.c = (int)blockIdx.x; S.ldA = DEXP; S.nt = 8; \
        S.bstride = (size_t)1024 * 512 * 2; S.bpn = (size_t)256 * 512 * 2; EpiDown E{(bf16_t*)(F.ws + WS_YB)}; pg8::gemm_phase<EpiDown, ExpertOrder>(F.lds, DEXP, S, E); }
#define RUN(k, BODY) do { if (IN(k)) { BODY; if (REP(k)) { xcd_barrier(bar); BODY; } } SEAM(k); } while (0)
    RUN(0, p0_prologue(F));
    RUN(1, P1_BODY);
#if (PROBE_REP & 0x1000)
    if (IN(2)) { if (F.vcu < 128) { p2_retention_mfma(F, F.vcu, 128); p2_retention_mfma(F, F.vcu, 128); } else p2_attention_mfma(F, F.vcu - 128, F.G - 128); } SEAM(2);
#elif (PROBE_REP & 0x2000)
    if (IN(2)) { if (F.vcu < 128) p2_retention_mfma(F, F.vcu, 128); else { p2_attention_mfma(F, F.vcu - 128, F.G - 128); p2_attention_mfma(F, F.vcu - 128, F.G - 128); } } SEAM(2);
#else
    RUN(2, P2_BODY);
#endif
    RUN(3, P3_BODY);
    RUN(4, P4_BODY);
    RUN(5, p5_router(F));
    RUN(6, p6_gather(F));
    RUN(7, P7_BODY);
    RUN(8, P8_BODY);
    if (IN(9)) { p9_combine(F); }
#undef IN
#undef SEAM
}

extern "C" void kernel_launch(void* const* d_in, const int* in_sizes, int n_in, void* d_out, int out_size, void* d_ws, size_t ws_size, hipStream_t stream) {
    static int grid = 0;
    if (grid == 0) {
        if (n_in != 17 || in_sizes[0] != T * DM || out_size != T * DM || ws_size < WS_END) {
            fprintf(stderr, "kernel_launch: unexpected shapes (n_in %d, in0 %d, out %d, ws %zu); nothing launched\n", n_in, n_in > 0 ? in_sizes[0] : -1, out_size, ws_size); grid = -1; return; }
        int dev = 0, cus = 0, per_cu = 0;
        if (hipGetDevice(&dev) != hipSuccess || hipDeviceGetAttribute(&cus, hipDeviceAttributeMultiprocessorCount, dev) != hipSuccess) { grid = -1; return; }
        if (hipFuncSetAttribute((const void*)hybrid_fwd, hipFuncAttributeMaxDynamicSharedMemorySize, LDS_BYTES) != hipSuccess) { fprintf(stderr, "kernel_launch: hipFuncSetAttribute failed\n"); grid = -1; return; }
        if (hipOccupancyMaxActiveBlocksPerMultiprocessor(&per_cu, (const void*)hybrid_fwd, NWAVES * 64, LDS_BYTES) != hipSuccess || per_cu < 1) { fprintf(stderr, "kernel_launch: occupancy query says %d blocks per CU\n", per_cu); grid = -1; (void)hipGetLastError(); return; }
        grid = cus;
    }
    if (grid < 0) return;
    if (hipMemsetAsync((char*)d_ws + WS_CTL, 0, CTL_ZERO_BYTES, stream) != hipSuccess) return;
    Args a{};
    for (int i = 0; i < 17; ++i) a.in[i] = (const float*)d_in[i];
    a.out = (float*)d_out; a.ws = (unsigned char*)d_ws; a.use_cg = 0; a.pad = 0;
    constexpr int NL = MK_N_LAUNCHES;
    if (NL == 1) {
        a.ph_lo = 0; a.ph_hi = NPHASE;
        void* kargs[] = {&a};
        hipError_t e = hipLaunchCooperativeKernel((const void*)hybrid_fwd, dim3(grid), dim3(NWAVES * 64), kargs, LDS_BYTES, stream);
        if (e != hipSuccess) fprintf(stderr, "kernel_launch: cooperative launch failed: %s (grid %d)\n", hipGetErrorString(e), grid);
    } else {
        for (int li = 0; li < NPHASE; ++li) {
            a.ph_lo = li; a.ph_hi = li + 1;
            hipLaunchKernelGGL(hybrid_fwd, dim3(grid), dim3(NWAVES * 64), LDS_BYTES, stream, a);
        }
    }
}
```

```cpp
#include <hip/hip_runtime.h>
#include <hip/hip_cooperative_groups.h>
#include <cstdio>
#include <cstdint>
namespace cg = cooperative_groups;

#ifndef PROBE_REP
#define PROBE_REP 0
#endif
#ifndef MK_N_LAUNCHES
#define MK_N_LAUNCHES 1
#endif

#define LAS __attribute__((address_space(3)))
#define GAS __attribute__((address_space(1)))
typedef unsigned short bf16_t;
typedef short bf16x8 __attribute__((ext_vector_type(8)));
typedef float f32x4 __attribute__((ext_vector_type(4)));
typedef float f32x2 __attribute__((ext_vector_type(2)));
typedef unsigned u32x4 __attribute__((ext_vector_type(4)));
typedef unsigned u32x2 __attribute__((ext_vector_type(2)));

constexpr int DM = 1024, NB = 16, SEQ = 2048, T = NB * SEQ;
constexpr int INW = 5888, PAW = 3840, GTW = 2048;
constexpr int C_AQ = 0, C_AK = 512, C_AV = 640, C_RQ = 768, C_RK = 1280, C_RV = 1792, C_RG = 2816;
constexpr int ARW = 1536;
constexpr int NEXP = 32, DEXP = 512;
constexpr int PSLOT = 65536 + 8192;
constexpr float EPS = 1e-6f;

constexpr size_t MiB = 1u << 20;
constexpr size_t WS_CTL = 0, CTL_ZERO_BYTES = 1 * MiB;
constexpr size_t WS_WIN = 2 * MiB;
constexpr size_t WS_WUP = 14 * MiB;
constexpr size_t WS_WOUT = 17 * MiB;
constexpr size_t WS_WGU = 20 * MiB;
constexpr size_t WS_WD = 84 * MiB;
constexpr size_t WS_PA = 116 * MiB;
constexpr size_t WS_GT = 356 * MiB;
constexpr size_t WS_TOK = 484 * MiB;
constexpr size_t WS_CNTG = 485 * MiB;
constexpr size_t WS_END = 486 * MiB;
constexpr size_t WS_MIX = 116 * MiB;
constexpr size_t WS_H2 = 180 * MiB;
constexpr size_t WS_XG = 244 * MiB;
constexpr size_t WS_ACT = 388 * MiB;
constexpr size_t WS_YB = 116 * MiB;
constexpr int CW_CNT = 1024;
constexpr int CW_BAR = 4096;

constexpr int RING_BYTES = 131072;
constexpr int SCRATCH_BYTES = 147456;
constexpr int MISC_OFF = SCRATCH_BYTES;
constexpr int WSCR_OFF = SCRATCH_BYTES + 1024;
constexpr int LDS_BYTES = SCRATCH_BYTES + 1024 + 4096;

__device__ __forceinline__ unsigned f2bf(float f) { unsigned u = __builtin_bit_cast(unsigned, f); return (u + 0x7fffu + ((u >> 16) & 1u)) >> 16; }
__device__ __forceinline__ unsigned pk2(float lo, float hi) { return f2bf(lo) | (f2bf(hi) << 16); }
__device__ __forceinline__ float bflo(unsigned w) { return __builtin_bit_cast(float, w << 16); }
__device__ __forceinline__ float bfhi(unsigned w) { return __builtin_bit_cast(float, w & 0xffff0000u); }
__device__ __forceinline__ float bf2f(bf16_t b) { return __builtin_bit_cast(float, (unsigned)b << 16); }
__device__ __forceinline__ unsigned cvt_pk_bf16(float lo, float hi) { unsigned r; asm volatile("v_cvt_pk_bf16_f32 %0, %1, %2" : "=v"(r) : "v"(lo), "v"(hi)); return r; }
__device__ __forceinline__ float sigmoidf_(float v) { return 1.0f / (1.0f + __expf(-v)); }
__device__ __forceinline__ float wave_sum(float v) {
#pragma unroll
    for (int o = 1; o < 64; o <<= 1) v += __shfl_xor(v, o);
    return v;
}
#define LDS_WAIT() asm volatile("s_waitcnt lgkmcnt(0)" ::: "memory")
#define VM_WAIT() asm volatile("s_waitcnt vmcnt(0)" ::: "memory")

namespace pg8 {
constexpr int BM = 256, BK = 64, HALF = 128, HTB = HALF * BK * 2, STAGE_BYTES = 8 * HTB;
__host__ __device__ __forceinline__ int lds_byte(int r, int c) { const int st = (r >> 4) * 2 + (c >> 5), rr = r & 15, cc = c & 31, ob = rr * 64 + cc * 2; return st * 1024 + (ob ^ (((ob >> 9) & 1) << 5)); }
__host__ __device__ __forceinline__ void stage_rc(int b, int& R, int& C) { const int st = b / 1024, sb = b % 1024, swz = sb ^ (((sb >> 9) & 1) << 5); R = (st >> 1) * 16 + swz / 64; C = (st & 1) * 32 + (swz % 64) / 2; }
__host__ __device__ __forceinline__ int perm32(int rho) { const int n = rho >> 4, i = rho & 15; return 8 * (i >> 2) + 4 * n + (i & 3); }

struct Unit { const char* a; const char* b; int pm, pn, nt, aux; };

template <class Epi, class Sched>
__device__ __forceinline__ void gemm_phase(LAS unsigned char* lds, const int ld  , const Sched& S, const Epi& E) {
    const int tid = threadIdx.x, wid = __builtin_amdgcn_readfirstlane(tid >> 6), lane = tid & 63, wr = wid >> 2, wc = wid & 3, fr = lane & 15, fq = lane >> 4;
    unsigned voffA[2], voffB[2];
#pragma unroll
    for (int i = 0; i < 2; ++i) { int R, C; stage_rc(tid * 16 + i * 8192, R, C); const int Rb = Epi::PERM ? ((R & ~31) + perm32(R & 31)) : R;
        voffA[i] = (unsigned)(R * ld + C) * 2u; voffB[i] = (unsigned)(Rb * ld + C) * 2u; }
    const size_t kstep = (size_t)(BK * 2);
    const size_t hstep = (size_t)HALF * ld * 2;
    const unsigned ldsw = (unsigned)wid * 1024u;
    const int aoff = lds_byte(wr * 64 + fr, fq * 8), boff = lds_byte(wc * 32 + fr, fq * 8);
#define PG8_SA(b, h) (((b) * 2 + (h)) * HTB)
#define PG8_SB(b, h) ((4 + (b) * 2 + (h)) * HTB)
#define PG8_STAGE(bufoff, gbase, voff) do { _Pragma("unroll") for (int _i = 0; _i < 2; ++_i) \
        __builtin_amdgcn_global_load_lds((const unsigned*)((const char*)(gbase) + (voff)[_i]), (LAS unsigned*)(lds + (bufoff) + ldsw + _i * 8192), 16, 0, 0); } while (0)
#define PG8_LDA(dst, b, h) do { _Pragma("unroll") for (int m = 0; m < 4; ++m) _Pragma("unroll") for (int k = 0; k < 2; ++k) dst[m][k] = *(const LAS bf16x8*)(lds + PG8_SA(b, h) + aoff + m * 2048 + k * 1024); } while (0)
#define PG8_LDB(dst, b, h) do { _Pragma("unroll") for (int n = 0; n < 2; ++n) _Pragma("unroll") for (int k = 0; k < 2; ++k) dst[n][k] = *(const LAS bf16x8*)(lds + PG8_SB(b, h) + boff + n * 2048 + k * 1024); } while (0)
#define PG8_MMA(ai, bj, At, Bt) do { __builtin_amdgcn_s_setprio(1); _Pragma("unroll") for (int m = 0; m < 4; ++m) _Pragma("unroll") for (int n = 0; n < 2; ++n) _Pragma("unroll") for (int k = 0; k < 2; ++k) \
        acc[ai][bj][m][n] = __builtin_amdgcn_mfma_f32_16x16x32_bf16(Bt[n][k], At[m][k], acc[ai][bj][m][n], 0, 0, 0); __builtin_amdgcn_s_setprio(0); } while (0)
#define PG8_WAIT_V(n) asm volatile("s_waitcnt vmcnt(" #n ")" ::: "memory")
#define PG8_WAIT_L(n) asm volatile("s_waitcnt lgkmcnt(" #n ")" ::: "memory")
#define PG8_BAR __builtin_amdgcn_s_barrier()
#define PG8_SCHED __builtin_amdgcn_sched_barrier(0)
    Unit cur, nxt; int ui = 0;
    if (!S.next(0, cur)) return;
    f32x4 acc[2][2][4][2];
#pragma unroll
    for (int a = 0; a < 2; ++a)
#pragma unroll
        for (int b = 0; b < 2; ++b)
#pragma unroll
            for (int m = 0; m < 4; ++m)
#pragma unroll
                for (int n = 0; n < 2; ++n) acc[a][b][m][n] = (f32x4){0.f, 0.f, 0.f, 0.f};
    bf16x8 At[4][2], B0[2][2], B1[2][2];
    const char* cA = cur.a; const char* cB = cur.b;
    PG8_STAGE(PG8_SB(0, 0), cB, voffB); PG8_STAGE(PG8_SB(0, 1), cB + hstep, voffB); PG8_STAGE(PG8_SA(0, 0), cA, voffA); PG8_STAGE(PG8_SA(0, 1), cA + hstep, voffA);
    if (wr == 1) PG8_BAR;
    PG8_WAIT_V(2); PG8_BAR;
    PG8_STAGE(PG8_SB(1, 0), cB + kstep, voffB); PG8_STAGE(PG8_SA(1, 0), cA + kstep, voffA); PG8_STAGE(PG8_SB(1, 1), cB + hstep + kstep, voffB);
    PG8_WAIT_V(6); PG8_BAR;
    for (;;) {
        const bool has_next = S.next(ui + 1, nxt);
        const char* nA = has_next ? nxt.a : cA; const char* nB = has_next ? nxt.b : cB;
        const int nt = cur.nt;
        for (int t = 0; t < nt; t += 2) {
            const bool last = (t == nt - 2);
            const char* a1 = cA + (size_t)(t + 1) * kstep;
            const char* a2 = last ? nA : cA + (size_t)(t + 2) * kstep; const char* b2 = last ? nB : cB + (size_t)(t + 2) * kstep;
            const char* a3 = a2 + kstep; const char* b3 = b2 + kstep;
            PG8_LDB(B0, 0, 0); PG8_LDB(B1, 0, 1); PG8_SCHED; PG8_LDA(At, 0, 0); PG8_STAGE(PG8_SA(1, 1), a1 + hstep, voffA);
            PG8_WAIT_V(8); PG8_WAIT_L(0); PG8_BAR; PG8_MMA(0, 0, At, B0); PG8_MMA(0, 1, At, B1); PG8_BAR; PG8_SCHED;
            PG8_LDA(At, 0, 1); PG8_STAGE(PG8_SB(0, 0), b2, voffB); PG8_STAGE(PG8_SB(0, 1), b2 + hstep, voffB); PG8_STAGE(PG8_SA(0, 0), a2, voffA);
            PG8_WAIT_V(8); PG8_WAIT_L(0); PG8_BAR; PG8_MMA(1, 0, At, B0); PG8_MMA(1, 1, At, B1); PG8_BAR; PG8_SCHED;
            PG8_LDB(B0, 1, 0); PG8_LDB(B1, 1, 1); PG8_SCHED; PG8_LDA(At, 1, 0); PG8_STAGE(PG8_SA(0, 1), a2 + hstep, voffA);
            PG8_WAIT_V(8); PG8_WAIT_L(0); PG8_BAR; PG8_MMA(0, 0, At, B0); PG8_MMA(0, 1, At, B1); PG8_BAR; PG8_SCHED;
            PG8_LDA(At, 1, 1); PG8_STAGE(PG8_SB(1, 0), b3, voffB); PG8_STAGE(PG8_SB(1, 1), b3 + hstep, voffB); PG8_STAGE(PG8_SA(1, 0), a3, voffA);
            PG8_WAIT_V(8); PG8_WAIT_L(0); PG8_BAR; PG8_MMA(1, 0, At, B0); PG8_MMA(1, 1, At, B1); PG8_BAR; PG8_SCHED;
        }
        if (wr == 0) PG8_BAR;
        E(acc, cur, wr, wc, fr, fq);
        if (!has_next) break;
#pragma unroll
        for (int a = 0; a < 2; ++a)
#pragma unroll
            for (int b = 0; b < 2; ++b)
#pragma unroll
                for (int m = 0; m < 4; ++m)
#pragma unroll
                    for (int n = 0; n < 2; ++n) acc[a][b][m][n] = (f32x4){0.f, 0.f, 0.f, 0.f};
        cur = nxt; cA = nA; cB = nB; ++ui;
        if (wr == 1) PG8_BAR;
    }
    PG8_WAIT_V(0);
    PG8_BAR;
#undef PG8_SA
#undef PG8_SB
#undef PG8_STAGE
#undef PG8_LDA
#undef PG8_LDB
#undef PG8_MMA
#undef PG8_WAIT_V
#undef PG8_WAIT_L
#undef PG8_BAR
#undef PG8_SCHED
}
typedef f32x4 Acc[2][2][4][2];
}

#define XB_TMO      128
#define XB_XCNT(j)  (256  + 64 * (j))
#define XB_XSUB(j)  (1280 + 64 * (j))
#define XB_XGEN(j)  (2304 + 64 * (j))
#define XB_TOP      3328
#define XB_TOPGEN   3392
#define XCD_BAR_WORDS 3456
#define XB_SPIN_CAP (1u << 18)
__device__ __forceinline__ unsigned xb_ld(unsigned* p)              { return __hip_atomic_load(p, __ATOMIC_RELAXED, __HIP_MEMORY_SCOPE_AGENT); }
__device__ __forceinline__ unsigned xb_add(unsigned* p, unsigned v) { return __hip_atomic_fetch_add(p, v, __ATOMIC_RELAXED, __HIP_MEMORY_SCOPE_AGENT); }
__device__ __forceinline__ unsigned xb_xcc_id() { return (unsigned)__builtin_amdgcn_s_getreg((3 << 11) | 20) & 0xFu; }
#define XB_SPIN(cond, bar) do { unsigned _sp = 0; while (cond) { __builtin_amdgcn_s_sleep(1); \
    if ((++_sp & 255u) == 0u) { if (xb_ld(&(bar)[XB_TMO])) break; if (_sp > XB_SPIN_CAP) { atomicAdd(&(bar)[XB_TMO], 1u); break; } } } } while (0)
struct XcdBarrier { unsigned* bar; unsigned x; volatile LAS unsigned* st; };
__device__ __forceinline__ XcdBarrier xcd_barrier_post(unsigned* bar, volatile LAS unsigned* st) {
    XcdBarrier b; b.bar = bar; b.x = xb_xcc_id(); b.st = st;
    if (threadIdx.x == 0) (void)xb_add(&bar[XB_XCNT(b.x)], 1u);
    return b;
}
__device__ __forceinline__ void xcd_barrier_complete(unsigned* bar, unsigned x, unsigned& nloc, unsigned& nx) {
    const unsigned G = gridDim.x * gridDim.y * gridDim.z;
    unsigned sum, cnt, mine, sp = 0u;
    for (;;) {
        sum = 0u; cnt = 0u; mine = 0u;
#pragma unroll
        for (unsigned j = 0; j < 16; ++j) { const unsigned c = xb_ld(&bar[XB_XCNT(j)]); sum += c; cnt += (c > 0u) ? 1u : 0u; mine = (j == x) ? c : mine; }
        if (sum == G) break;
        __builtin_amdgcn_s_sleep(1);
        if ((++sp & 255u) == 0u) { if (xb_ld(&bar[XB_TMO])) break; if (sp > XB_SPIN_CAP) { atomicAdd(&bar[XB_TMO], 1u); break; } }
    }
    nloc = mine > 0u ? mine : 1u; nx = cnt > 0u ? cnt : 1u;
}
__device__ __forceinline__ void xcd_barrier(const XcdBarrier& b) {
    asm volatile("s_waitcnt vmcnt(0)" ::: "memory");
    __syncthreads();
    if (threadIdx.x == 0) {
        unsigned* bar = b.bar;
        __builtin_amdgcn_s_waitcnt(0);
        unsigned nloc = b.st[0], nx = b.st[1];
        if (nloc == 0u) { xcd_barrier_complete(bar, b.x, nloc, nx); b.st[0] = nloc; b.st[1] = nx; }
        const unsigned old = xb_add(&bar[XB_XSUB(b.x)], 1u);
        const unsigned gen = old / nloc;
        if (old + 1u == (gen + 1u) * nloc) {
            __builtin_amdgcn_fence(__ATOMIC_RELEASE, "agent");
            asm volatile("s_waitcnt vmcnt(0)" ::: "memory");
            const unsigned og = xb_add(&bar[XB_TOP], 1u);
            const unsigned tg = og / nx;
            if (og + 1u == (tg + 1u) * nx) xb_add(&bar[XB_TOPGEN], 1u);
            else XB_SPIN(xb_ld(&bar[XB_TOPGEN]) == tg, bar);
            __builtin_amdgcn_fence(__ATOMIC_ACQUIRE, "agent");
            xb_add(&bar[XB_XGEN(b.x)], 1u);
            asm volatile("s_waitcnt vmcnt(0)" ::: "memory");
        } else {
            XB_SPIN(xb_ld(&bar[XB_XGEN(b.x)]) == gen, bar);
            __builtin_amdgcn_fence(__ATOMIC_ACQUIRE, "agent");
            asm volatile("s_waitcnt vmcnt(0)" ::: "memory");
        }
    }
    __syncthreads();
}

constexpr int NWAVES = 8;
struct Frame {
    LAS unsigned char* lds;
    volatile LAS unsigned* MISC;
    unsigned* ctl;
    int tid, lane, wave, vcu, G;
    unsigned char* ws; unsigned char* outb;
    const float *x, *g1, *w_in, *b_in, *sinks, *w_au, *w_ru, *w_out, *g2, *w_gr, *b_gr, *w_er, *b_er, *w_ge, *w_ue, *w_de, *gf;
};

__device__ __forceinline__ void p0_transpose_item(const float* W, int N, int k0, int n0, bf16_t* WT, size_t dpitch, int drow0, int dcol0, LAS float* scr, int lane) {
#pragma unroll 8
    for (int i = 0; i < 32; ++i) { const int kk = 2 * i + (lane >> 5); scr[kk * 33 + (lane & 31)] = W[(size_t)(k0 + kk) * N + n0 + (lane & 31)]; }
    LDS_WAIT(); asm volatile("" ::: "memory");
    const int c = lane & 7;
#pragma unroll
    for (int j = 0; j < 4; ++j) { const int n = (lane >> 3) + 8 * j; const LAS float* s = scr + (8 * c) * 33 + n;
        u32x4 o; o.x = pk2(s[0 * 33], s[1 * 33]); o.y = pk2(s[2 * 33], s[3 * 33]); o.z = pk2(s[4 * 33], s[5 * 33]); o.w = pk2(s[6 * 33], s[7 * 33]);
        *(GAS u32x4*)(WT + (size_t)(drow0 + n) * dpitch + dcol0 + k0 + 8 * c) = o; }
    LDS_WAIT(); asm volatile("" ::: "memory");
}
__device__ __forceinline__ void p0_prologue(Frame& F) {
    LAS float* scr = (LAS float*)(F.lds + F.wave * 16384);
    const int gw = F.vcu * NWAVES + F.wave, NGW = F.G * NWAVES;
    constexpr int I_IN = 16 * 184, I_AU = 8 * 32, I_RU = 16 * 32, I_OUT = 16 * 32, I_G = 32 * 256, I_U = 32 * 256, I_D = 32 * 256;
    constexpr int NITEMS = I_IN + I_AU + I_RU + I_OUT + I_G + I_U + I_D;
    bf16_t* WinT = (bf16_t*)(F.ws + WS_WIN); bf16_t* WupT = (bf16_t*)(F.ws + WS_WUP); bf16_t* WoutT = (bf16_t*)(F.ws + WS_WOUT);
    bf16_t* WguT = (bf16_t*)(F.ws + WS_WGU); bf16_t* WdT = (bf16_t*)(F.ws + WS_WD);
    for (int it = gw; it < NITEMS; it += NGW) {
        int r = it;
        if (r < I_IN) { const int kb = r / 184, nb = r % 184; p0_transpose_item(F.w_in, INW, 64 * kb, 32 * nb, WinT, 1024, 32 * nb, 0, scr, F.lane); continue; } r -= I_IN;
        if (r < I_AU) { const int kb = r / 32, nb = r % 32; p0_transpose_item(F.w_au, 1024, 64 * kb, 32 * nb, WupT, 1536, 32 * nb, 0, scr, F.lane); continue; } r -= I_AU;
        if (r < I_RU) { const int kb = r / 32, nb = r % 32; p0_transpose_item(F.w_ru, 1024, 64 * kb, 32 * nb, WupT, 1536, 32 * nb, 512, scr, F.lane); continue; } r -= I_RU;
        if (r < I_OUT) { const int kb = r / 32, nb = r % 32; p0_transpose_item(F.w_out, 1024, 64 * kb, 32 * nb, WoutT, 1024, 32 * nb, 0, scr, F.lane); continue; } r -= I_OUT;
        if (r < I_G) { const int e = r / 256, q = r % 256, kb = q / 16, nb = q % 16, n0 = 32 * nb;
            p0_transpose_item(F.w_ge + (size_t)e * 1024 * 512, 512, 64 * kb, n0, WguT + (size_t)e * 1024 * 1024, 1024, 256 * (n0 >> 7) + (n0 & 127), 0, scr, F.lane); continue; } r -= I_G;
        if (r < I_U) { const int e = r / 256, q = r % 256, kb = q / 16, nb = q % 16, n0 = 32 * nb;
            p0_transpose_item(F.w_ue + (size_t)e * 1024 * 512, 512, 64 * kb, n0, WguT + (size_t)e * 1024 * 1024, 1024, 256 * (n0 >> 7) + 128 + (n0 & 127), 0, scr, F.lane); continue; } r -= I_U;
        { const int e = r / 256, q = r % 256, kb = q / 32, nb = q % 32;
            p0_transpose_item(F.w_de + (size_t)e * 512 * 1024, 1024, 64 * kb, 32 * nb, WdT + (size_t)e * 1024 * 512, 512, 32 * nb, 0, scr, F.lane); }
    }
    bf16_t* XN = (bf16_t*)F.outb;
    f32x4 gv[4];
#pragma unroll
    for (int j = 0; j < 4; ++j) gv[j] = ((const GAS f32x4*)F.g1)[F.lane + 64 * j];
    for (int m = gw; m < T; m += NGW) {
        const GAS f32x4* xr = (const GAS f32x4*)(F.x + (size_t)m * DM) + F.lane;
        f32x4 v[4]; float s = 0.f;
#pragma unroll
        for (int j = 0; j < 4; ++j) { v[j] = xr[64 * j]; s += (v[j].x * v[j].x + v[j].y * v[j].y) + (v[j].z * v[j].z + v[j].w * v[j].w); }
        const float rstd = 1.0f / sqrtf(wave_sum(s) * (1.f / DM) + EPS);
        GAS u32x2* o8 = (GAS u32x2*)(XN + (size_t)m * DM) + F.lane;
#pragma unroll
        for (int j = 0; j < 4; ++j) { u32x2 w; w.x = pk2(v[j].x * rstd * gv[j].x, v[j].y * rstd * gv[j].y); w.y = pk2(v[j].z * rstd * gv[j].z, v[j].w * rstd * gv[j].w); o8[64 * j] = w; }
    }
}

struct DenseOrder {
    const char* A; const char* Bt; int nM, nN, nwg, G, c, ld, nt;
    __device__ __forceinline__ void tile(int wg, int& pm, int& pn) const {
        int wgid = wg; { const int q = nwg / 8, r = nwg % 8, xcd = wgid % 8, off = wgid / 8; wgid = (xcd < r ? xcd * (q + 1) : r * (q + 1) + (xcd - r) * q) + off; }
        const int nig = 8 * nN, gid = wgid / nig, fm = gid * 8, gsz = (nM - fm) < 8 ? (nM - fm) : 8;
        pm = fm + ((wgid % nig) % gsz); pn = (wgid % nig) / gsz;
    }
    __device__ __forceinline__ bool next(int i, pg8::Unit& u) const {
        const long L = (long)i * G + c; if (L >= nwg) return false;
        int pm, pn; tile((int)L, pm, pn);
        u.pm = pm; u.pn = pn; u.nt = nt; u.aux = 0;
        u.a = A + (size_t)pm * 256 * ld * 2; u.b = Bt + (size_t)pn * 256 * ld * 2; return true;
    }
};
struct UpOrder {
    DenseOrder d;
    __device__ __forceinline__ bool next(int i, pg8::Unit& u) const {
        const long L = (long)(i >> 1) * d.G + d.c; if (L >= d.nwg) return false;
        int pm, pn; d.tile((int)L, pm, pn);
        const int part = i & 1;
        u.pm = pm; u.pn = pn; u.aux = part; u.nt = part ? 16 : 8;
        u.a = d.A + (size_t)pm * 256 * ARW * 2 + (part ? 1024 : 0); u.b = d.Bt + (size_t)pn * 256 * ARW * 2 + (part ? 1024 : 0); return true;
    }
};
struct ExpertOrder {
    const char* A; const char* Bt; const volatile LAS int* tp; int ntiles, G, c, ldA, nt; size_t bstride  , bpn  ;
    __device__ __forceinline__ bool next(int i, pg8::Unit& u) const {
        const long L = (long)i * G + c; if (L >= (long)ntiles * 4) return false;
        const int tix = (int)(L >> 2), pn = (int)(L & 3);
        int e = 0;
        for (int k = 1; k < NEXP; ++k) e += (tix >= tp[k]) ? 1 : 0;
        u.pm = tix; u.pn = pn; u.nt = nt; u.aux = e;
        u.a = A + (size_t)tix * 256 * ldA * 2; u.b = Bt + (size_t)e * bstride + (size_t)pn * bpn; return true;
    }
};

struct EpiProj {
    static constexpr bool PERM = true;
    bf16_t* PA; bf16_t* GT; const float* bias;
    __device__ __forceinline__ void operator()(const pg8::Acc& acc, const pg8::Unit& u, int wr, int wc, int fr, int fq) const {
        const int ct = u.pn; const int mode = ct < 11 ? 0 : (ct < 15 ? 1 : 2);
        bf16_t* base; int ldc, colt;
        if (ct < 15) { base = PA; ldc = PAW; colt = ct * 256; } else { base = GT; ldc = GTW; colt = ct * 256 - PAW; }
        const int row0 = u.pm * 256 + wr * 64 + fr, col0 = colt + wc * 32 + 8 * fq, bcol0 = ct * 256 + wc * 32 + 8 * fq;
        f32x4 bv[2][2];
#pragma unroll
        for (int bj = 0; bj < 2; ++bj)
#pragma unroll
            for (int n = 0; n < 2; ++n) bv[bj][n] = *(const f32x4*)(bias + bcol0 + bj * 128 + 4 * n);
#pragma unroll
        for (int ai = 0; ai < 2; ++ai)
#pragma unroll
            for (int m = 0; m < 4; ++m) { bf16_t* rowp = base + (size_t)(row0 + ai * 128 + m * 16) * ldc + col0;
#pragma unroll
                for (int bj = 0; bj < 2; ++bj) { f32x4 v0 = acc[ai][bj][m][0] + bv[bj][0], v1 = acc[ai][bj][m][1] + bv[bj][1];
                    if (ct == 5 || ct == 6) {
                        const int hh = (bcol0 + bj * 128 - C_RK) >> 6, pos = (row0 + ai * 128 + m * 16) & 127;
                        const float ks = 0.125f * exp2f((float)(127 - pos) * log2f(1.0f - exp2f(-5.0f - (float)hh)));
                        v0 = v0 * ks; v1 = v1 * ks; }
                    if (mode != 0) {
#pragma unroll
                        for (int j = 0; j < 4; ++j) { const float s0 = sigmoidf_(v0[j]), s1 = sigmoidf_(v1[j]); v0[j] = (mode == 1) ? v0[j] * s0 : s0; v1[j] = (mode == 1) ? v1[j] * s1 : s1; } }
                    u32x4 w; w.x = cvt_pk_bf16(v0[0], v0[1]); w.y = cvt_pk_bf16(v0[2], v0[3]); w.z = cvt_pk_bf16(v1[0], v1[1]); w.w = cvt_pk_bf16(v1[2], v1[3]);
                    *(u32x4*)(rowp + bj * 128) = w; } }
    }
};
struct EpiUp {
    static constexpr bool PERM = true;
    bf16_t* MIX; const bf16_t* GT;
    __device__ __forceinline__ void operator()(const pg8::Acc& acc, const pg8::Unit& u, int wr, int wc, int fr, int fq) const {
        const int part = u.aux;
        const int row0 = u.pm * 256 + wr * 64 + fr, col0 = u.pn * 256 + wc * 32 + 8 * fq;
#pragma unroll
        for (int ai = 0; ai < 2; ++ai) {
            u32x4 g[4][2], p[4][2];
#pragma unroll
            for (int m = 0; m < 4; ++m)
#pragma unroll
                for (int bj = 0; bj < 2; ++bj) { const size_t row = (size_t)(row0 + ai * 128 + m * 16);
                    g[m][bj] = __builtin_nontemporal_load((const u32x4*)(GT + row * GTW + part * 1024 + col0 + bj * 128));
                    p[m][bj] = part ? *(const u32x4*)(MIX + row * DM + col0 + bj * 128) : (u32x4){0u, 0u, 0u, 0u}; }
            asm volatile("" ::: "memory");
#pragma unroll
            for (int m = 0; m < 4; ++m)
#pragma unroll
                for (int bj = 0; bj < 2; ++bj) { const size_t row = (size_t)(row0 + ai * 128 + m * 16);
                    const f32x4 a0 = acc[ai][bj][m][0], a1 = acc[ai][bj][m][1]; const u32x4 gg = g[m][bj], pp = p[m][bj];
                    float r[8];
                    r[0] = bflo(gg.x) * a0[0] + bflo(pp.x); r[1] = bfhi(gg.x) * a0[1] + bfhi(pp.x); r[2] = bflo(gg.y) * a0[2] + bflo(pp.y); r[3] = bfhi(gg.y) * a0[3] + bfhi(pp.y);
                    r[4] = bflo(gg.z) * a1[0] + bflo(pp.z); r[5] = bfhi(gg.z) * a1[1] + bfhi(pp.z); r[6] = bflo(gg.w) * a1[2] + bflo(pp.w); r[7] = bfhi(gg.w) * a1[3] + bfhi(pp.w);
                    u32x4 w; w.x = cvt_pk_bf16(r[0], r[1]); w.y = cvt_pk_bf16(r[2], r[3]); w.z = cvt_pk_bf16(r[4], r[5]); w.w = cvt_pk_bf16(r[6], r[7]);
                    *(u32x4*)(MIX + row * DM + col0 + bj * 128) = w; }
            asm volatile("" ::: "memory");
        }
    }
};
struct EpiOut {
    static constexpr bool PERM = false;
    const float* x; float* X2;
    __device__ __forceinline__ void operator()(const pg8::Acc& acc, const pg8::Unit& u, int wr, int wc, int fr, int fq) const {
        const int row0 = u.pm * 256 + wr * 64 + fr, col0 = u.pn * 256 + wc * 32 + 4 * fq;
#pragma unroll
        for (int ai = 0; ai < 2; ++ai) {
            f32x4 xv[4][2][2];
#pragma unroll
            for (int m = 0; m < 4; ++m) { const size_t off = (size_t)(row0 + ai * 128 + m * 16) * DM + col0;
#pragma unroll
                for (int bj = 0; bj < 2; ++bj)
#pragma unroll
                    for (int n = 0; n < 2; ++n) xv[m][bj][n] = __builtin_nontemporal_load((const f32x4*)(x + off + bj * 128 + n * 16)); }
            asm volatile("" ::: "memory");
#pragma unroll
            for (int m = 0; m < 4; ++m) { const size_t off = (size_t)(row0 + ai * 128 + m * 16) * DM + col0;
#pragma unroll
                for (int bj = 0; bj < 2; ++bj)
#pragma unroll
                    for (int n = 0; n < 2; ++n) *(f32x4*)(X2 + off + bj * 128 + n * 16) = xv[m][bj][n] + acc[ai][bj][m][n]; }
            asm volatile("" ::: "memory");
        }
    }
};
struct EpiSwiglu {
    static constexpr bool PERM = true;
    bf16_t* ACT;
    __device__ __forceinline__ void operator()(const pg8::Acc& acc, const pg8::Unit& u, int wr, int wc, int fr, int fq) const {
        const int row0 = u.pm * 256 + wr * 64 + fr, col0 = u.pn * 128 + wc * 32 + 8 * fq;
#pragma unroll
        for (int ai = 0; ai < 2; ++ai)
#pragma unroll
            for (int m = 0; m < 4; ++m) { bf16_t* rowp = ACT + (size_t)(row0 + ai * 128 + m * 16) * DEXP + col0;
                float r[8];
#pragma unroll
                for (int n = 0; n < 2; ++n)
#pragma unroll
                    for (int j = 0; j < 4; ++j) { const float g = acc[ai][0][m][n][j], up = acc[ai][1][m][n][j]; r[4 * n + j] = g * sigmoidf_(g) * up; }
                u32x4 w; w.x = cvt_pk_bf16(r[0], r[1]); w.y = cvt_pk_bf16(r[2], r[3]); w.z = cvt_pk_bf16(r[4], r[5]); w.w = cvt_pk_bf16(r[6], r[7]);
                *(u32x4*)rowp = w; }
    }
};
struct EpiDown {
    static constexpr bool PERM = true;
    bf16_t* YB;
    __device__ __forceinline__ void operator()(const pg8::Acc& acc, const pg8::Unit& u, int wr, int wc, int fr, int fq) const {
        const int row0 = u.pm * 256 + wr * 64 + fr, col0 = u.pn * 256 + wc * 32 + 8 * fq;
#pragma unroll
        for (int ai = 0; ai < 2; ++ai)
#pragma unroll
            for (int m = 0; m < 4; ++m) { bf16_t* rowp = YB + (size_t)(row0 + ai * 128 + m * 16) * DM + col0;
#pragma unroll
                for (int bj = 0; bj < 2; ++bj) { const f32x4 v0 = acc[ai][bj][m][0], v1 = acc[ai][bj][m][1];
                    u32x4 w; w.x = cvt_pk_bf16(v0[0], v0[1]); w.y = cvt_pk_bf16(v0[2], v0[3]); w.z = cvt_pk_bf16(v1[0], v1[1]); w.w = cvt_pk_bf16(v1[2], v1[3]);
                    *(u32x4*)(rowp + bj * 128) = w; } }
    }
};

__device__ __forceinline__ void ld8bf(const bf16_t* p, float* o) { const u32x4 w = *(const u32x4*)p; o[0] = bflo(w.x); o[1] = bfhi(w.x); o[2] = bflo(w.y); o[3] = bfhi(w.y); o[4] = bflo(w.z); o[5] = bfhi(w.z); o[6] = bflo(w.w); o[7] = bfhi(w.w); }
__device__ __forceinline__ void p2_attention_naive(Frame& F, int u0, int ustride) {
    LAS float* Ks = (LAS float*)F.lds;
    LAS float* Vs = Ks + 256 * 68;
    const bf16_t* PA = (const bf16_t*)(F.ws + WS_PA); bf16_t* AR = (bf16_t*)F.outb;
    const int tid = F.tid, part = tid & 7;
    for (int unit = u0; unit < NB * 16 * 8; unit += ustride) {
        const int h = unit & 7, n = (unit >> 3) & 15, b = unit >> 7, kvh = h >> 2;
        const size_t tok0 = (size_t)b * SEQ + n * 128;
        __syncthreads();
        for (int idx = tid; idx < 256 * 8; idx += 512) {
            const int j = idx >> 3, c = idx & 7;
            float kf[8], vf[8];
            if (n == 0 && j < 128) {
#pragma unroll
                for (int i = 0; i < 8; ++i) { kf[i] = 0.f; vf[i] = 0.f; }
            } else {
                const bf16_t* rp = PA + (tok0 - 128 + j) * PAW;
                ld8bf(rp + C_AK + kvh * 64 + c * 8, kf); ld8bf(rp + C_AV + kvh * 64 + c * 8, vf);
            }
            *(LAS f32x4*)(Ks + j * 68 + c * 8) = (f32x4){kf[0], kf[1], kf[2], kf[3]}; *(LAS f32x4*)(Ks + j * 68 + c * 8 + 4) = (f32x4){kf[4], kf[5], kf[6], kf[7]};
            *(LAS f32x4*)(Vs + j * 68 + c * 8) = (f32x4){vf[0], vf[1], vf[2], vf[3]}; *(LAS f32x4*)(Vs + j * 68 + c * 8 + 4) = (f32x4){vf[4], vf[5], vf[6], vf[7]};
        }
        __syncthreads();
        const float slope = exp2f(-(float)(h + 1)), sink = F.sinks[h];
        for (int qh = 0; qh < 2; ++qh) {
            const int q = qh * 64 + (tid >> 3);
            const size_t tq = tok0 + q;
            float qr[64];
#pragma unroll
            for (int c = 0; c < 8; ++c) ld8bf(PA + tq * PAW + C_AQ + h * 64 + c * 8, qr + 8 * c);
            float o[64];
#pragma unroll
            for (int d = 0; d < 64; ++d) o[d] = 0.f;
            float mx = sink, den = (part == 0) ? 1.0f : 0.0f;
#pragma unroll 1
            for (int jj = 0; jj < 32; ++jj) {
                const int j = part + 8 * jj, dist = q + 128 - j;
                const bool valid = dist >= 0 && dist < 128 && (n > 0 || j >= 128);
                if (valid) {
                    float d = 0.f;
                    const LAS f32x4* kp = (const LAS f32x4*)(Ks + j * 68);
#pragma unroll
                    for (int c = 0; c < 16; ++c) { const f32x4 kv = kp[c]; d += qr[4 * c] * kv.x + qr[4 * c + 1] * kv.y + qr[4 * c + 2] * kv.z + qr[4 * c + 3] * kv.w; }
                    const float sc = d * 0.125f - slope * (float)dist;
                    const float mn = fmaxf(mx, sc), f = __expf(mx - mn), p = __expf(sc - mn);
                    mx = mn; den = den * f + p;
                    const LAS f32x4* vp = (const LAS f32x4*)(Vs + j * 68);
#pragma unroll
                    for (int c = 0; c < 16; ++c) { const f32x4 vv = vp[c]; o[4 * c] = o[4 * c] * f + p * vv.x; o[4 * c + 1] = o[4 * c + 1] * f + p * vv.y; o[4 * c + 2] = o[4 * c + 2] * f + p * vv.z; o[4 * c + 3] = o[4 * c + 3] * f + p * vv.w; }
                }
            }
            float ma = fmaxf(mx, __shfl_xor(mx, 1)); ma = fmaxf(ma, __shfl_xor(ma, 2)); ma = fmaxf(ma, __shfl_xor(ma, 4));
            const float fs = __expf(mx - ma);
            den *= fs; den += __shfl_xor(den, 1); den += __shfl_xor(den, 2); den += __shfl_xor(den, 4);
            const float inv = 1.0f / den;
#pragma unroll
            for (int d = 0; d < 64; ++d) { o[d] *= fs; o[d] += __shfl_xor(o[d], 1); o[d] += __shfl_xor(o[d], 2); o[d] += __shfl_xor(o[d], 4); }
            if (part == 0) {
                bf16_t* op = AR + tq * ARW + h * 64;
#pragma unroll
                for (int c = 0; c < 8; ++c) { u32x4 w0; w0.x = pk2(o[8 * c] * inv, o[8 * c + 1] * inv); w0.y = pk2(o[8 * c + 2] * inv, o[8 * c + 3] * inv); w0.z = pk2(o[8 * c + 4] * inv, o[8 * c + 5] * inv); w0.w = pk2(o[8 * c + 6] * inv, o[8 * c + 7] * inv);
                    *(u32x4*)(op + 8 * c) = w0; }
            }
        }
    }
}
__device__ __forceinline__ void p2_retention_naive(Frame& F, int u0, int ustride) {
    LAS float* Qs = (LAS float*)F.lds;
    LAS float* Ks = Qs + 128 * 68;
    LAS bf16_t* Vs = (LAS bf16_t*)(Ks + 128 * 68);
    LAS float* Ss = (LAS float*)(Vs + 128 * 136);
    const bf16_t* PA = (const bf16_t*)(F.ws + WS_PA); bf16_t* AR = (bf16_t*)F.outb;
    const int tid = F.tid;
    for (int unit = u0; unit < NB * 8; unit += ustride) {
        const int h = unit & 7, b = unit >> 3;
        const float lg = log2f(1.0f - exp2f(-5.0f - (float)h));
        __syncthreads();
        for (int idx = tid; idx < 64 * 128; idx += 512) Ss[idx] = 0.f;
        for (int n = 0; n < 16; ++n) {
            const size_t tok0 = (size_t)b * SEQ + n * 128;
            __syncthreads();
            for (int idx = tid; idx < 128 * 8; idx += 512) {
                const int j = idx >> 3, c = idx & 7; const bf16_t* rp = PA + (tok0 + j) * PAW;
                float qf[8], kf[8]; ld8bf(rp + C_RQ + h * 64 + c * 8, qf); ld8bf(rp + C_RK + h * 64 + c * 8, kf);
                *(LAS f32x4*)(Qs + j * 68 + c * 8) = (f32x4){qf[0], qf[1], qf[2], qf[3]}; *(LAS f32x4*)(Qs + j * 68 + c * 8 + 4) = (f32x4){qf[4], qf[5], qf[6], qf[7]};
                *(LAS f32x4*)(Ks + j * 68 + c * 8) = (f32x4){kf[0], kf[1], kf[2], kf[3]}; *(LAS f32x4*)(Ks + j * 68 + c * 8 + 4) = (f32x4){kf[4], kf[5], kf[6], kf[7]};
            }
            for (int idx = tid; idx < 128 * 16; idx += 512) {
                const int j = idx >> 4, c = idx & 15;
                *(LAS u32x4*)(Vs + j * 136 + c * 8) = *(const u32x4*)(PA + (tok0 + j) * PAW + C_RV + h * 128 + c * 8);
            }
            __syncthreads();
            {
                const int i = tid >> 2, part = tid & 3;
                float qreg[16];
#pragma unroll
                for (int c = 0; c < 4; ++c) { const f32x4 v = *(const LAS f32x4*)(Qs + i * 68 + 16 * part + 4 * c); qreg[4 * c] = v.x; qreg[4 * c + 1] = v.y; qreg[4 * c + 2] = v.z; qreg[4 * c + 3] = v.w; }
                float y[32];
#pragma unroll
                for (int e = 0; e < 32; ++e) y[e] = 0.f;
                const int jmax = i | 15;
                for (int j = 0; j <= jmax; ++j) {
                    float sdot = 0.f;
#pragma unroll
                    for (int c = 0; c < 4; ++c) { const f32x4 kv = *(const LAS f32x4*)(Ks + j * 68 + 16 * part + 4 * c); sdot += qreg[4 * c] * kv.x + qreg[4 * c + 1] * kv.y + qreg[4 * c + 2] * kv.z + qreg[4 * c + 3] * kv.w; }
                    sdot += __shfl_xor(sdot, 1); sdot += __shfl_xor(sdot, 2);
                    const float w = (j <= i) ? sdot * 0.125f * exp2f((float)(i - j) * lg) : 0.f;
#pragma unroll
                    for (int c = 0; c < 4; ++c) { const u32x4 vv = *(const LAS u32x4*)(Vs + j * 136 + 32 * part + 8 * c);
                        y[8 * c] += w * bflo(vv.x); y[8 * c + 1] += w * bfhi(vv.x); y[8 * c + 2] += w * bflo(vv.y); y[8 * c + 3] += w * bfhi(vv.y);
                        y[8 * c + 4] += w * bflo(vv.z); y[8 * c + 5] += w * bfhi(vv.z); y[8 * c + 6] += w * bflo(vv.w); y[8 * c + 7] += w * bfhi(vv.w); }
                }
                const float gi = exp2f((float)(i + 1) * lg);
                for (int d = 0; d < 64; ++d) {
                    const float qd = Qs[i * 68 + d] * gi;
#pragma unroll
                    for (int c = 0; c < 8; ++c) { const f32x4 sv = *(const LAS f32x4*)(Ss + d * 128 + 32 * part + 4 * c); y[4 * c] += qd * sv.x; y[4 * c + 1] += qd * sv.y; y[4 * c + 2] += qd * sv.z; y[4 * c + 3] += qd * sv.w; }
                }
                float sum = 0.f;
#pragma unroll
                for (int e = 0; e < 32; ++e) sum += y[e];
                sum += __shfl_xor(sum, 1); sum += __shfl_xor(sum, 2);
                const float mu = sum * (1.f / 128.f); float var = 0.f;
#pragma unroll
                for (int e = 0; e < 32; ++e) { y[e] -= mu; var += y[e] * y[e]; }
                var += __shfl_xor(var, 1); var += __shfl_xor(var, 2);
                const float rstd = 1.0f / sqrtf(var * (1.f / 128.f) + EPS);
                const size_t t = tok0 + i;
                const bf16_t* gp = PA + t * PAW + C_RG + h * 128 + 32 * part;
                bf16_t* op = AR + t * ARW + 512 + h * 128 + 32 * part;
#pragma unroll
                for (int c = 0; c < 4; ++c) { float g[8]; ld8bf(gp + 8 * c, g);
                    u32x4 w; w.x = pk2(y[8 * c] * rstd * g[0], y[8 * c + 1] * rstd * g[1]); w.y = pk2(y[8 * c + 2] * rstd * g[2], y[8 * c + 3] * rstd * g[3]);
                    w.z = pk2(y[8 * c + 4] * rstd * g[4], y[8 * c + 5] * rstd * g[5]); w.w = pk2(y[8 * c + 6] * rstd * g[6], y[8 * c + 7] * rstd * g[7]);
                    *(u32x4*)(op + 8 * c) = w; }
            }
            __syncthreads();
            {
                const int d = tid >> 3, eg = tid & 7;
                const float cd = exp2f(128.f * lg);
                float a[16];
#pragma unroll
                for (int c = 0; c < 4; ++c) { const f32x4 sv = *(const LAS f32x4*)(Ss + d * 128 + 16 * eg + 4 * c); a[4 * c] = sv.x * cd; a[4 * c + 1] = sv.y * cd; a[4 * c + 2] = sv.z * cd; a[4 * c + 3] = sv.w * cd; }
                for (int j = 0; j < 128; ++j) {
                    const float kd = Ks[j * 68 + d] * 0.125f * exp2f((float)(127 - j) * lg);
#pragma unroll
                    for (int c = 0; c < 2; ++c) { const u32x4 vv = *(const LAS u32x4*)(Vs + j * 136 + 16 * eg + 8 * c);
                        a[8 * c] += kd * bflo(vv.x); a[8 * c + 1] += kd * bfhi(vv.x); a[8 * c + 2] += kd * bflo(vv.y); a[8 * c + 3] += kd * bfhi(vv.y);
                        a[8 * c + 4] += kd * bflo(vv.z); a[8 * c + 5] += kd * bfhi(vv.z); a[8 * c + 6] += kd * bflo(vv.w); a[8 * c + 7] += kd * bfhi(vv.w); }
                }
#pragma unroll
                for (int c = 0; c < 4; ++c) *(LAS f32x4*)(Ss + d * 128 + 16 * eg + 4 * c) = (f32x4){a[4 * c], a[4 * c + 1], a[4 * c + 2], a[4 * c + 3]};
            }
        }
    }
}

typedef float f32x16 __attribute__((ext_vector_type(16)));
typedef short s16x4 __attribute__((ext_vector_type(4)));
__device__ __forceinline__ int crow(int r, int hi) { return (r & 3) + 8 * (r >> 2) + 4 * hi; }
__device__ __forceinline__ s16x4 ds_tr16(const LAS unsigned char* p) { return __builtin_bit_cast(s16x4, __builtin_amdgcn_ds_read_tr16_b64_v4i16((LAS s16x4*)p)); }
__device__ __forceinline__ bf16x8 pack8(const f32x16& p, int b) {
    u32x4 w; w.x = cvt_pk_bf16(p[b], p[b + 1]); w.y = cvt_pk_bf16(p[b + 2], p[b + 3]); w.z = cvt_pk_bf16(p[b + 4], p[b + 5]); w.w = cvt_pk_bf16(p[b + 6], p[b + 7]);
    return __builtin_bit_cast(bf16x8, w);
}
constexpr int AT_K = 0, AT_V = 36864, AT_WS = AT_V + 32768, AT_OST = AT_WS + 8 * 128, AT_END = AT_OST + 8 * 4096;
static_assert(AT_END <= SCRATCH_BYTES, "attention LDS");
__device__ __forceinline__ void p2_attention_mfma(Frame& F, int u0, int ustride) {
    const bf16_t* PA = (const bf16_t*)(F.ws + WS_PA); bf16_t* AR = (bf16_t*)F.outb;
    LAS unsigned char* lds = F.lds;
    const int tid = F.tid, lane = F.lane, wid = F.wave, r32 = lane & 31, hi = lane >> 5;
    const int g = wid >> 1, qhalf = wid & 1;
    constexpr float LOG2E = 1.4426950408889634f;
    for (int unit = u0; unit < NB * 16 * 2; unit += ustride) {
        const int kvh = unit & 1, n = (unit >> 1) & 15, b = unit >> 5;
        const size_t tok0 = (size_t)b * SEQ + n * 128;
        __syncthreads();
#pragma unroll
        for (int it = 0; it < 4; ++it) {
            const int idx = tid + 512 * it, j = idx >> 3, c = idx & 7;
            u32x4 kv = (u32x4){0u, 0u, 0u, 0u}, vv = (u32x4){0u, 0u, 0u, 0u};
            if (n > 0 || j >= 128) { const bf16_t* rp = PA + (tok0 - 128 + j) * PAW; kv = *(const u32x4*)(rp + C_AK + kvh * 64 + c * 8); vv = *(const u32x4*)(rp + C_AV + kvh * 64 + c * 8); }
            *(LAS u32x4*)(lds + AT_K + j * 144 + c * 16) = kv;
            *(LAS u32x4*)(lds + AT_V + (c >> 2) * 16384 + (j >> 4) * 1024 + (j & 15) * 64 + (c & 3) * 16) = vv;
        }
        __syncthreads();
        const int hd = kvh * 4 + g;
        const float SL = exp2f(-(float)(hd + 1)) * LOG2E, SC = 0.125f * LOG2E, sink2 = F.sinks[hd] * LOG2E;
#pragma unroll 1
        for (int qb = 0; qb < 2; ++qb) {
            const int m = qhalf * 2 + qb, i0 = 32 * m;
            bf16x8 qr[4];
            { const bf16_t* qp = PA + (tok0 + i0 + r32) * PAW + C_AQ + hd * 64 + hi * 8;
#pragma unroll
              for (int s = 0; s < 4; ++s) qr[s] = *(const bf16x8*)(qp + 16 * s); }
            f32x16 p[5];
#pragma unroll
            for (int c = 0; c < 5; ++c) {
                const LAS unsigned char* kp = lds + AT_K + (32 * (m + c) + r32) * 144 + hi * 16;
                f32x16 a;
#pragma unroll
                for (int r = 0; r < 16; ++r) a[r] = 0.f;
#pragma unroll
                for (int s = 0; s < 4; ++s) a = __builtin_amdgcn_mfma_f32_32x32x16_bf16(*(const LAS bf16x8*)(kp + s * 32), qr[s], a, 0, 0, 0);
                p[c] = a;
            }
            const int iq = i0 + r32;
            float mx = sink2;
#pragma unroll
            for (int c = 0; c < 5; ++c)
#pragma unroll
                for (int r = 0; r < 16; ++r) {
                    const int j = 32 * (m + c) + crow(r, hi), dist = iq + 128 - j;
                    const bool valid = dist >= 0 && dist < 128 && (n > 0 || j >= 128);
                    const float t = valid ? p[c][r] * SC - SL * (float)dist : -1e30f;
                    p[c][r] = t; mx = fmaxf(mx, t);
                }
            mx = fmaxf(mx, __shfl_xor(mx, 32));
            float sum = 0.f;
#pragma unroll
            for (int c = 0; c < 5; ++c)
#pragma unroll
                for (int r = 0; r < 16; ++r) { const float e = __builtin_amdgcn_exp2f(p[c][r] - mx); p[c][r] = e; sum += e; }
            sum += __shfl_xor(sum, 32);
            const float den = sum + __builtin_amdgcn_exp2f(sink2 - mx);
            bf16x8 pa[5][2];
#pragma unroll
            for (int c = 0; c < 5; ++c) { pa[c][0] = pack8(p[c], 0); pa[c][1] = pack8(p[c], 8); }
            f32x16 o[2];
#pragma unroll
            for (int d0 = 0; d0 < 2; ++d0) {
                f32x16 a;
#pragma unroll
                for (int r = 0; r < 16; ++r) a[r] = 0.f;
#pragma unroll
                for (int c = 0; c < 5; ++c)
#pragma unroll
                    for (int s = 0; s < 2; ++s) {
                        const LAS unsigned char* vb = lds + AT_V + d0 * 16384 + (2 * (m + c) + s) * 1024 + ((lane >> 4) & 1) * 32 + (lane & 3) * 8 + (4 * hi + ((lane & 15) >> 2)) * 64;
                        const s16x4 lo = ds_tr16(vb), h4 = ds_tr16(vb + 512);
                        const bf16x8 vf = (bf16x8){lo[0], lo[1], lo[2], lo[3], h4[0], h4[1], h4[2], h4[3]};
                        a = __builtin_amdgcn_mfma_f32_32x32x16_bf16(pa[c][s], vf, a, 0, 0, 0);
                    }
                o[d0] = a;
            }
            LAS float* wsf = (LAS float*)(lds + AT_WS + wid * 128);
            asm volatile("s_waitcnt lgkmcnt(0)" ::: "memory");
            if (hi == 0) wsf[r32] = den;
            asm volatile("s_waitcnt lgkmcnt(0)" ::: "memory");
            float rinv[16];
#pragma unroll
            for (int r = 0; r < 16; ++r) rinv[r] = 1.0f / wsf[crow(r, hi)];
            LAS bf16_t* stg = (LAS bf16_t*)(lds + AT_OST + wid * 4096);
#pragma unroll
            for (int r = 0; r < 16; ++r)
#pragma unroll
                for (int d0 = 0; d0 < 2; ++d0) stg[crow(r, hi) * 64 + d0 * 32 + r32] = (bf16_t)f2bf(o[d0][r] * rinv[r]);
            asm volatile("s_waitcnt lgkmcnt(0)" ::: "memory");
#pragma unroll
            for (int it = 0; it < 4; ++it) { const int row = it * 8 + (lane >> 3), ch = lane & 7;
                const u32x4 v = *(const LAS u32x4*)(stg + row * 64 + ch * 8);
                *(u32x4*)(AR + (tok0 + i0 + row) * ARW + hd * 64 + ch * 8) = v; }
            asm volatile("s_waitcnt lgkmcnt(0)" ::: "memory");
        }
    }
}

constexpr int RT_KR = 0, RT_KT = 18432, RT_V = RT_KT + 16384, RT_ST = RT_V + 32768, RT_RED = RT_ST + 18432, RT_OST = RT_RED + 2048, RT_Q = RT_OST + 8 * 4608, RT_END = RT_Q + 18432;
static_assert(RT_END <= SCRATCH_BYTES, "retention LDS");
__device__ __forceinline__ u32x4 scale8bf(u32x4 w, float s) {
    u32x4 o; o.x = pk2(bflo(w.x) * s, bfhi(w.x) * s); o.y = pk2(bflo(w.y) * s, bfhi(w.y) * s); o.z = pk2(bflo(w.z) * s, bfhi(w.z) * s); o.w = pk2(bflo(w.w) * s, bfhi(w.w) * s); return o;
}
__device__ __forceinline__ bf16x8 tr_frag(const LAS unsigned char* p) {
    const s16x4 lo = ds_tr16(p), h4 = ds_tr16(p + 512);
    return (bf16x8){lo[0], lo[1], lo[2], lo[3], h4[0], h4[1], h4[2], h4[3]};
}
__device__ __forceinline__ void p2_retention_mfma(Frame& F, int u0, int ustride) {
    const bf16_t* PA = (const bf16_t*)(F.ws + WS_PA); bf16_t* AR = (bf16_t*)F.outb;
    LAS unsigned char* lds = F.lds;
    const int tid = F.tid, lane = F.lane, wid = F.wave, r32 = lane & 31, hi = lane >> 5;
    const int ib = wid >> 1, eh = wid & 1;
    const int sdb = wid & 1, seb = wid >> 1;
    const int troff = ((lane >> 4) & 1) * 32 + (lane & 3) * 8 + (4 * hi + ((lane & 15) >> 2)) * 64;
    for (int unit = u0; unit < NB * 8; unit += ustride) {
        const int h = unit & 7, b = unit >> 3;
        const float lg = log2f(1.0f - exp2f(-5.0f - (float)h));
        const float fac_i = exp2f((float)(32 * ib + r32 - 127) * lg), gi1 = exp2f((float)(32 * ib + r32 + 1) * lg), cd = exp2f(128.0f * lg);
        f32x16 st;
#pragma unroll
        for (int r = 0; r < 16; ++r) st[r] = 0.f;
        __syncthreads();
        for (int idx = tid; idx < 18432 / 4; idx += 512) ((LAS unsigned*)(lds + RT_ST))[idx] = 0u;
        u32x4 kreg[2], vreg[4], qreg[2];
        {
            const size_t tok0 = (size_t)b * SEQ;
#pragma unroll
            for (int it = 0; it < 2; ++it) { const int idx = tid + 512 * it, j = idx >> 3, c = idx & 7; kreg[it] = *(const u32x4*)(PA + (tok0 + j) * PAW + C_RK + h * 64 + c * 8); }
#pragma unroll
            for (int it = 0; it < 4; ++it) { const int idx = tid + 512 * it, j = idx >> 4, c = idx & 15; vreg[it] = *(const u32x4*)(PA + (tok0 + j) * PAW + C_RV + h * 128 + c * 8); }
#pragma unroll
            for (int it = 0; it < 2; ++it) { const int idx = tid + 512 * it, j = idx >> 3, c = idx & 7; qreg[it] = *(const u32x4*)(PA + (tok0 + j) * PAW + C_RQ + h * 64 + c * 8); }
        }
#pragma unroll 1
        for (int n = 0; n < 16; ++n) {
            const size_t tok0 = (size_t)b * SEQ + n * 128;
#pragma unroll
            for (int it = 0; it < 2; ++it) { const int idx = tid + 512 * it, j = idx >> 3, c = idx & 7;
                const u32x4 kk = kreg[it];
                *(LAS u32x4*)(lds + RT_KR + j * 144 + c * 16) = kk;
                *(LAS u32x4*)(lds + RT_KT + (c >> 2) * 8192 + (j >> 4) * 1024 + (j & 15) * 64 + (c & 3) * 16) = kk;
                *(LAS u32x4*)(lds + RT_Q + j * 144 + c * 16) = qreg[it]; }
#pragma unroll
            for (int it = 0; it < 4; ++it) { const int idx = tid + 512 * it, j = idx >> 4, c = idx & 15;
                *(LAS u32x4*)(lds + RT_V + (c >> 2) * 8192 + (j >> 4) * 1024 + (j & 15) * 64 + (c & 3) * 16) = vreg[it]; }
            __syncthreads();
            if (n < 15) {
                const size_t tokn = tok0 + 128;
#pragma unroll
                for (int it = 0; it < 2; ++it) { const int idx = tid + 512 * it, j = idx >> 3, c = idx & 7; kreg[it] = *(const u32x4*)(PA + (tokn + j) * PAW + C_RK + h * 64 + c * 8); }
#pragma unroll
                for (int it = 0; it < 4; ++it) { const int idx = tid + 512 * it, j = idx >> 4, c = idx & 15; vreg[it] = *(const u32x4*)(PA + (tokn + j) * PAW + C_RV + h * 128 + c * 8); }
#pragma unroll
                for (int it = 0; it < 2; ++it) { const int idx = tid + 512 * it, j = idx >> 3, c = idx & 7; qreg[it] = *(const u32x4*)(PA + (tokn + j) * PAW + C_RQ + h * 64 + c * 8); }
            }
            u32x4 rgreg[4];
#pragma unroll
            for (int it = 0; it < 4; ++it) { const int row = it * 8 + (lane >> 3), ch = lane & 7; rgreg[it] = *(const u32x4*)(PA + (tok0 + 32 * ib + row) * PAW + C_RG + h * 128 + 64 * eh + 8 * ch); }
            bf16x8 qr[4];
#pragma unroll
            for (int s = 0; s < 4; ++s) qr[s] = *(const LAS bf16x8*)(lds + RT_Q + (32 * ib + r32) * 144 + s * 32 + hi * 16);
            bf16x8 pb[4][2];
#pragma unroll
            for (int jb = 0; jb < 4; ++jb) {
                if (jb <= ib) {
                    const LAS unsigned char* kp = lds + RT_KR + (32 * jb + r32) * 144 + hi * 16;
                    f32x16 a;
#pragma unroll
                    for (int r = 0; r < 16; ++r) a[r] = 0.f;
#pragma unroll
                    for (int s = 0; s < 4; ++s) a = __builtin_amdgcn_mfma_f32_32x32x16_bf16(*(const LAS bf16x8*)(kp + s * 32), qr[s], a, 0, 0, 0);
                    const bool diag = (jb == ib);
#pragma unroll
                    for (int r = 0; r < 16; ++r) a[r] = (!diag || crow(r, hi) <= r32) ? a[r] * fac_i : 0.f;
                    pb[jb][0] = pack8(a, 0); pb[jb][1] = pack8(a, 8);
                    asm volatile("" ::: "memory");
                } else { pb[jb][0] = (bf16x8){0, 0, 0, 0, 0, 0, 0, 0}; pb[jb][1] = (bf16x8){0, 0, 0, 0, 0, 0, 0, 0}; }
            }
            f32x16 y[2];
#pragma unroll
            for (int t = 0; t < 2; ++t) {
                const int eb = 2 * eh + t;
                const LAS unsigned char* sp = lds + RT_ST + (32 * eb + r32) * 144 + hi * 16;
                f32x16 a;
#pragma unroll
                for (int r = 0; r < 16; ++r) a[r] = 0.f;
#pragma unroll
                for (int s = 0; s < 4; ++s) a = __builtin_amdgcn_mfma_f32_32x32x16_bf16(*(const LAS bf16x8*)(sp + s * 32), qr[s], a, 0, 0, 0);
#pragma unroll
                for (int r = 0; r < 16; ++r) a[r] *= gi1;
#pragma unroll
                for (int jb = 0; jb < 4; ++jb) {
                    if (jb <= ib) {
#pragma unroll
                        for (int s2 = 0; s2 < 2; ++s2) {
                            const bf16x8 vf = tr_frag(lds + RT_V + eb * 8192 + (2 * jb + s2) * 1024 + troff);
                            a = __builtin_amdgcn_mfma_f32_32x32x16_bf16(vf, pb[jb][s2], a, 0, 0, 0);
                        }
                        asm volatile("" ::: "memory");
                    }
                }
                y[t] = a;
            }
            float s1 = 0.f, s2 = 0.f;
#pragma unroll
            for (int t = 0; t < 2; ++t)
#pragma unroll
                for (int r = 0; r < 16; ++r) { s1 += y[t][r]; s2 += y[t][r] * y[t][r]; }
            s1 += __shfl_xor(s1, 32); s2 += __shfl_xor(s2, 32);
            if (hi == 0) *(LAS f32x2*)(lds + RT_RED + (wid * 32 + r32) * 8) = (f32x2){s1, s2};
#pragma unroll
            for (int r = 0; r < 16; ++r) st[r] *= cd;
#pragma unroll
            for (int sp = 0; sp < 8; ++sp) {
                const bf16x8 kf = tr_frag(lds + RT_KT + sdb * 8192 + sp * 1024 + troff);
                const bf16x8 vf = tr_frag(lds + RT_V + seb * 8192 + sp * 1024 + troff);
                st = __builtin_amdgcn_mfma_f32_32x32x16_bf16(kf, vf, st, 0, 0, 0);
                if (sp & 1) asm volatile("" ::: "memory");
            }
            __syncthreads();
            {
                const f32x2 o = *(const LAS f32x2*)(lds + RT_RED + ((wid ^ 1) * 32 + r32) * 8);
                const float mu = (s1 + o.x) * (1.f / 128.f), var = (s2 + o.y) * (1.f / 128.f) - mu * mu, rstd = 1.0f / sqrtf(fmaxf(var, 0.f) + EPS);
                LAS unsigned char* stg = lds + RT_OST + wid * 4608;
#pragma unroll
                for (int t = 0; t < 2; ++t)
#pragma unroll
                    for (int gq = 0; gq < 4; ++gq) {
                        u32x2 w; w.x = cvt_pk_bf16((y[t][4 * gq] - mu) * rstd, (y[t][4 * gq + 1] - mu) * rstd); w.y = cvt_pk_bf16((y[t][4 * gq + 2] - mu) * rstd, (y[t][4 * gq + 3] - mu) * rstd);
                        *(LAS u32x2*)(stg + r32 * 144 + (32 * t + 8 * gq + 4 * hi) * 2) = w; }
#pragma unroll
                for (int gq = 0; gq < 4; ++gq) {
                    u32x2 w; w.x = cvt_pk_bf16(st[4 * gq], st[4 * gq + 1]); w.y = cvt_pk_bf16(st[4 * gq + 2], st[4 * gq + 3]);
                    *(LAS u32x2*)(lds + RT_ST + (32 * seb + r32) * 144 + (32 * sdb + 8 * gq + 4 * hi) * 2) = w; }
                asm volatile("s_waitcnt lgkmcnt(0)" ::: "memory");
#pragma unroll
                for (int it = 0; it < 4; ++it) { const int row = it * 8 + (lane >> 3), ch = lane & 7;
                    const u32x4 v = *(const LAS u32x4*)(stg + row * 144 + ch * 16);
                    const size_t t = tok0 + 32 * ib + row;
                    const u32x4 gt = rgreg[it];
                    u32x4 w; w.x = pk2(bflo(v.x) * bflo(gt.x), bfhi(v.x) * bfhi(gt.x)); w.y = pk2(bflo(v.y) * bflo(gt.y), bfhi(v.y) * bfhi(gt.y));
                    w.z = pk2(bflo(v.z) * bflo(gt.z), bfhi(v.z) * bfhi(gt.z)); w.w = pk2(bflo(v.w) * bflo(gt.w), bfhi(v.w) * bfhi(gt.w));
                    *(u32x4*)(AR + t * ARW + 512 + h * 128 + 64 * eh + 8 * ch) = w; }
                asm volatile("s_waitcnt lgkmcnt(0)" ::: "memory");
            }
        }
    }
}

template <int N> __device__ __forceinline__ float tree_reduce64(float (&v)[N], int lane) {
    constexpr int N1 = (N + 1) / 2, N2 = (N1 + 1) / 2, N3 = (N2 + 1) / 2, N4 = (N3 + 1) / 2, N5 = (N4 + 1) / 2;
    static_assert(N <= 64, "one result register");
    float a1[N1], a2[N2], a3[N3], a4[N4], a5[N5];
#define TR_STEP(SRC, NS, DST, ND, OFF) { const bool up = (lane & (OFF)) != 0; _Pragma("unroll") for (int m = 0; m < ND; ++m) { \
        const float e0 = SRC[2 * m], e1 = (2 * m + 1 < NS) ? SRC[2 * m + 1] : 0.f; const float keep = up ? e1 : e0, send = up ? e0 : e1; DST[m] = keep + __shfl_xor(send, OFF); } }
    TR_STEP(v, N, a1, N1, 32) TR_STEP(a1, N1, a2, N2, 16) TR_STEP(a2, N2, a3, N3, 8) TR_STEP(a3, N3, a4, N4, 4) TR_STEP(a4, N4, a5, N5, 2)
    float r; { const bool up = (lane & 1) != 0; const float e0 = a5[0], e1 = (N5 > 1) ? a5[N5 > 1 ? 1 : 0] : 0.f; const float keep = up ? e1 : e0, send = up ? e0 : e1; r = keep + __shfl_xor(send, 1); }
#undef TR_STEP
    return r;
}
struct TokRec { int e0, r0; float w0; int e1, r1; float w1; int pad0, pad1; };
constexpr int NGROUP = T / 128;
__device__ __forceinline__ void p5_router(Frame& F) {
    LAS float* W = (LAS float*)F.lds;
    LAS float* BIAS = (LAS float*)(F.lds + MISC_OFF + 4 * 128);
    volatile LAS unsigned* lcnt = F.MISC + 192;
    {
        const float* w_gr = F.w_gr; const float* w_er = F.w_er;
#pragma unroll 4
        for (int idx = F.tid; idx < 1024 * 32; idx += 512) { const int k = idx >> 5, c = idx & 31; W[(((k & 3) + 4 * (k >> 8)) * 64 + ((k >> 2) & 63)) * 36 + 4 + c] = w_er[idx]; }
#pragma unroll 4
        for (int idx = F.tid; idx < 1024 * 4; idx += 512) { const int k = idx >> 2, c = idx & 3; W[(((k & 3) + 4 * (k >> 8)) * 64 + ((k >> 2) & 63)) * 36 + c] = w_gr[idx]; }
        if (F.tid < 4) BIAS[F.tid] = F.b_gr[F.tid]; else if (F.tid < 36) BIAS[F.tid] = F.b_er[F.tid - 4];
    }
    const float* X2 = (const float*)F.outb; bf16_t* H2 = (bf16_t*)(F.ws + WS_H2); TokRec* TK = (TokRec*)(F.ws + WS_TOK); unsigned* CNTG = (unsigned*)(F.ws + WS_CNTG);
    const int lane = F.lane;
    f32x4 gv[4];
#pragma unroll
    for (int j = 0; j < 4; ++j) gv[j] = ((const GAS f32x4*)F.g2)[lane + 64 * j];
    for (int gi = F.vcu; gi < NGROUP; gi += F.G) {
        __syncthreads();
        if (F.tid < NEXP) lcnt[F.tid] = 0u;
        __syncthreads();
#pragma unroll 1
        for (int pp = 0; pp < 8; ++pp) {
            const int tb = gi * 128 + F.wave * 16 + 2 * pp;
            f32x4 xv[2][4]; float rstd[2];
#pragma unroll
            for (int tk = 0; tk < 2; ++tk) {
                const size_t t = (size_t)(tb + tk);
                const GAS f32x4* xr = (const GAS f32x4*)(X2 + t * DM) + lane; float s = 0.f;
#pragma unroll
                for (int j = 0; j < 4; ++j) { const f32x4 v = xr[64 * j]; xv[tk][j] = v; s += (v.x * v.x + v.y * v.y) + (v.z * v.z + v.w * v.w); }
                rstd[tk] = 1.0f / sqrtf(wave_sum(s) * (1.f / DM) + EPS);
                GAS u32x2* o8 = (GAS u32x2*)(H2 + t * DM) + lane;
#pragma unroll
                for (int j = 0; j < 4; ++j) { xv[tk][j] = xv[tk][j] * gv[j]; const f32x4 hv = xv[tk][j] * rstd[tk]; u32x2 w; w.x = pk2(hv.x, hv.y); w.y = pk2(hv.z, hv.w); o8[64 * j] = w; }
            }
            LAS float* wscr = (LAS float*)(F.lds + WSCR_OFF + F.wave * 512);
            const int brl = (int)(__builtin_bitreverse32((unsigned)lane) >> 26);
#pragma unroll
            for (int half = 0; half < 2; ++half) {
                const int c0 = half ? 5 : 0;
                float acc[40];
#pragma unroll
                for (int c = 0; c < 40; ++c) acc[c] = 0.f;
#pragma unroll
                for (int j = 0; j < 4; ++j)
#pragma unroll
                    for (int i = 0; i < 4; ++i) {
                        const LAS f32x4* wp = (const LAS f32x4*)(W + ((i + 4 * j) * 64 + lane) * 36) + c0;
                        const float x0 = xv[0][j][i], x1 = xv[1][j][i];
#pragma unroll
                        for (int c = 0; c < 5; ++c) { if (half && c == 4) continue; const f32x4 w = wp[c];
                            acc[4 * c] += x0 * w.x; acc[4 * c + 1] += x0 * w.y; acc[4 * c + 2] += x0 * w.z; acc[4 * c + 3] += x0 * w.w;
                            acc[20 + 4 * c] += x1 * w.x; acc[20 + 4 * c + 1] += x1 * w.y; acc[20 + 4 * c + 2] += x1 * w.z; acc[20 + 4 * c + 3] += x1 * w.w; }
                        asm volatile("" ::: "memory");
                    }
                const float r = tree_reduce64<40>(acc, lane);
                if (brl < 40) wscr[half * 40 + brl] = r;
            }
            asm volatile("s_waitcnt lgkmcnt(0)" ::: "memory");
            float a[36];
            { const int tk = lane & 1; const float rs = tk ? rstd[1] : rstd[0];
#pragma unroll
              for (int c = 0; c < 36; ++c) a[c] = wscr[(c < 20 ? 0 : 40) + tk * 20 + (c < 20 ? c : c - 20)] * rs + BIAS[c]; }
            asm volatile("s_waitcnt lgkmcnt(0)" ::: "memory");
            if (lane < 2) {
                const int t = tb + lane;
                int g = 0; float gm = a[0];
#pragma unroll
                for (int c = 1; c < 4; ++c) if (a[c] > gm) { gm = a[c]; g = c; }
                float gs = 0.f;
#pragma unroll
                for (int c = 0; c < 4; ++c) gs += __expf(a[c] - gm);
                const float gprob = 1.0f / gs;
                float el[8];
#pragma unroll
                for (int i = 0; i < 8; ++i) el[i] = (g == 0 ? a[4 + i] : g == 1 ? a[12 + i] : g == 2 ? a[20 + i] : a[28 + i]);
                int i0 = 0; float v0 = el[0];
#pragma unroll
                for (int i = 1; i < 8; ++i) if (el[i] > v0) { v0 = el[i]; i0 = i; }
                int i1 = -1; float v1 = -3.0e38f;
#pragma unroll
                for (int i = 0; i < 8; ++i) if (i != i0 && el[i] > v1) { v1 = el[i]; i1 = i; }
                const float ex = __expf(v1 - v0), w0 = gprob / (1.0f + ex), w1 = gprob * ex / (1.0f + ex);
                const int e0 = g * 8 + i0, e1 = g * 8 + i1;
                const int r0 = (int)__hip_atomic_fetch_add((LAS unsigned*)(lcnt + e0), 1u, __ATOMIC_RELAXED, __HIP_MEMORY_SCOPE_WORKGROUP);
                const int r1 = (int)__hip_atomic_fetch_add((LAS unsigned*)(lcnt + e1), 1u, __ATOMIC_RELAXED, __HIP_MEMORY_SCOPE_WORKGROUP);
                TokRec rec; rec.e0 = e0; rec.r0 = r0; rec.w0 = w0; rec.e1 = e1; rec.r1 = r1; rec.w1 = w1; rec.pad0 = 0; rec.pad1 = 0;
                TK[t] = rec;
            }
        }
        __syncthreads();
        if (F.tid < NEXP) CNTG[gi * NEXP + F.tid] = lcnt[F.tid];
    }
}
__device__ __forceinline__ void build_offsets(Frame& F) {
    LAS int* OFF = (LAS int*)F.lds; LAS int* SEG = (LAS int*)(F.lds + 32768);
    const unsigned* CNTG = (const unsigned*)(F.ws + WS_CNTG);
    __syncthreads();
    for (int idx = F.tid; idx < NGROUP * NEXP; idx += 512) OFF[idx] = (int)__builtin_nontemporal_load(CNTG + idx);
    __syncthreads();
    const int e = F.tid & 31, seg = F.tid >> 5;
    constexpr int GS = NGROUP / 16;
    { int s = 0;
      for (int g = 0; g < GS; ++g) s += OFF[(seg * GS + g) * NEXP + e];
      SEG[seg * NEXP + e] = s; }
    __syncthreads();
    int before = 0, total = 0;
    for (int s2 = 0; s2 < 16; ++s2) { const int v = SEG[s2 * NEXP + e]; total += v; if (s2 < seg) before += v; }
    const int pad = (total + 255) & ~255;
    int incl = pad;
#pragma unroll
    for (int o = 1; o < 32; o <<= 1) { const int v = __shfl_up(incl, o, 32); if (e >= o) incl += v; }
    const int ebase = incl - pad;
    if (F.tid < NEXP) { F.MISC[16 + e] = (unsigned)(ebase >> 8); if (e == 31) F.MISC[48] = (unsigned)(incl >> 8); }
    int run = ebase + before;
    for (int g = 0; g < GS; ++g) { const int i = (seg * GS + g) * NEXP + e; const int c = OFF[i]; OFF[i] = run; run += c; }
    __syncthreads();
}
__device__ __forceinline__ void p6_gather(Frame& F) {
    build_offsets(F);
    const LAS int* OFF = (const LAS int*)F.lds;
    const bf16_t* H2 = (const bf16_t*)(F.ws + WS_H2); bf16_t* XG = (bf16_t*)(F.ws + WS_XG); const TokRec* TK = (const TokRec*)(F.ws + WS_TOK);
    if (blockIdx.x == 0 && F.tid < 33) F.ctl[CW_CNT + F.tid] = F.MISC[16 + F.tid];
    const int gw = F.vcu * NWAVES + F.wave, NGW = F.G * NWAVES, lane = F.lane;
    for (int t = gw; t < T; t += NGW) {
        const TokRec rec = TK[t];
        const int gi = t >> 7;
        const int s0 = OFF[gi * NEXP + rec.e0] + rec.r0, s1 = OFF[gi * NEXP + rec.e1] + rec.r1;
        const GAS u32x4* src = (const GAS u32x4*)(H2 + (size_t)t * DM) + lane;
        const u32x4 v0 = src[0], v1 = src[64];
        GAS u32x4* d0 = (GAS u32x4*)(XG + (size_t)s0 * DM) + lane; GAS u32x4* d1 = (GAS u32x4*)(XG + (size_t)s1 * DM) + lane;
        d0[0] = v0; d0[64] = v1; d1[0] = v0; d1[64] = v1;
    }
}
__device__ __forceinline__ int expert_tiles_to_lds(Frame& F) {
    __syncthreads();
    if (F.tid < 33) F.MISC[16 + F.tid] = __hip_atomic_load(F.ctl + CW_CNT + F.tid, __ATOMIC_RELAXED, __HIP_MEMORY_SCOPE_AGENT);
    __syncthreads();
    return (int)F.MISC[48];
}
__device__ __forceinline__ void p9_combine(Frame& F) {
    build_offsets(F);
    const LAS int* OFF = (const LAS int*)F.lds;
    float* X2 = (float*)F.outb; const bf16_t* YB = (const bf16_t*)(F.ws + WS_YB); const TokRec* TK = (const TokRec*)(F.ws + WS_TOK);
    const int gw = F.vcu * NWAVES + F.wave, NGW = F.G * NWAVES, lane = F.lane;
    f32x4 gv[4];
#pragma unroll
    for (int j = 0; j < 4; ++j) gv[j] = ((const GAS f32x4*)F.gf)[lane + 64 * j];
    for (int ch = gw; ch < T / 16; ch += NGW) {
        const int t0 = ch * 16;
        int ms0 = 0, ms1 = 0; float mw0 = 0.f, mw1 = 0.f;
        if (lane < 16) { const TokRec rec = TK[t0 + lane]; const int gi = (t0 + lane) >> 7;
            ms0 = OFF[gi * NEXP + rec.e0] + rec.r0; ms1 = OFF[gi * NEXP + rec.e1] + rec.r1; mw0 = rec.w0; mw1 = rec.w1; }
#pragma unroll 1
        for (int k = 0; k < 8; ++k) {
            f32x4 xv[2][4]; u32x2 ya[2][4], yb[2][4]; float w0[2], w1[2];
#pragma unroll
            for (int q = 0; q < 2; ++q) {
                const int t = t0 + 2 * k + q;
                const int s0 = __shfl(ms0, 2 * k + q), s1 = __shfl(ms1, 2 * k + q); w0[q] = __shfl(mw0, 2 * k + q); w1[q] = __shfl(mw1, 2 * k + q);
                const GAS f32x4* xr = (const GAS f32x4*)(X2 + (size_t)t * DM) + lane;
                const GAS u32x2* y0 = (const GAS u32x2*)(YB + (size_t)s0 * DM) + lane; const GAS u32x2* y1 = (const GAS u32x2*)(YB + (size_t)s1 * DM) + lane;
#pragma unroll
                for (int j = 0; j < 4; ++j) { xv[q][j] = xr[64 * j]; ya[q][j] = y0[64 * j]; yb[q][j] = y1[64 * j]; }
            }
#pragma unroll
            for (int q = 0; q < 2; ++q) {
                const int t = t0 + 2 * k + q;
                f32x4 v[4]; float s = 0.f;
#pragma unroll
                for (int j = 0; j < 4; ++j) { const f32x4 x4 = xv[q][j]; const u32x2 a = ya[q][j], b = yb[q][j];
                    f32x4 r;
                    r.x = x4.x + w0[q] * bflo(a.x) + w1[q] * bflo(b.x); r.y = x4.y + w0[q] * bfhi(a.x) + w1[q] * bfhi(b.x);
                    r.z = x4.z + w0[q] * bflo(a.y) + w1[q] * bflo(b.y); r.w = x4.w + w0[q] * bfhi(a.y) + w1[q] * bfhi(b.y);
                    v[j] = r; s += (r.x * r.x + r.y * r.y) + (r.z * r.z + r.w * r.w); }
                const float rstd = 1.0f / sqrtf(wave_sum(s) * (1.f / DM) + EPS);
                GAS f32x4* xw = (GAS f32x4*)(X2 + (size_t)t * DM) + lane;
#pragma unroll
                for (int j = 0; j < 4; ++j) xw[64 * j] = v[j] * rstd * gv[j];
            }
        }
    }
}

constexpr int NPHASE = 10;
struct Args { const float* in[17]; float* out; unsigned char* ws; int ph_lo, ph_hi, use_cg, pad; };
__global__ void __launch_bounds__(NWAVES * 64, 2) hybrid_fwd(Args args) {
    extern __shared__ __attribute__((aligned(16))) unsigned char lds[];
    Frame F;
    F.lds = (LAS unsigned char*)lds;
    F.MISC = (volatile LAS unsigned*)(F.lds + MISC_OFF);
    F.tid = threadIdx.x; F.lane = F.tid & 63; F.wave = __builtin_amdgcn_readfirstlane(F.tid >> 6);
    F.G = gridDim.x; { const int bx = blockIdx.x; F.vcu = (F.G % 8 == 0) ? (bx % 8) * (F.G / 8) + bx / 8 : bx; }
    F.ws = args.ws; F.outb = (unsigned char*)args.out; F.ctl = (unsigned*)(args.ws + WS_CTL);
    F.x = args.in[0]; F.g1 = args.in[1]; F.w_in = args.in[2]; F.b_in = args.in[3]; F.sinks = args.in[4]; F.w_au = args.in[5]; F.w_ru = args.in[6]; F.w_out = args.in[7];
    F.g2 = args.in[8]; F.w_gr = args.in[9]; F.b_gr = args.in[10]; F.w_er = args.in[11]; F.b_er = args.in[12]; F.w_ge = args.in[13]; F.w_ue = args.in[14]; F.w_de = args.in[15]; F.gf = args.in[16];
    for (int u = F.tid; u < (LDS_BYTES - MISC_OFF) / 4; u += NWAVES * 64) ((LAS unsigned*)(F.lds + MISC_OFF))[u] = 0u;
    __syncthreads();
    const int lo = args.ph_lo, hi = args.ph_hi;
    const bool multi = (hi - lo) > 1;
    XcdBarrier bar; bar.bar = F.ctl + CW_BAR; bar.x = 0; bar.st = nullptr;
    if (multi) bar = xcd_barrier_post(F.ctl + CW_BAR, F.MISC + 8);
    if (args.use_cg == 12345) cg::this_grid().sync();
#define IN(k) (lo <= (k) && (k) < hi)
#define SEAM(k) do { if (IN(k) && IN((k) + 1)) xcd_barrier(bar); } while (0)

#define REP(k) ((PROBE_REP >> (k)) & 1)
#define P1_BODY { DenseOrder S; S.A = (const char*)F.outb; S.Bt = (const char*)(F.ws + WS_WIN); S.nM = T / 256; S.nN = INW / 256; S.nwg = S.nM * S.nN; S.G = F.G; S.c = (int)blockIdx.x; S.ld = DM; S.nt = 16; \
        EpiProj E{(bf16_t*)(F.ws + WS_PA), (bf16_t*)(F.ws + WS_GT), F.b_in}; pg8::gemm_phase<EpiProj, DenseOrder>(F.lds, DM, S, E); }
#define P2_BODY { if (F.G >= 256) { if (F.vcu < 128) p2_retention_mfma(F, F.vcu, 128); else p2_attention_mfma(F, F.vcu - 128, F.G - 128); } \
        else { p2_retention_mfma(F, F.vcu, F.G); p2_attention_mfma(F, F.vcu, F.G); } }
#define P3_BODY { UpOrder S; S.d.A = (const char*)F.outb; S.d.Bt = (const char*)(F.ws + WS_WUP); S.d.nM = T / 256; S.d.nN = 4; S.d.nwg = S.d.nM * 4; S.d.G = F.G; S.d.c = (int)blockIdx.x; S.d.ld = ARW; S.d.nt = 0; \
        EpiUp E{(bf16_t*)(F.ws + WS_MIX), (const bf16_t*)(F.ws + WS_GT)}; pg8::gemm_phase<EpiUp, UpOrder>(F.lds, ARW, S, E); }
#define P4_BODY { DenseOrder S; S.A = (const char*)(F.ws + WS_MIX); S.Bt = (const char*)(F.ws + WS_WOUT); S.nM = T / 256; S.nN = 4; S.nwg = S.nM * 4; S.G = F.G; S.c = (int)blockIdx.x; S.ld = DM; S.nt = 16; \
        EpiOut E{F.x, (float*)F.outb}; pg8::gemm_phase<EpiOut, DenseOrder>(F.lds, DM, S, E); }
#define P7_BODY { const int ntl = expert_tiles_to_lds(F); \
        ExpertOrder S; S.A = (const char*)(F.ws + WS_XG); S.Bt = (const char*)(F.ws + WS_WGU); S.tp = (const volatile LAS int*)(F.MISC + 16); S.ntiles = ntl; S.G = F.G; S.c = (int)blockIdx.x; S.ldA = DM; S.nt = 16; \
        S.bstride = (size_t)1024 * 1024 * 2; S.bpn = (size_t)256 * 1024 * 2; EpiSwiglu E{(bf16_t*)(F.ws + WS_ACT)}; pg8::gemm_phase<EpiSwiglu, ExpertOrder>(F.lds, DM, S, E); }
#define P8_BODY { const int ntl = expert_tiles_to_lds(F); \
        ExpertOrder S; S.A = (const char*)(F.ws + WS_ACT); S.Bt = (const char*)(F.ws + WS_WD); S.tp = (const volatile LAS int*)(F.MISC + 16); S.ntiles = ntl; S.G = F.G; S.c = (int)blockIdx.x; S.ldA = DEXP; S.nt = 8; \
        S.bstride = (size_t)1024 * 512 * 2; S.bpn = (size_t)256 * 512 * 2; EpiDown E{(bf16_t*)(F.ws + WS_YB)}; pg8::gemm_phase<EpiDown, ExpertOrder>(F.lds, DEXP, S, E); }
#define RUN(k, BODY) do { if (IN(k)) { BODY; if (REP(k)) { xcd_barrier(bar); BODY; } } SEAM(k); } while (0)
    RUN(0, p0_prologue(F));
    RUN(1, P1_BODY);
#if (PROBE_REP & 0x1000)
    if (IN(2)) { if (F.vcu < 128) { p2_retention_mfma(F, F.vcu, 128); p2_retention_mfma(F, F.vcu, 128); } else p2_attention_mfma(F, F.vcu - 128, F.G - 128); } SEAM(2);
#elif (PROBE_REP & 0x2000)
    if (IN(2)) { if (F.vcu < 128) p2_retention_mfma(F, F.vcu, 128); else { p2_attention_mfma(F, F.vcu - 128, F.G - 128); p2_attention_mfma(F, F.vcu - 128, F.G - 128); } } SEAM(2);
#else
    RUN(2, P2_BODY);
#endif
    RUN(3, P3_BODY);
    RUN(4, P4_BODY);
    RUN(5, p5_router(F));
    RUN(6, p6_gather(F));
    RUN(7, P7_BODY);
    RUN(8, P8_BODY);
    if (IN(9)) { p9_combine(F); }
#undef IN
#undef SEAM
}

extern "C" void kernel_launch(void* const* d_in, const int* in_sizes, int n_in, void* d_out, int out_size, void* d_ws, size_t ws_size, hipStream_t stream) {
    static int grid = 0;
    if (grid == 0) {
        if (n_in != 17 || in_sizes[0] != T * DM || out_size != T * DM || ws_size < WS_END) {
            fprintf(stderr, "kernel_launch: unexpected shapes (n_in %d, in0 %d, out %d, ws %zu); nothing launched\n", n_in, n_in > 0 ? in_sizes[0] : -1, out_size, ws_size); grid = -1; return; }
        int dev = 0, cus = 0, per_cu = 0;
        if (hipGetDevice(&dev) != hipSuccess || hipDeviceGetAttribute(&cus, hipDeviceAttributeMultiprocessorCount, dev) != hipSuccess) { grid = -1; return; }
        if (hipFuncSetAttribute((const void*)hybrid_fwd, hipFuncAttributeMaxDynamicSharedMemorySize, LDS_BYTES) != hipSuccess) { fprintf(stderr, "kernel_launch: hipFuncSetAttribute failed\n"); grid = -1; return; }
        if (hipOccupancyMaxActiveBlocksPerMultiprocessor(&per_cu, (const void*)hybrid_fwd, NWAVES * 64, LDS_BYTES) != hipSuccess || per_cu < 1) { fprintf(stderr, "kernel_launch: occupancy query says %d blocks per CU\n", per_cu); grid = -1; (void)hipGetLastError(); return; }
        grid = cus;
    }
    if (grid < 0) return;
    if (hipMemsetAsync((char*)d_ws + WS_CTL, 0, CTL_ZERO_BYTES, stream) != hipSuccess) return;
    Args a{};
    for (int i = 0; i < 17; ++i) a.in[i] = (const float*)d_in[i];
    a.out = (float*)d_out; a.ws = (unsigned char*)d_ws; a.use_cg = 0; a.pad = 0;
    constexpr int NL = MK_N_LAUNCHES;
    if (NL == 1) {
        a.ph_lo = 0; a.ph_hi = NPHASE;
        void* kargs[] = {&a};
        hipError_t e = hipLaunchCooperativeKernel((const void*)hybrid_fwd, dim3(grid), dim3(NWAVES * 64), kargs, LDS_BYTES, stream);
        if (e != hipSuccess) fprintf(stderr, "kernel_launch: cooperative launch failed: %s (grid %d)\n", hipGetErrorString(e), grid);
    } else {
        for (int li = 0; li < NPHASE; ++li) {
            a.ph_lo = li; a.ph_hi = li + 1;
            hipLaunchKernelGGL(hybrid_fwd, dim3(grid), dim3(NWAVES * 64), LDS_BYTES, stream, a);
        }
    }
}
```

```cpp
#include <hip/hip_runtime.h>
#include <hip/hip_cooperative_groups.h>
#include <cstdio>
#include <cstdint>
namespace cg = cooperative_groups;

#ifndef PROBE_REP
#define PROBE_REP 0
#endif
#ifndef MK_N_LAUNCHES
#define MK_N_LAUNCHES 1
#endif

#define LAS __attribute__((address_space(3)))
#define GAS __attribute__((address_space(1)))
typedef unsigned short bf16_t;
typedef short bf16x8 __attribute__((ext_vector_type(8)));
typedef float f32x4 __attribute__((ext_vector_type(4)));
typedef float f32x2 __attribute__((ext_vector_type(2)));
typedef unsigned u32x4 __attribute__((ext_vector_type(4)));
typedef unsigned u32x2 __attribute__((ext_vector_type(2)));

constexpr int DM = 1024, NB = 16, SEQ = 2048, T = NB * SEQ;
constexpr int INW = 5888, PAW = 3840, GTW = 2048;
constexpr int C_AQ = 0, C_AK = 512, C_AV = 640, C_RQ = 768, C_RK = 1280, C_RV = 1792, C_RG = 2816;
constexpr int ARW = 1536;
constexpr int NEXP = 32, DEXP = 512;
constexpr int PSLOT = 65536 + 8192;
constexpr float EPS = 1e-6f;

constexpr size_t MiB = 1u << 20;
constexpr size_t WS_CTL = 0, CTL_ZERO_BYTES = 1 * MiB;
constexpr size_t WS_WIN = 2 * MiB;
constexpr size_t WS_WUP = 14 * MiB;
constexpr size_t WS_WOUT = 17 * MiB;
constexpr size_t WS_WGU = 20 * MiB;
constexpr size_t WS_WD = 84 * MiB;
constexpr size_t WS_PA = 116 * MiB;
constexpr size_t WS_GT = 356 * MiB;
constexpr size_t WS_TOK = 484 * MiB;
constexpr size_t WS_CNTG = 485 * MiB;
constexpr size_t WS_END = 486 * MiB;
constexpr size_t WS_MIX = 116 * MiB;
constexpr size_t WS_H2 = 180 * MiB;
constexpr size_t WS_LIST = 244 * MiB;
constexpr size_t WS_ACT = 388 * MiB;
constexpr size_t WS_YB = 116 * MiB;
constexpr int CW_CNT = 1024;
constexpr int CW_BAR = 4096;

constexpr int RING_BYTES = 131072;
constexpr int SCRATCH_BYTES = 147456;
constexpr int MISC_OFF = SCRATCH_BYTES;
constexpr int WSCR_OFF = SCRATCH_BYTES + 1024;
constexpr int LDS_BYTES = SCRATCH_BYTES + 1024 + 4096;

__device__ __forceinline__ unsigned f2bf(float f) { unsigned u = __builtin_bit_cast(unsigned, f); return (u + 0x7fffu + ((u >> 16) & 1u)) >> 16; }
__device__ __forceinline__ unsigned pk2(float lo, float hi) { return f2bf(lo) | (f2bf(hi) << 16); }
__device__ __forceinline__ float bflo(unsigned w) { return __builtin_bit_cast(float, w << 16); }
__device__ __forceinline__ float bfhi(unsigned w) { return __builtin_bit_cast(float, w & 0xffff0000u); }
__device__ __forceinline__ float bf2f(bf16_t b) { return __builtin_bit_cast(float, (unsigned)b << 16); }
__device__ __forceinline__ unsigned cvt_pk_bf16(float lo, float hi) { unsigned r; asm volatile("v_cvt_pk_bf16_f32 %0, %1, %2" : "=v"(r) : "v"(lo), "v"(hi)); return r; }
__device__ __forceinline__ float sigmoidf_(float v) { return 1.0f / (1.0f + __expf(-v)); }
__device__ __forceinline__ float wave_sum(float v) {
#pragma unroll
    for (int o = 1; o < 64; o <<= 1) v += __shfl_xor(v, o);
    return v;
}
#define LDS_WAIT() asm volatile("s_waitcnt lgkmcnt(0)" ::: "memory")
#define VM_WAIT() asm volatile("s_waitcnt vmcnt(0)" ::: "memory")

namespace pg8 {
constexpr int BM = 256, BK = 64, HALF = 128, HTB = HALF * BK * 2, STAGE_BYTES = 8 * HTB;
__host__ __device__ __forceinline__ int lds_byte(int r, int c) { const int st = (r >> 4) * 2 + (c >> 5), rr = r & 15, cc = c & 31, ob = rr * 64 + cc * 2; return st * 1024 + (ob ^ (((ob >> 9) & 1) << 5)); }
__host__ __device__ __forceinline__ void stage_rc(int b, int& R, int& C) { const int st = b / 1024, sb = b % 1024, swz = sb ^ (((sb >> 9) & 1) << 5); R = (st >> 1) * 16 + swz / 64; C = (st & 1) * 32 + (swz % 64) / 2; }
__host__ __device__ __forceinline__ int perm32(int rho) { const int n = rho >> 4, i = rho & 15; return 8 * (i >> 2) + 4 * n + (i & 3); }

struct Unit { const char* a; const char* b; int pm, pn, nt, aux; };

template <class Epi, class Sched, bool GATHER = false>
__device__ __forceinline__ void gemm_phase(LAS unsigned char* lds, const int ld  , const Sched& S, const Epi& E, const LAS int* ids = nullptr) {
    const int tid = threadIdx.x, wid = __builtin_amdgcn_readfirstlane(tid >> 6), lane = tid & 63, wr = wid >> 2, wc = wid & 3, fr = lane & 15, fq = lane >> 4;
    unsigned voffA[2], voffB[2];
#pragma unroll
    for (int i = 0; i < 2; ++i) { int R, C; stage_rc(tid * 16 + i * 8192, R, C); const int Rb = Epi::PERM ? ((R & ~31) + perm32(R & 31)) : R;
        voffA[i] = (unsigned)(R * ld + C) * 2u; voffB[i] = (unsigned)(Rb * ld + C) * 2u; }
    const size_t kstep = (size_t)(BK * 2);
    const size_t hstep = (size_t)HALF * ld * 2;
    const unsigned ldsw = (unsigned)wid * 1024u;
    unsigned vAc[2][2], vAn[2][2];
    int gR[2], gC[2];
#pragma unroll
    for (int i = 0; i < 2; ++i) stage_rc(tid * 16 + i * 8192, gR[i], gC[i]);
#define PG8_AOFFS(dst, ui_) do { _Pragma("unroll") for (int h_ = 0; h_ < 2; ++h_) _Pragma("unroll") for (int i_ = 0; i_ < 2; ++i_) { \
        if (GATHER) dst[h_][i_] = ((unsigned)ids[(ui_) * 256 + h_ * 128 + gR[i_]] * (unsigned)ld + (unsigned)gC[i_]) * 2u; \
        else dst[h_][i_] = voffA[i_] + (unsigned)(h_ * hstep); } } while (0)
    const int aoff = lds_byte(wr * 64 + fr, fq * 8), boff = lds_byte(wc * 32 + fr, fq * 8);
#define PG8_SA(b, h) (((b) * 2 + (h)) * HTB)
#define PG8_SB(b, h) ((4 + (b) * 2 + (h)) * HTB)
#define PG8_STAGE(bufoff, gbase, voff) do { _Pragma("unroll") for (int _i = 0; _i < 2; ++_i) \
        __builtin_amdgcn_global_load_lds((const unsigned*)((const char*)(gbase) + (voff)[_i]), (LAS unsigned*)(lds + (bufoff) + ldsw + _i * 8192), 16, 0, 0); } while (0)
#define PG8_LDA(dst, b, h) do { _Pragma("unroll") for (int m = 0; m < 4; ++m) _Pragma("unroll") for (int k = 0; k < 2; ++k) dst[m][k] = *(const LAS bf16x8*)(lds + PG8_SA(b, h) + aoff + m * 2048 + k * 1024); } while (0)
#define PG8_LDB(dst, b, h) do { _Pragma("unroll") for (int n = 0; n < 2; ++n) _Pragma("unroll") for (int k = 0; k < 2; ++k) dst[n][k] = *(const LAS bf16x8*)(lds + PG8_SB(b, h) + boff + n * 2048 + k * 1024); } while (0)
#define PG8_MMA(ai, bj, At, Bt) do { __builtin_amdgcn_s_setprio(1); _Pragma("unroll") for (int m = 0; m < 4; ++m) _Pragma("unroll") for (int n = 0; n < 2; ++n) _Pragma("unroll") for (int k = 0; k < 2; ++k) \
        acc[ai][bj][m][n] = __builtin_amdgcn_mfma_f32_16x16x32_bf16(Bt[n][k], At[m][k], acc[ai][bj][m][n], 0, 0, 0); __builtin_amdgcn_s_setprio(0); } while (0)
#define PG8_WAIT_V(n) asm volatile("s_waitcnt vmcnt(" #n ")" ::: "memory")
#define PG8_WAIT_L(n) asm volatile("s_waitcnt lgkmcnt(" #n ")" ::: "memory")
#define PG8_BAR __builtin_amdgcn_s_barrier()
#define PG8_SCHED __builtin_amdgcn_sched_barrier(0)
    Unit cur, nxt; int ui = 0;
    if (!S.next(0, cur)) return;
    f32x4 acc[2][2][4][2];
#pragma unroll
    for (int a = 0; a < 2; ++a)
#pragma unroll
        for (int b = 0; b < 2; ++b)
#pragma unroll
            for (int m = 0; m < 4; ++m)
#pragma unroll
                for (int n = 0; n < 2; ++n) acc[a][b][m][n] = (f32x4){0.f, 0.f, 0.f, 0.f};
    bf16x8 At[4][2], B0[2][2], B1[2][2];
    const char* cA = cur.a; const char* cB = cur.b;
    PG8_AOFFS(vAc, 0);
    PG8_STAGE(PG8_SB(0, 0), cB, voffB); PG8_STAGE(PG8_SB(0, 1), cB + hstep, voffB); PG8_STAGE(PG8_SA(0, 0), cA, vAc[0]); PG8_STAGE(PG8_SA(0, 1), cA, vAc[1]);
    if (wr == 1) PG8_BAR;
    PG8_WAIT_V(2); PG8_BAR;
    PG8_STAGE(PG8_SB(1, 0), cB + kstep, voffB); PG8_STAGE(PG8_SA(1, 0), cA + kstep, vAc[0]); PG8_STAGE(PG8_SB(1, 1), cB + hstep + kstep, voffB);
    PG8_WAIT_V(6); PG8_BAR;
    for (;;) {
        const bool has_next = S.next(ui + 1, nxt);
        const char* nA = has_next ? nxt.a : cA; const char* nB = has_next ? nxt.b : cB;
        if (has_next) { PG8_AOFFS(vAn, ui + 1); } else {
#pragma unroll
            for (int h_ = 0; h_ < 2; ++h_) { vAn[h_][0] = vAc[h_][0]; vAn[h_][1] = vAc[h_][1]; } }
        const int nt = cur.nt;
        for (int t = 0; t < nt; t += 2) {
            const bool last = (t == nt - 2);
            const char* a1 = cA + (size_t)(t + 1) * kstep;
            const char* a2 = last ? nA : cA + (size_t)(t + 2) * kstep; const char* b2 = last ? nB : cB + (size_t)(t + 2) * kstep;
            const char* a3 = a2 + kstep; const char* b3 = b2 + kstep;
            unsigned v2[2][2];
#pragma unroll
            for (int h_ = 0; h_ < 2; ++h_) { v2[h_][0] = last ? vAn[h_][0] : vAc[h_][0]; v2[h_][1] = last ? vAn[h_][1] : vAc[h_][1]; }
            PG8_LDB(B0, 0, 0); PG8_LDB(B1, 0, 1); PG8_SCHED; PG8_LDA(At, 0, 0); PG8_STAGE(PG8_SA(1, 1), a1, vAc[1]);
            PG8_WAIT_V(8); PG8_WAIT_L(0); PG8_BAR; PG8_MMA(0, 0, At, B0); PG8_MMA(0, 1, At, B1); PG8_BAR; PG8_SCHED;
            PG8_LDA(At, 0, 1); PG8_STAGE(PG8_SB(0, 0), b2, voffB); PG8_STAGE(PG8_SB(0, 1), b2 + hstep, voffB); PG8_STAGE(PG8_SA(0, 0), a2, v2[0]);
            PG8_WAIT_V(8); PG8_WAIT_L(0); PG8_BAR; PG8_MMA(1, 0, At, B0); PG8_MMA(1, 1, At, B1); PG8_BAR; PG8_SCHED;
            PG8_LDB(B0, 1, 0); PG8_LDB(B1, 1, 1); PG8_SCHED; PG8_LDA(At, 1, 0); PG8_STAGE(PG8_SA(0, 1), a2, v2[1]);
            PG8_WAIT_V(8); PG8_WAIT_L(0); PG8_BAR; PG8_MMA(0, 0, At, B0); PG8_MMA(0, 1, At, B1); PG8_BAR; PG8_SCHED;
            PG8_LDA(At, 1, 1); PG8_STAGE(PG8_SB(1, 0), b3, voffB); PG8_STAGE(PG8_SB(1, 1), b3 + hstep, voffB); PG8_STAGE(PG8_SA(1, 0), a3, v2[0]);
            PG8_WAIT_V(8); PG8_WAIT_L(0); PG8_BAR; PG8_MMA(1, 0, At, B0); PG8_MMA(1, 1, At, B1); PG8_BAR; PG8_SCHED;
        }
        if (wr == 0) PG8_BAR;
        E(acc, cur, wr, wc, fr, fq);
        if (!has_next) break;
#pragma unroll
        for (int a = 0; a < 2; ++a)
#pragma unroll
            for (int b = 0; b < 2; ++b)
#pragma unroll
                for (int m = 0; m < 4; ++m)
#pragma unroll
                    for (int n = 0; n < 2; ++n) acc[a][b][m][n] = (f32x4){0.f, 0.f, 0.f, 0.f};
        cur = nxt; cA = nA; cB = nB; ++ui;
#pragma unroll
        for (int h_ = 0; h_ < 2; ++h_) { vAc[h_][0] = vAn[h_][0]; vAc[h_][1] = vAn[h_][1]; }
        if (wr == 1) PG8_BAR;
    }
    PG8_WAIT_V(0);
    PG8_BAR;
#undef PG8_AOFFS
#undef PG8_SA
#undef PG8_SB
#undef PG8_STAGE
#undef PG8_LDA
#undef PG8_LDB
#undef PG8_MMA
#undef PG8_WAIT_V
#undef PG8_WAIT_L
#undef PG8_BAR
#undef PG8_SCHED
}
typedef f32x4 Acc[2][2][4][2];
}

#define XB_TMO      128
#define XB_XCNT(j)  (256  + 64 * (j))
#define XB_XSUB(j)  (1280 + 64 * (j))
#define XB_XGEN(j)  (2304 + 64 * (j))
#define XB_TOP      3328
#define XB_TOPGEN   3392
#define XCD_BAR_WORDS 3456
#define XB_SPIN_CAP (1u << 18)
__device__ __forceinline__ unsigned xb_ld(unsigned* p)              { return __hip_atomic_load(p, __ATOMIC_RELAXED, __HIP_MEMORY_SCOPE_AGENT); }
__device__ __forceinline__ unsigned xb_add(unsigned* p, unsigned v) { return __hip_atomic_fetch_add(p, v, __ATOMIC_RELAXED, __HIP_MEMORY_SCOPE_AGENT); }
__device__ __forceinline__ unsigned xb_xcc_id() { return (unsigned)__builtin_amdgcn_s_getreg((3 << 11) | 20) & 0xFu; }
#define XB_SPIN(cond, bar) do { unsigned _sp = 0; while (cond) { __builtin_amdgcn_s_sleep(1); \
    if ((++_sp & 255u) == 0u) { if (xb_ld(&(bar)[XB_TMO])) break; if (_sp > XB_SPIN_CAP) { atomicAdd(&(bar)[XB_TMO], 1u); break; } } } } while (0)
struct XcdBarrier { unsigned* bar; unsigned x; volatile LAS unsigned* st; };
__device__ __forceinline__ XcdBarrier xcd_barrier_post(unsigned* bar, volatile LAS unsigned* st) {
    XcdBarrier b; b.bar = bar; b.x = xb_xcc_id(); b.st = st;
    if (threadIdx.x == 0) (void)xb_add(&bar[XB_XCNT(b.x)], 1u);
    return b;
}
__device__ __forceinline__ void xcd_barrier_complete(unsigned* bar, unsigned x, unsigned& nloc, unsigned& nx) {
    const unsigned G = gridDim.x * gridDim.y * gridDim.z;
    unsigned sum, cnt, mine, sp = 0u;
    for (;;) {
        sum = 0u; cnt = 0u; mine = 0u;
#pragma unroll
        for (unsigned j = 0; j < 16; ++j) { const unsigned c = xb_ld(&bar[XB_XCNT(j)]); sum += c; cnt += (c > 0u) ? 1u : 0u; mine = (j == x) ? c : mine; }
        if (sum == G) break;
        __builtin_amdgcn_s_sleep(1);
        if ((++sp & 255u) == 0u) { if (xb_ld(&bar[XB_TMO])) break; if (sp > XB_SPIN_CAP) { atomicAdd(&bar[XB_TMO], 1u); break; } }
    }
    nloc = mine > 0u ? mine : 1u; nx = cnt > 0u ? cnt : 1u;
}
__device__ __forceinline__ void xcd_barrier(const XcdBarrier& b) {
    asm volatile("s_waitcnt vmcnt(0)" ::: "memory");
    __syncthreads();
    if (threadIdx.x == 0) {
        unsigned* bar = b.bar;
        __builtin_amdgcn_s_waitcnt(0);
        unsigned nloc = b.st[0], nx = b.st[1];
        if (nloc == 0u) { xcd_barrier_complete(bar, b.x, nloc, nx); b.st[0] = nloc; b.st[1] = nx; }
        const unsigned old = xb_add(&bar[XB_XSUB(b.x)], 1u);
        const unsigned gen = old / nloc;
        if (old + 1u == (gen + 1u) * nloc) {
            __builtin_amdgcn_fence(__ATOMIC_RELEASE, "agent");
            asm volatile("s_waitcnt vmcnt(0)" ::: "memory");
            const unsigned og = xb_add(&bar[XB_TOP], 1u);
            const unsigned tg = og / nx;
            if (og + 1u == (tg + 1u) * nx) xb_add(&bar[XB_TOPGEN], 1u);
            else XB_SPIN(xb_ld(&bar[XB_TOPGEN]) == tg, bar);
            __builtin_amdgcn_fence(__ATOMIC_ACQUIRE, "agent");
            xb_add(&bar[XB_XGEN(b.x)], 1u);
            asm volatile("s_waitcnt vmcnt(0)" ::: "memory");
        } else {
            XB_SPIN(xb_ld(&bar[XB_XGEN(b.x)]) == gen, bar);
            __builtin_amdgcn_fence(__ATOMIC_ACQUIRE, "agent");
            asm volatile("s_waitcnt vmcnt(0)" ::: "memory");
        }
    }
    __syncthreads();
}

constexpr int NWAVES = 8;
struct Frame {
    LAS unsigned char* lds;
    volatile LAS unsigned* MISC;
    unsigned* ctl;
    int tid, lane, wave, vcu, G;
    unsigned char* ws; unsigned char* outb;
    const float *x, *g1, *w_in, *b_in, *sinks, *w_au, *w_ru, *w_out, *g2, *w_gr, *b_gr, *w_er, *b_er, *w_ge, *w_ue, *w_de, *gf;
};

__device__ __forceinline__ void p0_transpose_item(const float* W, int N, int k0, int n0, bf16_t* WT, size_t dpitch, int drow0, int dcol0, LAS float* scr, int lane) {
#pragma unroll 8
    for (int i = 0; i < 32; ++i) { const int kk = 2 * i + (lane >> 5); scr[kk * 33 + (lane & 31)] = W[(size_t)(k0 + kk) * N + n0 + (lane & 31)]; }
    LDS_WAIT(); asm volatile("" ::: "memory");
    const int c = lane & 7;
#pragma unroll
    for (int j = 0; j < 4; ++j) { const int n = (lane >> 3) + 8 * j; const LAS float* s = scr + (8 * c) * 33 + n;
        u32x4 o; o.x = pk2(s[0 * 33], s[1 * 33]); o.y = pk2(s[2 * 33], s[3 * 33]); o.z = pk2(s[4 * 33], s[5 * 33]); o.w = pk2(s[6 * 33], s[7 * 33]);
        *(GAS u32x4*)(WT + (size_t)(drow0 + n) * dpitch + dcol0 + k0 + 8 * c) = o; }
    LDS_WAIT(); asm volatile("" ::: "memory");
}
__device__ __forceinline__ void p0_prologue(Frame& F) {
    LAS float* scr = (LAS float*)(F.lds + F.wave * 16384);
    const int gw = F.vcu * NWAVES + F.wave, NGW = F.G * NWAVES;
    constexpr int I_IN = 16 * 184, I_AU = 8 * 32, I_RU = 16 * 32, I_OUT = 16 * 32, I_G = 32 * 256, I_U = 32 * 256, I_D = 32 * 256;
    constexpr int NITEMS = I_IN + I_AU + I_RU + I_OUT + I_G + I_U + I_D;
    bf16_t* WinT = (bf16_t*)(F.ws + WS_WIN); bf16_t* WupT = (bf16_t*)(F.ws + WS_WUP); bf16_t* WoutT = (bf16_t*)(F.ws + WS_WOUT);
    bf16_t* WguT = (bf16_t*)(F.ws + WS_WGU); bf16_t* WdT = (bf16_t*)(F.ws + WS_WD);
    for (int it = gw; it < NITEMS; it += NGW) {
        int r = it;
        if (r < I_IN) { const int kb = r / 184, nb = r % 184; p0_transpose_item(F.w_in, INW, 64 * kb, 32 * nb, WinT, 1024, 32 * nb, 0, scr, F.lane); continue; } r -= I_IN;
        if (r < I_AU) { const int kb = r / 32, nb = r % 32; p0_transpose_item(F.w_au, 1024, 64 * kb, 32 * nb, WupT, 1536, 32 * nb, 0, scr, F.lane); continue; } r -= I_AU;
        if (r < I_RU) { const int kb = r / 32, nb = r % 32; p0_transpose_item(F.w_ru, 1024, 64 * kb, 32 * nb, WupT, 1536, 32 * nb, 512, scr, F.lane); continue; } r -= I_RU;
        if (r < I_OUT) { const int kb = r / 32, nb = r % 32; p0_transpose_item(F.w_out, 1024, 64 * kb, 32 * nb, WoutT, 1024, 32 * nb, 0, scr, F.lane); continue; } r -= I_OUT;
        if (r < I_G) { const int e = r / 256, q = r % 256, kb = q / 16, nb = q % 16, n0 = 32 * nb;
            p0_transpose_item(F.w_ge + (size_t)e * 1024 * 512, 512, 64 * kb, n0, WguT + (size_t)e * 1024 * 1024, 1024, 256 * (n0 >> 7) + (n0 & 127), 0, scr, F.lane); continue; } r -= I_G;
        if (r < I_U) { const int e = r / 256, q = r % 256, kb = q / 16, nb = q % 16, n0 = 32 * nb;
            p0_transpose_item(F.w_ue + (size_t)e * 1024 * 512, 512, 64 * kb, n0, WguT + (size_t)e * 1024 * 1024, 1024, 256 * (n0 >> 7) + 128 + (n0 & 127), 0, scr, F.lane); continue; } r -= I_U;
        { const int e = r / 256, q = r % 256, kb = q / 32, nb = q % 32;
            p0_transpose_item(F.w_de + (size_t)e * 512 * 1024, 1024, 64 * kb, 32 * nb, WdT + (size_t)e * 1024 * 512, 512, 32 * nb, 0, scr, F.lane); }
    }
    bf16_t* XN = (bf16_t*)F.outb;
    f32x4 gv[4];
#pragma unroll
    for (int j = 0; j < 4; ++j) gv[j] = ((const GAS f32x4*)F.g1)[F.lane + 64 * j];
    for (int m = gw; m < T; m += NGW) {
        const GAS f32x4* xr = (const GAS f32x4*)(F.x + (size_t)m * DM) + F.lane;
        f32x4 v[4]; float s = 0.f;
#pragma unroll
        for (int j = 0; j < 4; ++j) { v[j] = xr[64 * j]; s += (v[j].x * v[j].x + v[j].y * v[j].y) + (v[j].z * v[j].z + v[j].w * v[j].w); }
        const float rstd = 1.0f / sqrtf(wave_sum(s) * (1.f / DM) + EPS);
        GAS u32x2* o8 = (GAS u32x2*)(XN + (size_t)m * DM) + F.lane;
#pragma unroll
        for (int j = 0; j < 4; ++j) { u32x2 w; w.x = pk2(v[j].x * rstd * gv[j].x, v[j].y * rstd * gv[j].y); w.y = pk2(v[j].z * rstd * gv[j].z, v[j].w * rstd * gv[j].w); o8[64 * j] = w; }
    }
}

struct DenseOrder {
    const char* A; const char* Bt; int nM, nN, nwg, G, c, ld, nt;
    __device__ __forceinline__ void tile(int wg, int& pm, int& pn) const {
        int wgid = wg; { const int q = nwg / 8, r = nwg % 8, xcd = wgid % 8, off = wgid / 8; wgid = (xcd < r ? xcd * (q + 1) : r * (q + 1) + (xcd - r) * q) + off; }
        const int nig = 8 * nN, gid = wgid / nig, fm = gid * 8, gsz = (nM - fm) < 8 ? (nM - fm) : 8;
        pm = fm + ((wgid % nig) % gsz); pn = (wgid % nig) / gsz;
    }
    __device__ __forceinline__ bool next(int i, pg8::Unit& u) const {
        const long L = (long)i * G + c; if (L >= nwg) return false;
        int pm, pn; tile((int)L, pm, pn);
        u.pm = pm; u.pn = pn; u.nt = nt; u.aux = 0;
        u.a = A + (size_t)pm * 256 * ld * 2; u.b = Bt + (size_t)pn * 256 * ld * 2; return true;
    }
};
struct UpOrder {
    DenseOrder d;
    __device__ __forceinline__ bool next(int i, pg8::Unit& u) const {
        const long L = (long)(i >> 1) * d.G + d.c; if (L >= d.nwg) return false;
        int pm, pn; d.tile((int)L, pm, pn);
        const int part = i & 1;
        u.pm = pm; u.pn = pn; u.aux = part; u.nt = part ? 16 : 8;
        u.a = d.A + (size_t)pm * 256 * ARW * 2 + (part ? 1024 : 0); u.b = d.Bt + (size_t)pn * 256 * ARW * 2 + (part ? 1024 : 0); return true;
    }
};
struct ExpertOrder {
    const char* A; const char* Bt; const volatile LAS int* tp; int ntiles, G, c, ldA, nt; size_t bstride  , bpn  ; bool gather;
    __device__ __forceinline__ bool next(int i, pg8::Unit& u) const {
        const long L = (long)i * G + c; if (L >= (long)ntiles * 4) return false;
        const int tix = (int)(L >> 2), pn = (int)(L & 3);
        int e = 0;
        for (int k = 1; k < NEXP; ++k) e += (tix >= tp[k]) ? 1 : 0;
        u.pm = tix; u.pn = pn; u.nt = nt; u.aux = e;
        u.a = gather ? A : A + (size_t)tix * 256 * ldA * 2; u.b = Bt + (size_t)e * bstride + (size_t)pn * bpn; return true;
    }
};

struct EpiProj {
    static constexpr bool PERM = true;
    bf16_t* PA; bf16_t* GT; const float* bias;
    __device__ __forceinline__ void operator()(const pg8::Acc& acc, const pg8::Unit& u, int wr, int wc, int fr, int fq) const {
        const int ct = u.pn; const int mode = ct < 11 ? 0 : (ct < 15 ? 1 : 2);
        bf16_t* base; int ldc, colt;
        if (ct < 15) { base = PA; ldc = PAW; colt = ct * 256; } else { base = GT; ldc = GTW; colt = ct * 256 - PAW; }
        const int row0 = u.pm * 256 + wr * 64 + fr, col0 = colt + wc * 32 + 8 * fq, bcol0 = ct * 256 + wc * 32 + 8 * fq;
        f32x4 bv[2][2];
#pragma unroll
        for (int bj = 0; bj < 2; ++bj)
#pragma unroll
            for (int n = 0; n < 2; ++n) bv[bj][n] = *(const f32x4*)(bias + bcol0 + bj * 128 + 4 * n);
#pragma unroll
        for (int ai = 0; ai < 2; ++ai)
#pragma unroll
            for (int m = 0; m < 4; ++m) { bf16_t* rowp = base + (size_t)(row0 + ai * 128 + m * 16) * ldc + col0;
#pragma unroll
                for (int bj = 0; bj < 2; ++bj) { f32x4 v0 = acc[ai][bj][m][0] + bv[bj][0], v1 = acc[ai][bj][m][1] + bv[bj][1];
                    if (ct == 5 || ct == 6) {
                        const int hh = (bcol0 + bj * 128 - C_RK) >> 6, pos = (row0 + ai * 128 + m * 16) & 127;
                        const float ks = 0.125f * exp2f((float)(127 - pos) * log2f(1.0f - exp2f(-5.0f - (float)hh)));
                        v0 = v0 * ks; v1 = v1 * ks; }
                    if (mode != 0) {
#pragma unroll
                        for (int j = 0; j < 4; ++j) { const float s0 = sigmoidf_(v0[j]), s1 = sigmoidf_(v1[j]); v0[j] = (mode == 1) ? v0[j] * s0 : s0; v1[j] = (mode == 1) ? v1[j] * s1 : s1; } }
                    u32x4 w; w.x = cvt_pk_bf16(v0[0], v0[1]); w.y = cvt_pk_bf16(v0[2], v0[3]); w.z = cvt_pk_bf16(v1[0], v1[1]); w.w = cvt_pk_bf16(v1[2], v1[3]);
                    *(u32x4*)(rowp + bj * 128) = w; } }
    }
};
struct EpiUp {
    static constexpr bool PERM = true;
    bf16_t* MIX; const bf16_t* GT;
    __device__ __forceinline__ void operator()(const pg8::Acc& acc, const pg8::Unit& u, int wr, int wc, int fr, int fq) const {
        const int part = u.aux;
        const int row0 = u.pm * 256 + wr * 64 + fr, col0 = u.pn * 256 + wc * 32 + 8 * fq;
#pragma unroll
        for (int ai = 0; ai < 2; ++ai) {
            u32x4 g[4][2], p[4][2];
#pragma unroll
            for (int m = 0; m < 4; ++m)
#pragma unroll
                for (int bj = 0; bj < 2; ++bj) { const size_t row = (size_t)(row0 + ai * 128 + m * 16);
                    g[m][bj] = __builtin_nontemporal_load((const u32x4*)(GT + row * GTW + part * 1024 + col0 + bj * 128));
                    p[m][bj] = part ? *(const u32x4*)(MIX + row * DM + col0 + bj * 128) : (u32x4){0u, 0u, 0u, 0u}; }
            asm volatile("" ::: "memory");
#pragma unroll
            for (int m = 0; m < 4; ++m)
#pragma unroll
                for (int bj = 0; bj < 2; ++bj) { const size_t row = (size_t)(row0 + ai * 128 + m * 16);
                    const f32x4 a0 = acc[ai][bj][m][0], a1 = acc[ai][bj][m][1]; const u32x4 gg = g[m][bj], pp = p[m][bj];
                    float r[8];
                    r[0] = bflo(gg.x) * a0[0] + bflo(pp.x); r[1] = bfhi(gg.x) * a0[1] + bfhi(pp.x); r[2] = bflo(gg.y) * a0[2] + bflo(pp.y); r[3] = bfhi(gg.y) * a0[3] + bfhi(pp.y);
                    r[4] = bflo(gg.z) * a1[0] + bflo(pp.z); r[5] = bfhi(gg.z) * a1[1] + bfhi(pp.z); r[6] = bflo(gg.w) * a1[2] + bflo(pp.w); r[7] = bfhi(gg.w) * a1[3] + bfhi(pp.w);
                    u32x4 w; w.x = cvt_pk_bf16(r[0], r[1]); w.y = cvt_pk_bf16(r[2], r[3]); w.z = cvt_pk_bf16(r[4], r[5]); w.w = cvt_pk_bf16(r[6], r[7]);
                    *(u32x4*)(MIX + row * DM + col0 + bj * 128) = w; }
            asm volatile("" ::: "memory");
        }
    }
};
struct EpiOut {
    static constexpr bool PERM = false;
    const float* x; float* X2;
    __device__ __forceinline__ void operator()(const pg8::Acc& acc, const pg8::Unit& u, int wr, int wc, int fr, int fq) const {
        const int row0 = u.pm * 256 + wr * 64 + fr, col0 = u.pn * 256 + wc * 32 + 4 * fq;
#pragma unroll
        for (int ai = 0; ai < 2; ++ai) {
            f32x4 xv[4][2][2];
#pragma unroll
            for (int m = 0; m < 4; ++m) { const size_t off = (size_t)(row0 + ai * 128 + m * 16) * DM + col0;
#pragma unroll
                for (int bj = 0; bj < 2; ++bj)
#pragma unroll
                    for (int n = 0; n < 2; ++n) xv[m][bj][n] = __builtin_nontemporal_load((const f32x4*)(x + off + bj * 128 + n * 16)); }
            asm volatile("" ::: "memory");
#pragma unroll
            for (int m = 0; m < 4; ++m) { const size_t off = (size_t)(row0 + ai * 128 + m * 16) * DM + col0;
#pragma unroll
                for (int bj = 0; bj < 2; ++bj)
#pragma unroll
                    for (int n = 0; n < 2; ++n) *(f32x4*)(X2 + off + bj * 128 + n * 16) = xv[m][bj][n] + acc[ai][bj][m][n]; }
            asm volatile("" ::: "memory");
        }
    }
};
struct EpiSwiglu {
    static constexpr bool PERM = true;
    bf16_t* ACT;
    __device__ __forceinline__ void operator()(const pg8::Acc& acc, const pg8::Unit& u, int wr, int wc, int fr, int fq) const {
        const int row0 = u.pm * 256 + wr * 64 + fr, col0 = u.pn * 128 + wc * 32 + 8 * fq;
#pragma unroll
        for (int ai = 0; ai < 2; ++ai)
#pragma unroll
            for (int m = 0; m < 4; ++m) { bf16_t* rowp = ACT + (size_t)(row0 + ai * 128 + m * 16) * DEXP + col0;
                float r[8];
#pragma unroll
                for (int n = 0; n < 2; ++n)
#pragma unroll
                    for (int j = 0; j < 4; ++j) { const float g = acc[ai][0][m][n][j], up = acc[ai][1][m][n][j]; r[4 * n + j] = g * sigmoidf_(g) * up; }
                u32x4 w; w.x = cvt_pk_bf16(r[0], r[1]); w.y = cvt_pk_bf16(r[2], r[3]); w.z = cvt_pk_bf16(r[4], r[5]); w.w = cvt_pk_bf16(r[6], r[7]);
                *(u32x4*)rowp = w; }
    }
};
struct EpiDown {
    static constexpr bool PERM = true;
    bf16_t* YB;
    __device__ __forceinline__ void operator()(const pg8::Acc& acc, const pg8::Unit& u, int wr, int wc, int fr, int fq) const {
        const int row0 = u.pm * 256 + wr * 64 + fr, col0 = u.pn * 256 + wc * 32 + 8 * fq;
#pragma unroll
        for (int ai = 0; ai < 2; ++ai)
#pragma unroll
            for (int m = 0; m < 4; ++m) { bf16_t* rowp = YB + (size_t)(row0 + ai * 128 + m * 16) * DM + col0;
#pragma unroll
                for (int bj = 0; bj < 2; ++bj) { const f32x4 v0 = acc[ai][bj][m][0], v1 = acc[ai][bj][m][1];
                    u32x4 w; w.x = cvt_pk_bf16(v0[0], v0[1]); w.y = cvt_pk_bf16(v0[2], v0[3]); w.z = cvt_pk_bf16(v1[0], v1[1]); w.w = cvt_pk_bf16(v1[2], v1[3]);
                    *(u32x4*)(rowp + bj * 128) = w; } }
    }
};

__device__ __forceinline__ void ld8bf(const bf16_t* p, float* o) { const u32x4 w = *(const u32x4*)p; o[0] = bflo(w.x); o[1] = bfhi(w.x); o[2] = bflo(w.y); o[3] = bfhi(w.y); o[4] = bflo(w.z); o[5] = bfhi(w.z); o[6] = bflo(w.w); o[7] = bfhi(w.w); }
__device__ __forceinline__ void p2_attention_naive(Frame& F, int u0, int ustride) {
    LAS float* Ks = (LAS float*)F.lds;
    LAS float* Vs = Ks + 256 * 68;
    const bf16_t* PA = (const bf16_t*)(F.ws + WS_PA); bf16_t* AR = (bf16_t*)F.outb;
    const int tid = F.tid, part = tid & 7;
    for (int unit = u0; unit < NB * 16 * 8; unit += ustride) {
        const int h = unit & 7, n = (unit >> 3) & 15, b = unit >> 7, kvh = h >> 2;
        const size_t tok0 = (size_t)b * SEQ + n * 128;
        __syncthreads();
        for (int idx = tid; idx < 256 * 8; idx += 512) {
            const int j = idx >> 3, c = idx & 7;
            float kf[8], vf[8];
            if (n == 0 && j < 128) {
#pragma unroll
                for (int i = 0; i < 8; ++i) { kf[i] = 0.f; vf[i] = 0.f; }
            } else {
                const bf16_t* rp = PA + (tok0 - 128 + j) * PAW;
                ld8bf(rp + C_AK + kvh * 64 + c * 8, kf); ld8bf(rp + C_AV + kvh * 64 + c * 8, vf);
            }
            *(LAS f32x4*)(Ks + j * 68 + c * 8) = (f32x4){kf[0], kf[1], kf[2], kf[3]}; *(LAS f32x4*)(Ks + j * 68 + c * 8 + 4) = (f32x4){kf[4], kf[5], kf[6], kf[7]};
            *(LAS f32x4*)(Vs + j * 68 + c * 8) = (f32x4){vf[0], vf[1], vf[2], vf[3]}; *(LAS f32x4*)(Vs + j * 68 + c * 8 + 4) = (f32x4){vf[4], vf[5], vf[6], vf[7]};
        }
        __syncthreads();
        const float slope = exp2f(-(float)(h + 1)), sink = F.sinks[h];
        for (int qh = 0; qh < 2; ++qh) {
            const int q = qh * 64 + (tid >> 3);
            const size_t tq = tok0 + q;
            float qr[64];
#pragma unroll
            for (int c = 0; c < 8; ++c) ld8bf(PA + tq * PAW + C_AQ + h * 64 + c * 8, qr + 8 * c);
            float o[64];
#pragma unroll
            for (int d = 0; d < 64; ++d) o[d] = 0.f;
            float mx = sink, den = (part == 0) ? 1.0f : 0.0f;
#pragma unroll 1
            for (int jj = 0; jj < 32; ++jj) {
                const int j = part + 8 * jj, dist = q + 128 - j;
                const bool valid = dist >= 0 && dist < 128 && (n > 0 || j >= 128);
                if (valid) {
                    float d = 0.f;
                    const LAS f32x4* kp = (const LAS f32x4*)(Ks + j * 68);
#pragma unroll
                    for (int c = 0; c < 16; ++c) { const f32x4 kv = kp[c]; d += qr[4 * c] * kv.x + qr[4 * c + 1] * kv.y + qr[4 * c + 2] * kv.z + qr[4 * c + 3] * kv.w; }
                    const float sc = d * 0.125f - slope * (float)dist;
                    const float mn = fmaxf(mx, sc), f = __expf(mx - mn), p = __expf(sc - mn);
                    mx = mn; den = den * f + p;
                    const LAS f32x4* vp = (const LAS f32x4*)(Vs + j * 68);
#pragma unroll
                    for (int c = 0; c < 16; ++c) { const f32x4 vv = vp[c]; o[4 * c] = o[4 * c] * f + p * vv.x; o[4 * c + 1] = o[4 * c + 1] * f + p * vv.y; o[4 * c + 2] = o[4 * c + 2] * f + p * vv.z; o[4 * c + 3] = o[4 * c + 3] * f + p * vv.w; }
                }
            }
            float ma = fmaxf(mx, __shfl_xor(mx, 1)); ma = fmaxf(ma, __shfl_xor(ma, 2)); ma = fmaxf(ma, __shfl_xor(ma, 4));
            const float fs = __expf(mx - ma);
            den *= fs; den += __shfl_xor(den, 1); den += __shfl_xor(den, 2); den += __shfl_xor(den, 4);
            const float inv = 1.0f / den;
#pragma unroll
            for (int d = 0; d < 64; ++d) { o[d] *= fs; o[d] += __shfl_xor(o[d], 1); o[d] += __shfl_xor(o[d], 2); o[d] += __shfl_xor(o[d], 4); }
            if (part == 0) {
                bf16_t* op = AR + tq * ARW + h * 64;
#pragma unroll
                for (int c = 0; c < 8; ++c) { u32x4 w0; w0.x = pk2(o[8 * c] * inv, o[8 * c + 1] * inv); w0.y = pk2(o[8 * c + 2] * inv, o[8 * c + 3] * inv); w0.z = pk2(o[8 * c + 4] * inv, o[8 * c + 5] * inv); w0.w = pk2(o[8 * c + 6] * inv, o[8 * c + 7] * inv);
                    *(u32x4*)(op + 8 * c) = w0; }
            }
        }
    }
}
__device__ __forceinline__ void p2_retention_naive(Frame& F, int u0, int ustride) {
    LAS float* Qs = (LAS float*)F.lds;
    LAS float* Ks = Qs + 128 * 68;
    LAS bf16_t* Vs = (LAS bf16_t*)(Ks + 128 * 68);
    LAS float* Ss = (LAS float*)(Vs + 128 * 136);
    const bf16_t* PA = (const bf16_t*)(F.ws + WS_PA); bf16_t* AR = (bf16_t*)F.outb;
    const int tid = F.tid;
    for (int unit = u0; unit < NB * 8; unit += ustride) {
        const int h = unit & 7, b = unit >> 3;
        const float lg = log2f(1.0f - exp2f(-5.0f - (float)h));
        __syncthreads();
        for (int idx = tid; idx < 64 * 128; idx += 512) Ss[idx] = 0.f;
        for (int n = 0; n < 16; ++n) {
            const size_t tok0 = (size_t)b * SEQ + n * 128;
            __syncthreads();
            for (int idx = tid; idx < 128 * 8; idx += 512) {
                const int j = idx >> 3, c = idx & 7; const bf16_t* rp = PA + (tok0 + j) * PAW;
                float qf[8], kf[8]; ld8bf(rp + C_RQ + h * 64 + c * 8, qf); ld8bf(rp + C_RK + h * 64 + c * 8, kf);
                *(LAS f32x4*)(Qs + j * 68 + c * 8) = (f32x4){qf[0], qf[1], qf[2], qf[3]}; *(LAS f32x4*)(Qs + j * 68 + c * 8 + 4) = (f32x4){qf[4], qf[5], qf[6], qf[7]};
                *(LAS f32x4*)(Ks + j * 68 + c * 8) = (f32x4){kf[0], kf[1], kf[2], kf[3]}; *(LAS f32x4*)(Ks + j * 68 + c * 8 + 4) = (f32x4){kf[4], kf[5], kf[6], kf[7]};
            }
            for (int idx = tid; idx < 128 * 16; idx += 512) {
                const int j = idx >> 4, c = idx & 15;
                *(LAS u32x4*)(Vs + j * 136 + c * 8) = *(const u32x4*)(PA + (tok0 + j) * PAW + C_RV + h * 128 + c * 8);
            }
            __syncthreads();
            {
                const int i = tid >> 2, part = tid & 3;
                float qreg[16];
#pragma unroll
                for (int c = 0; c < 4; ++c) { const f32x4 v = *(const LAS f32x4*)(Qs + i * 68 + 16 * part + 4 * c); qreg[4 * c] = v.x; qreg[4 * c + 1] = v.y; qreg[4 * c + 2] = v.z; qreg[4 * c + 3] = v.w; }
                float y[32];
#pragma unroll
                for (int e = 0; e < 32; ++e) y[e] = 0.f;
                const int jmax = i | 15;
                for (int j = 0; j <= jmax; ++j) {
                    float sdot = 0.f;
#pragma unroll
                    for (int c = 0; c < 4; ++c) { const f32x4 kv = *(const LAS f32x4*)(Ks + j * 68 + 16 * part + 4 * c); sdot += qreg[4 * c] * kv.x + qreg[4 * c + 1] * kv.y + qreg[4 * c + 2] * kv.z + qreg[4 * c + 3] * kv.w; }
                    sdot += __shfl_xor(sdot, 1); sdot += __shfl_xor(sdot, 2);
                    const float w = (j <= i) ? sdot * 0.125f * exp2f((float)(i - j) * lg) : 0.f;
#pragma unroll
                    for (int c = 0; c < 4; ++c) { const u32x4 vv = *(const LAS u32x4*)(Vs + j * 136 + 32 * part + 8 * c);
                        y[8 * c] += w * bflo(vv.x); y[8 * c + 1] += w * bfhi(vv.x); y[8 * c + 2] += w * bflo(vv.y); y[8 * c + 3] += w * bfhi(vv.y);
                        y[8 * c + 4] += w * bflo(vv.z); y[8 * c + 5] += w * bfhi(vv.z); y[8 * c + 6] += w * bflo(vv.w); y[8 * c + 7] += w * bfhi(vv.w); }
                }
                const float gi = exp2f((float)(i + 1) * lg);
                for (int d = 0; d < 64; ++d) {
                    const float qd = Qs[i * 68 + d] * gi;
#pragma unroll
                    for (int c = 0; c < 8; ++c) { const f32x4 sv = *(const LAS f32x4*)(Ss + d * 128 + 32 * part + 4 * c); y[4 * c] += qd * sv.x; y[4 * c + 1] += qd * sv.y; y[4 * c + 2] += qd * sv.z; y[4 * c + 3] += qd * sv.w; }
                }
                float sum = 0.f;
#pragma unroll
                for (int e = 0; e < 32; ++e) sum += y[e];
                sum += __shfl_xor(sum, 1); sum += __shfl_xor(sum, 2);
                const float mu = sum * (1.f / 128.f); float var = 0.f;
#pragma unroll
                for (int e = 0; e < 32; ++e) { y[e] -= mu; var += y[e] * y[e]; }
                var += __shfl_xor(var, 1); var += __shfl_xor(var, 2);
                const float rstd = 1.0f / sqrtf(var * (1.f / 128.f) + EPS);
                const size_t t = tok0 + i;
                const bf16_t* gp = PA + t * PAW + C_RG + h * 128 + 32 * part;
                bf16_t* op = AR + t * ARW + 512 + h * 128 + 32 * part;
#pragma unroll
                for (int c = 0; c < 4; ++c) { float g[8]; ld8bf(gp + 8 * c, g);
                    u32x4 w; w.x = pk2(y[8 * c] * rstd * g[0], y[8 * c + 1] * rstd * g[1]); w.y = pk2(y[8 * c + 2] * rstd * g[2], y[8 * c + 3] * rstd * g[3]);
                    w.z = pk2(y[8 * c + 4] * rstd * g[4], y[8 * c + 5] * rstd * g[5]); w.w = pk2(y[8 * c + 6] * rstd * g[6], y[8 * c + 7] * rstd * g[7]);
                    *(u32x4*)(op + 8 * c) = w; }
            }
            __syncthreads();
            {
                const int d = tid >> 3, eg = tid & 7;
                const float cd = exp2f(128.f * lg);
                float a[16];
#pragma unroll
                for (int c = 0; c < 4; ++c) { const f32x4 sv = *(const LAS f32x4*)(Ss + d * 128 + 16 * eg + 4 * c); a[4 * c] = sv.x * cd; a[4 * c + 1] = sv.y * cd; a[4 * c + 2] = sv.z * cd; a[4 * c + 3] = sv.w * cd; }
                for (int j = 0; j < 128; ++j) {
                    const float kd = Ks[j * 68 + d] * 0.125f * exp2f((float)(127 - j) * lg);
#pragma unroll
                    for (int c = 0; c < 2; ++c) { const u32x4 vv = *(const LAS u32x4*)(Vs + j * 136 + 16 * eg + 8 * c);
                        a[8 * c] += kd * bflo(vv.x); a[8 * c + 1] += kd * bfhi(vv.x); a[8 * c + 2] += kd * bflo(vv.y); a[8 * c + 3] += kd * bfhi(vv.y);
                        a[8 * c + 4] += kd * bflo(vv.z); a[8 * c + 5] += kd * bfhi(vv.z); a[8 * c + 6] += kd * bflo(vv.w); a[8 * c + 7] += kd * bfhi(vv.w); }
                }
#pragma unroll
                for (int c = 0; c < 4; ++c) *(LAS f32x4*)(Ss + d * 128 + 16 * eg + 4 * c) = (f32x4){a[4 * c], a[4 * c + 1], a[4 * c + 2], a[4 * c + 3]};
            }
        }
    }
}

typedef float f32x16 __attribute__((ext_vector_type(16)));
typedef short s16x4 __attribute__((ext_vector_type(4)));
__device__ __forceinline__ int crow(int r, int hi) { return (r & 3) + 8 * (r >> 2) + 4 * hi; }
__device__ __forceinline__ s16x4 ds_tr16(const LAS unsigned char* p) { return __builtin_bit_cast(s16x4, __builtin_amdgcn_ds_read_tr16_b64_v4i16((LAS s16x4*)p)); }
__device__ __forceinline__ bf16x8 pack8(const f32x16& p, int b) {
    u32x4 w; w.x = cvt_pk_bf16(p[b], p[b + 1]); w.y = cvt_pk_bf16(p[b + 2], p[b + 3]); w.z = cvt_pk_bf16(p[b + 4], p[b + 5]); w.w = cvt_pk_bf16(p[b + 6], p[b + 7]);
    return __builtin_bit_cast(bf16x8, w);
}
constexpr int AT_K = 0, AT_V = 36864, AT_WS = AT_V + 32768, AT_OST = AT_WS + 8 * 128, AT_END = AT_OST + 8 * 4096;
static_assert(AT_END <= SCRATCH_BYTES, "attention LDS");
__device__ __forceinline__ void p2_attention_mfma(Frame& F, int u0, int ustride) {
    const bf16_t* PA = (const bf16_t*)(F.ws + WS_PA); bf16_t* AR = (bf16_t*)F.outb;
    LAS unsigned char* lds = F.lds;
    const int tid = F.tid, lane = F.lane, wid = F.wave, r32 = lane & 31, hi = lane >> 5;
    const int g = wid >> 1, qhalf = wid & 1;
    constexpr float LOG2E = 1.4426950408889634f;
    for (int unit = u0; unit < NB * 16 * 2; unit += ustride) {
        const int kvh = unit & 1, n = (unit >> 1) & 15, b = unit >> 5;
        const size_t tok0 = (size_t)b * SEQ + n * 128;
        __syncthreads();
#pragma unroll
        for (int it = 0; it < 4; ++it) {
            const int idx = tid + 512 * it, j = idx >> 3, c = idx & 7;
            u32x4 kv = (u32x4){0u, 0u, 0u, 0u}, vv = (u32x4){0u, 0u, 0u, 0u};
            if (n > 0 || j >= 128) { const bf16_t* rp = PA + (tok0 - 128 + j) * PAW; kv = *(const u32x4*)(rp + C_AK + kvh * 64 + c * 8); vv = *(const u32x4*)(rp + C_AV + kvh * 64 + c * 8); }
            *(LAS u32x4*)(lds + AT_K + j * 144 + c * 16) = kv;
            *(LAS u32x4*)(lds + AT_V + (c >> 2) * 16384 + (j >> 4) * 1024 + (j & 15) * 64 + (c & 3) * 16) = vv;
        }
        __syncthreads();
        const int hd = kvh * 4 + g;
        const float SL = exp2f(-(float)(hd + 1)) * LOG2E, SC = 0.125f * LOG2E, sink2 = F.sinks[hd] * LOG2E;
#pragma unroll 1
        for (int qb = 0; qb < 2; ++qb) {
            const int m = qhalf * 2 + qb, i0 = 32 * m;
            bf16x8 qr[4];
            { const bf16_t* qp = PA + (tok0 + i0 + r32) * PAW + C_AQ + hd * 64 + hi * 8;
#pragma unroll
              for (int s = 0; s < 4; ++s) qr[s] = *(const bf16x8*)(qp + 16 * s); }
            f32x16 p[5];
#pragma unroll
            for (int c = 0; c < 5; ++c) {
                const LAS unsigned char* kp = lds + AT_K + (32 * (m + c) + r32) * 144 + hi * 16;
                f32x16 a;
#pragma unroll
                for (int r = 0; r < 16; ++r) a[r] = 0.f;
#pragma unroll
                for (int s = 0; s < 4; ++s) a = __builtin_amdgcn_mfma_f32_32x32x16_bf16(*(const LAS bf16x8*)(kp + s * 32), qr[s], a, 0, 0, 0);
                p[c] = a;
            }
            const int iq = i0 + r32;
            float mx = sink2;
#pragma unroll
            for (int c = 0; c < 5; ++c)
#pragma unroll
                for (int r = 0; r < 16; ++r) {
                    const int j = 32 * (m + c) + crow(r, hi), dist = iq + 128 - j;
                    const bool valid = dist >= 0 && dist < 128 && (n > 0 || j >= 128);
                    const float t = valid ? p[c][r] * SC - SL * (float)dist : -1e30f;
                    p[c][r] = t; mx = fmaxf(mx, t);
                }
            mx = fmaxf(mx, __shfl_xor(mx, 32));
            float sum = 0.f;
#pragma unroll
            for (int c = 0; c < 5; ++c)
#pragma unroll
                for (int r = 0; r < 16; ++r) { const float e = __builtin_amdgcn_exp2f(p[c][r] - mx); p[c][r] = e; sum += e; }
            sum += __shfl_xor(sum, 32);
            const float den = sum + __builtin_amdgcn_exp2f(sink2 - mx);
            bf16x8 pa[5][2];
#pragma unroll
            for (int c = 0; c < 5; ++c) { pa[c][0] = pack8(p[c], 0); pa[c][1] = pack8(p[c], 8); }
            f32x16 o[2];
#pragma unroll
            for (int d0 = 0; d0 < 2; ++d0) {
                f32x16 a;
#pragma unroll
                for (int r = 0; r < 16; ++r) a[r] = 0.f;
#pragma unroll
                for (int c = 0; c < 5; ++c)
#pragma unroll
                    for (int s = 0; s < 2; ++s) {
                        const LAS unsigned char* vb = lds + AT_V + d0 * 16384 + (2 * (m + c) + s) * 1024 + ((lane >> 4) & 1) * 32 + (lane & 3) * 8 + (4 * hi + ((lane & 15) >> 2)) * 64;
                        const s16x4 lo = ds_tr16(vb), h4 = ds_tr16(vb + 512);
                        const bf16x8 vf = (bf16x8){lo[0], lo[1], lo[2], lo[3], h4[0], h4[1], h4[2], h4[3]};
                        a = __builtin_amdgcn_mfma_f32_32x32x16_bf16(pa[c][s], vf, a, 0, 0, 0);
                    }
                o[d0] = a;
            }
            LAS float* wsf = (LAS float*)(lds + AT_WS + wid * 128);
            asm volatile("s_waitcnt lgkmcnt(0)" ::: "memory");
            if (hi == 0) wsf[r32] = den;
            asm volatile("s_waitcnt lgkmcnt(0)" ::: "memory");
            float rinv[16];
#pragma unroll
            for (int r = 0; r < 16; ++r) rinv[r] = 1.0f / wsf[crow(r, hi)];
            LAS bf16_t* stg = (LAS bf16_t*)(lds + AT_OST + wid * 4096);
#pragma unroll
            for (int r = 0; r < 16; ++r)
#pragma unroll
                for (int d0 = 0; d0 < 2; ++d0) stg[crow(r, hi) * 64 + d0 * 32 + r32] = (bf16_t)f2bf(o[d0][r] * rinv[r]);
            asm volatile("s_waitcnt lgkmcnt(0)" ::: "memory");
#pragma unroll
            for (int it = 0; it < 4; ++it) { const int row = it * 8 + (lane >> 3), ch = lane & 7;
                const u32x4 v = *(const LAS u32x4*)(stg + row * 64 + ch * 8);
                *(u32x4*)(AR + (tok0 + i0 + row) * ARW + hd * 64 + ch * 8) = v; }
            asm volatile("s_waitcnt lgkmcnt(0)" ::: "memory");
        }
    }
}

constexpr int RT_KR = 0, RT_KT = 18432, RT_V = RT_KT + 16384, RT_ST = RT_V + 32768, RT_RED = RT_ST + 18432, RT_OST = RT_RED + 2048, RT_Q = RT_OST + 8 * 4608, RT_END = RT_Q + 18432;
static_assert(RT_END <= SCRATCH_BYTES, "retention LDS");
__device__ __forceinline__ u32x4 scale8bf(u32x4 w, float s) {
    u32x4 o; o.x = pk2(bflo(w.x) * s, bfhi(w.x) * s); o.y = pk2(bflo(w.y) * s, bfhi(w.y) * s); o.z = pk2(bflo(w.z) * s, bfhi(w.z) * s); o.w = pk2(bflo(w.w) * s, bfhi(w.w) * s); return o;
}
__device__ __forceinline__ bf16x8 tr_frag(const LAS unsigned char* p) {
    const s16x4 lo = ds_tr16(p), h4 = ds_tr16(p + 512);
    return (bf16x8){lo[0], lo[1], lo[2], lo[3], h4[0], h4[1], h4[2], h4[3]};
}
__device__ __forceinline__ void p2_retention_mfma(Frame& F, int u0, int ustride) {
    const bf16_t* PA = (const bf16_t*)(F.ws + WS_PA); bf16_t* AR = (bf16_t*)F.outb;
    LAS unsigned char* lds = F.lds;
    const int tid = F.tid, lane = F.lane, wid = F.wave, r32 = lane & 31, hi = lane >> 5;
    const int ib = wid >> 1, eh = wid & 1;
    const int sdb = wid & 1, seb = wid >> 1;
    const int troff = ((lane >> 4) & 1) * 32 + (lane & 3) * 8 + (4 * hi + ((lane & 15) >> 2)) * 64;
    for (int unit = u0; unit < NB * 8; unit += ustride) {
        const int h = unit & 7, b = unit >> 3;
        const float lg = log2f(1.0f - exp2f(-5.0f - (float)h));
        const float fac_i = exp2f((float)(32 * ib + r32 - 127) * lg), gi1 = exp2f((float)(32 * ib + r32 + 1) * lg), cd = exp2f(128.0f * lg);
        f32x16 st;
#pragma unroll
        for (int r = 0; r < 16; ++r) st[r] = 0.f;
        __syncthreads();
        for (int idx = tid; idx < 18432 / 4; idx += 512) ((LAS unsigned*)(lds + RT_ST))[idx] = 0u;
        u32x4 kreg[2], vreg[4], qreg[2];
        {
            const size_t tok0 = (size_t)b * SEQ;
#pragma unroll
            for (int it = 0; it < 2; ++it) { const int idx = tid + 512 * it, j = idx >> 3, c = idx & 7; kreg[it] = *(const u32x4*)(PA + (tok0 + j) * PAW + C_RK + h * 64 + c * 8); }
#pragma unroll
            for (int it = 0; it < 4; ++it) { const int idx = tid + 512 * it, j = idx >> 4, c = idx & 15; vreg[it] = *(const u32x4*)(PA + (tok0 + j) * PAW + C_RV + h * 128 + c * 8); }
#pragma unroll
            for (int it = 0; it < 2; ++it) { const int idx = tid + 512 * it, j = idx >> 3, c = idx & 7; qreg[it] = *(const u32x4*)(PA + (tok0 + j) * PAW + C_RQ + h * 64 + c * 8); }
        }
#pragma unroll 1
        for (int n = 0; n < 16; ++n) {
            const size_t tok0 = (size_t)b * SEQ + n * 128;
#pragma unroll
            for (int it = 0; it < 2; ++it) { const int idx = tid + 512 * it, j = idx >> 3, c = idx & 7;
                const u32x4 kk = kreg[it];
                *(LAS u32x4*)(lds + RT_KR + j * 144 + c * 16) = kk;
                *(LAS u32x4*)(lds + RT_KT + (c >> 2) * 8192 + (j >> 4) * 1024 + (j & 15) * 64 + (c & 3) * 16) = kk;
                *(LAS u32x4*)(lds + RT_Q + j * 144 + c * 16) = qreg[it]; }
#pragma unroll
            for (int it = 0; it < 4; ++it) { const int idx = tid + 512 * it, j = idx >> 4, c = idx & 15;
                *(LAS u32x4*)(lds + RT_V + (c >> 2) * 8192 + (j >> 4) * 1024 + (j & 15) * 64 + (c & 3) * 16) = vreg[it]; }
            __syncthreads();
            if (n < 15) {
                const size_t tokn = tok0 + 128;
#pragma unroll
                for (int it = 0; it < 2; ++it) { const int idx = tid + 512 * it, j = idx >> 3, c = idx & 7; kreg[it] = *(const u32x4*)(PA + (tokn + j) * PAW + C_RK + h * 64 + c * 8); }
#pragma unroll
                for (int it = 0; it < 4; ++it) { const int idx = tid + 512 * it, j = idx >> 4, c = idx & 15; vreg[it] = *(const u32x4*)(PA + (tokn + j) * PAW + C_RV + h * 128 + c * 8); }
#pragma unroll
                for (int it = 0; it < 2; ++it) { const int idx = tid + 512 * it, j = idx >> 3, c = idx & 7; qreg[it] = *(const u32x4*)(PA + (tokn + j) * PAW + C_RQ + h * 64 + c * 8); }
            }
            u32x4 rgreg[4];
#pragma unroll
            for (int it = 0; it < 4; ++it) { const int row = it * 8 + (lane >> 3), ch = lane & 7; rgreg[it] = *(const u32x4*)(PA + (tok0 + 32 * ib + row) * PAW + C_RG + h * 128 + 64 * eh + 8 * ch); }
            bf16x8 qr[4];
#pragma unroll
            for (int s = 0; s < 4; ++s) qr[s] = *(const LAS bf16x8*)(lds + RT_Q + (32 * ib + r32) * 144 + s * 32 + hi * 16);
            bf16x8 pb[4][2];
#pragma unroll
            for (int jb = 0; jb < 4; ++jb) {
                if (jb <= ib) {
                    const LAS unsigned char* kp = lds + RT_KR + (32 * jb + r32) * 144 + hi * 16;
                    f32x16 a;
#pragma unroll
                    for (int r = 0; r < 16; ++r) a[r] = 0.f;
#pragma unroll
                    for (int s = 0; s < 4; ++s) a = __builtin_amdgcn_mfma_f32_32x32x16_bf16(*(const LAS bf16x8*)(kp + s * 32), qr[s], a, 0, 0, 0);
                    const bool diag = (jb == ib);
#pragma unroll
                    for (int r = 0; r < 16; ++r) a[r] = (!diag || crow(r, hi) <= r32) ? a[r] * fac_i : 0.f;
                    pb[jb][0] = pack8(a, 0); pb[jb][1] = pack8(a, 8);
                    asm volatile("" ::: "memory");
                } else { pb[jb][0] = (bf16x8){0, 0, 0, 0, 0, 0, 0, 0}; pb[jb][1] = (bf16x8){0, 0, 0, 0, 0, 0, 0, 0}; }
            }
            f32x16 y[2];
#pragma unroll
            for (int t = 0; t < 2; ++t) {
                const int eb = 2 * eh + t;
                const LAS unsigned char* sp = lds + RT_ST + (32 * eb + r32) * 144 + hi * 16;
                f32x16 a;
#pragma unroll
                for (int r = 0; r < 16; ++r) a[r] = 0.f;
#pragma unroll
                for (int s = 0; s < 4; ++s) a = __builtin_amdgcn_mfma_f32_32x32x16_bf16(*(const LAS bf16x8*)(sp + s * 32), qr[s], a, 0, 0, 0);
#pragma unroll
                for (int r = 0; r < 16; ++r) a[r] *= gi1;
#pragma unroll
                for (int jb = 0; jb < 4; ++jb) {
                    if (jb <= ib) {
#pragma unroll
                        for (int s2 = 0; s2 < 2; ++s2) {
                            const bf16x8 vf = tr_frag(lds + RT_V + eb * 8192 + (2 * jb + s2) * 1024 + troff);
                            a = __builtin_amdgcn_mfma_f32_32x32x16_bf16(vf, pb[jb][s2], a, 0, 0, 0);
                        }
                        asm volatile("" ::: "memory");
                    }
                }
                y[t] = a;
            }
            float s1 = 0.f, s2 = 0.f;
#pragma unroll
            for (int t = 0; t < 2; ++t)
#pragma unroll
                for (int r = 0; r < 16; ++r) { s1 += y[t][r]; s2 += y[t][r] * y[t][r]; }
            s1 += __shfl_xor(s1, 32); s2 += __shfl_xor(s2, 32);
            if (hi == 0) *(LAS f32x2*)(lds + RT_RED + (wid * 32 + r32) * 8) = (f32x2){s1, s2};
#pragma unroll
            for (int r = 0; r < 16; ++r) st[r] *= cd;
#pragma unroll
            for (int sp = 0; sp < 8; ++sp) {
                const bf16x8 kf = tr_frag(lds + RT_KT + sdb * 8192 + sp * 1024 + troff);
                const bf16x8 vf = tr_frag(lds + RT_V + seb * 8192 + sp * 1024 + troff);
                st = __builtin_amdgcn_mfma_f32_32x32x16_bf16(kf, vf, st, 0, 0, 0);
                if (sp & 1) asm volatile("" ::: "memory");
            }
            __syncthreads();
            {
                const f32x2 o = *(const LAS f32x2*)(lds + RT_RED + ((wid ^ 1) * 32 + r32) * 8);
                const float mu = (s1 + o.x) * (1.f / 128.f), var = (s2 + o.y) * (1.f / 128.f) - mu * mu, rstd = 1.0f / sqrtf(fmaxf(var, 0.f) + EPS);
                LAS unsigned char* stg = lds + RT_OST + wid * 4608;
#pragma unroll
                for (int t = 0; t < 2; ++t)
#pragma unroll
                    for (int gq = 0; gq < 4; ++gq) {
                        u32x2 w; w.x = cvt_pk_bf16((y[t][4 * gq] - mu) * rstd, (y[t][4 * gq + 1] - mu) * rstd); w.y = cvt_pk_bf16((y[t][4 * gq + 2] - mu) * rstd, (y[t][4 * gq + 3] - mu) * rstd);
                        *(LAS u32x2*)(stg + r32 * 144 + (32 * t + 8 * gq + 4 * hi) * 2) = w; }
#pragma unroll
                for (int gq = 0; gq < 4; ++gq) {
                    u32x2 w; w.x = cvt_pk_bf16(st[4 * gq], st[4 * gq + 1]); w.y = cvt_pk_bf16(st[4 * gq + 2], st[4 * gq + 3]);
                    *(LAS u32x2*)(lds + RT_ST + (32 * seb + r32) * 144 + (32 * sdb + 8 * gq + 4 * hi) * 2) = w; }
                asm volatile("s_waitcnt lgkmcnt(0)" ::: "memory");
#pragma unroll
                for (int it = 0; it < 4; ++it) { const int row = it * 8 + (lane >> 3), ch = lane & 7;
                    const u32x4 v = *(const LAS u32x4*)(stg + row * 144 + ch * 16);
                    const size_t t = tok0 + 32 * ib + row;
                    const u32x4 gt = rgreg[it];
                    u32x4 w; w.x = pk2(bflo(v.x) * bflo(gt.x), bfhi(v.x) * bfhi(gt.x)); w.y = pk2(bflo(v.y) * bflo(gt.y), bfhi(v.y) * bfhi(gt.y));
                    w.z = pk2(bflo(v.z) * bflo(gt.z), bfhi(v.z) * bfhi(gt.z)); w.w = pk2(bflo(v.w) * bflo(gt.w), bfhi(v.w) * bfhi(gt.w));
                    *(u32x4*)(AR + t * ARW + 512 + h * 128 + 64 * eh + 8 * ch) = w; }
                asm volatile("s_waitcnt lgkmcnt(0)" ::: "memory");
            }
        }
    }
}

template <int N> __device__ __forceinline__ float tree_reduce64(float (&v)[N], int lane) {
    constexpr int N1 = (N + 1) / 2, N2 = (N1 + 1) / 2, N3 = (N2 + 1) / 2, N4 = (N3 + 1) / 2, N5 = (N4 + 1) / 2;
    static_assert(N <= 64, "one result register");
    float a1[N1], a2[N2], a3[N3], a4[N4], a5[N5];
#define TR_STEP(SRC, NS, DST, ND, OFF) { const bool up = (lane & (OFF)) != 0; _Pragma("unroll") for (int m = 0; m < ND; ++m) { \
        const float e0 = SRC[2 * m], e1 = (2 * m + 1 < NS) ? SRC[2 * m + 1] : 0.f; const float keep = up ? e1 : e0, send = up ? e0 : e1; DST[m] = keep + __shfl_xor(send, OFF); } }
    TR_STEP(v, N, a1, N1, 32) TR_STEP(a1, N1, a2, N2, 16) TR_STEP(a2, N2, a3, N3, 8) TR_STEP(a3, N3, a4, N4, 4) TR_STEP(a4, N4, a5, N5, 2)
    float r; { const bool up = (lane & 1) != 0; const float e0 = a5[0], e1 = (N5 > 1) ? a5[N5 > 1 ? 1 : 0] : 0.f; const float keep = up ? e1 : e0, send = up ? e0 : e1; r = keep + __shfl_xor(send, 1); }
#undef TR_STEP
    return r;
}
struct TokRec { int e0, r0; float w0; int e1, r1; float w1; int pad0, pad1; };
constexpr int NGROUP = T / 128;
__device__ __forceinline__ void p5_router(Frame& F) {
    LAS float* W = (LAS float*)F.lds;
    LAS float* BIAS = (LAS float*)(F.lds + MISC_OFF + 4 * 128);
    volatile LAS unsigned* lcnt = F.MISC + 192;
    {
        const float* w_gr = F.w_gr; const float* w_er = F.w_er;
#pragma unroll 4
        for (int idx = F.tid; idx < 1024 * 32; idx += 512) { const int k = idx >> 5, c = idx & 31; W[(((k & 3) + 4 * (k >> 8)) * 64 + ((k >> 2) & 63)) * 36 + 4 + c] = w_er[idx]; }
#pragma unroll 4
        for (int idx = F.tid; idx < 1024 * 4; idx += 512) { const int k = idx >> 2, c = idx & 3; W[(((k & 3) + 4 * (k >> 8)) * 64 + ((k >> 2) & 63)) * 36 + c] = w_gr[idx]; }
        if (F.tid < 4) BIAS[F.tid] = F.b_gr[F.tid]; else if (F.tid < 36) BIAS[F.tid] = F.b_er[F.tid - 4];
    }
    const float* X2 = (const float*)F.outb; bf16_t* H2 = (bf16_t*)(F.ws + WS_H2); TokRec* TK = (TokRec*)(F.ws + WS_TOK); unsigned* CNTG = (unsigned*)(F.ws + WS_CNTG);
    const int lane = F.lane;
    f32x4 gv[4];
#pragma unroll
    for (int j = 0; j < 4; ++j) gv[j] = ((const GAS f32x4*)F.g2)[lane + 64 * j];
    for (int gi = F.vcu; gi < NGROUP; gi += F.G) {
        __syncthreads();
        if (F.tid < NEXP) lcnt[F.tid] = 0u;
        __syncthreads();
#pragma unroll 1
        for (int pp = 0; pp < 8; ++pp) {
            const int tb = gi * 128 + F.wave * 16 + 2 * pp;
            f32x4 xv[2][4]; float rstd[2];
#pragma unroll
            for (int tk = 0; tk < 2; ++tk) {
                const size_t t = (size_t)(tb + tk);
                const GAS f32x4* xr = (const GAS f32x4*)(X2 + t * DM) + lane; float s = 0.f;
#pragma unroll
                for (int j = 0; j < 4; ++j) { const f32x4 v = xr[64 * j]; xv[tk][j] = v; s += (v.x * v.x + v.y * v.y) + (v.z * v.z + v.w * v.w); }
                rstd[tk] = 1.0f / sqrtf(wave_sum(s) * (1.f / DM) + EPS);
                GAS u32x2* o8 = (GAS u32x2*)(H2 + t * DM) + lane;
#pragma unroll
                for (int j = 0; j < 4; ++j) { xv[tk][j] = xv[tk][j] * gv[j]; const f32x4 hv = xv[tk][j] * rstd[tk]; u32x2 w; w.x = pk2(hv.x, hv.y); w.y = pk2(hv.z, hv.w); o8[64 * j] = w; }
            }
            LAS float* wscr = (LAS float*)(F.lds + WSCR_OFF + F.wave * 512);
            const int brl = (int)(__builtin_bitreverse32((unsigned)lane) >> 26);
#pragma unroll
            for (int half = 0; half < 2; ++half) {
                const int c0 = half ? 5 : 0;
                float acc[40];
#pragma unroll
                for (int c = 0; c < 40; ++c) acc[c] = 0.f;
#pragma unroll
                for (int j = 0; j < 4; ++j)
#pragma unroll
                    for (int i = 0; i < 4; ++i) {
                        const LAS f32x4* wp = (const LAS f32x4*)(W + ((i + 4 * j) * 64 + lane) * 36) + c0;
                        const float x0 = xv[0][j][i], x1 = xv[1][j][i];
#pragma unroll
                        for (int c = 0; c < 5; ++c) { if (half && c == 4) continue; const f32x4 w = wp[c];
                            acc[4 * c] += x0 * w.x; acc[4 * c + 1] += x0 * w.y; acc[4 * c + 2] += x0 * w.z; acc[4 * c + 3] += x0 * w.w;
                            acc[20 + 4 * c] += x1 * w.x; acc[20 + 4 * c + 1] += x1 * w.y; acc[20 + 4 * c + 2] += x1 * w.z; acc[20 + 4 * c + 3] += x1 * w.w; }
                        asm volatile("" ::: "memory");
                    }
                const float r = tree_reduce64<40>(acc, lane);
                if (brl < 40) wscr[half * 40 + brl] = r;
            }
            asm volatile("s_waitcnt lgkmcnt(0)" ::: "memory");
            float a[36];
            { const int tk = lane & 1; const float rs = tk ? rstd[1] : rstd[0];
#pragma unroll
              for (int c = 0; c < 36; ++c) a[c] = wscr[(c < 20 ? 0 : 40) + tk * 20 + (c < 20 ? c : c - 20)] * rs + BIAS[c]; }
            asm volatile("s_waitcnt lgkmcnt(0)" ::: "memory");
            if (lane < 2) {
                const int t = tb + lane;
                int g = 0; float gm = a[0];
#pragma unroll
                for (int c = 1; c < 4; ++c) if (a[c] > gm) { gm = a[c]; g = c; }
                float gs = 0.f;
#pragma unroll
                for (int c = 0; c < 4; ++c) gs += __expf(a[c] - gm);
                const float gprob = 1.0f / gs;
                float el[8];
#pragma unroll
                for (int i = 0; i < 8; ++i) el[i] = (g == 0 ? a[4 + i] : g == 1 ? a[12 + i] : g == 2 ? a[20 + i] : a[28 + i]);
                int i0 = 0; float v0 = el[0];
#pragma unroll
                for (int i = 1; i < 8; ++i) if (el[i] > v0) { v0 = el[i]; i0 = i; }
                int i1 = -1; float v1 = -3.0e38f;
#pragma unroll
                for (int i = 0; i < 8; ++i) if (i != i0 && el[i] > v1) { v1 = el[i]; i1 = i; }
                const float ex = __expf(v1 - v0), w0 = gprob / (1.0f + ex), w1 = gprob * ex / (1.0f + ex);
                const int e0 = g * 8 + i0, e1 = g * 8 + i1;
                const int r0 = (int)__hip_atomic_fetch_add((LAS unsigned*)(lcnt + e0), 1u, __ATOMIC_RELAXED, __HIP_MEMORY_SCOPE_WORKGROUP);
                const int r1 = (int)__hip_atomic_fetch_add((LAS unsigned*)(lcnt + e1), 1u, __ATOMIC_RELAXED, __HIP_MEMORY_SCOPE_WORKGROUP);
                TokRec rec; rec.e0 = e0; rec.r0 = r0; rec.w0 = w0; rec.e1 = e1; rec.r1 = r1; rec.w1 = w1; rec.pad0 = 0; rec.pad1 = 0;
                TK[t] = rec;
            }
        }
        __syncthreads();
        if (F.tid < NEXP) CNTG[gi * NEXP + F.tid] = lcnt[F.tid];
    }
}
__device__ __forceinline__ void build_offsets(Frame& F) {
    LAS int* OFF = (LAS int*)F.lds; LAS int* SEG = (LAS int*)(F.lds + 32768);
    const unsigned* CNTG = (const unsigned*)(F.ws + WS_CNTG);
    __syncthreads();
    for (int idx = F.tid; idx < NGROUP * NEXP; idx += 512) OFF[idx] = (int)__builtin_nontemporal_load(CNTG + idx);
    __syncthreads();
    const int e = F.tid & 31, seg = F.tid >> 5;
    constexpr int GS = NGROUP / 16;
    { int s = 0;
      for (int g = 0; g < GS; ++g) s += OFF[(seg * GS + g) * NEXP + e];
      SEG[seg * NEXP + e] = s; }
    __syncthreads();
    int before = 0, total = 0;
    for (int s2 = 0; s2 < 16; ++s2) { const int v = SEG[s2 * NEXP + e]; total += v; if (s2 < seg) before += v; }
    const int pad = (total + 255) & ~255;
    int incl = pad;
#pragma unroll
    for (int o = 1; o < 32; o <<= 1) { const int v = __shfl_up(incl, o, 32); if (e >= o) incl += v; }
    const int ebase = incl - pad;
    if (F.tid < NEXP) { F.MISC[16 + e] = (unsigned)(ebase >> 8); F.MISC[64 + e] = (unsigned)total; if (e == 31) F.MISC[48] = (unsigned)(incl >> 8); }
    int run = ebase + before;
    for (int g = 0; g < GS; ++g) { const int i = (seg * GS + g) * NEXP + e; const int c = OFF[i]; OFF[i] = run; run += c; }
    __syncthreads();
}
__device__ __forceinline__ void p6_lists(Frame& F) {
    build_offsets(F);
    const LAS int* OFF = (const LAS int*)F.lds;
    int* LIST = (int*)(F.ws + WS_LIST); const TokRec* TK = (const TokRec*)(F.ws + WS_TOK);
    if (blockIdx.x == 0 && F.tid < 33) F.ctl[CW_CNT + F.tid] = F.MISC[16 + F.tid];
    for (int gi = F.vcu; gi < NGROUP; gi += F.G)
        if (F.tid < 128) { const int t = gi * 128 + F.tid; const TokRec rec = TK[t];
            LIST[OFF[gi * NEXP + rec.e0] + rec.r0] = t; LIST[OFF[gi * NEXP + rec.e1] + rec.r1] = t; }
    for (int e = F.vcu; e < NEXP; e += F.G) {
        const int base = (int)F.MISC[16 + e] << 8, tot = (int)F.MISC[64 + e], end = (int)F.MISC[17 + e] << 8;
        for (int s = base + tot + F.tid; s < end; s += 512) LIST[s] = 0;
    }
}
__device__ __forceinline__ int expert_tiles_to_lds(Frame& F) {
    __syncthreads();
    if (F.tid < 33) F.MISC[16 + F.tid] = __hip_atomic_load(F.ctl + CW_CNT + F.tid, __ATOMIC_RELAXED, __HIP_MEMORY_SCOPE_AGENT);
    __syncthreads();
    return (int)F.MISC[48];
}
__device__ __forceinline__ void p9_combine(Frame& F) {
    build_offsets(F);
    const LAS int* OFF = (const LAS int*)F.lds;
    float* X2 = (float*)F.outb; const bf16_t* YB = (const bf16_t*)(F.ws + WS_YB); const TokRec* TK = (const TokRec*)(F.ws + WS_TOK);
    const int gw = F.vcu * NWAVES + F.wave, NGW = F.G * NWAVES, lane = F.lane;
    f32x4 gv[4];
#pragma unroll
    for (int j = 0; j < 4; ++j) gv[j] = ((const GAS f32x4*)F.gf)[lane + 64 * j];
    for (int ch = gw; ch < T / 16; ch += NGW) {
        const int t0 = ch * 16;
        int ms0 = 0, ms1 = 0; float mw0 = 0.f, mw1 = 0.f;
        if (lane < 16) { const TokRec rec = TK[t0 + lane]; const int gi = (t0 + lane) >> 7;
            ms0 = OFF[gi * NEXP + rec.e0] + rec.r0; ms1 = OFF[gi * NEXP + rec.e1] + rec.r1; mw0 = rec.w0; mw1 = rec.w1; }
#pragma unroll 1
        for (int k = 0; k < 8; ++k) {
            f32x4 xv[2][4]; u32x2 ya[2][4], yb[2][4]; float w0[2], w1[2];
#pragma unroll
            for (int q = 0; q < 2; ++q) {
                const int t = t0 + 2 * k + q;
                const int s0 = __shfl(ms0, 2 * k + q), s1 = __shfl(ms1, 2 * k + q); w0[q] = __shfl(mw0, 2 * k + q); w1[q] = __shfl(mw1, 2 * k + q);
                const GAS f32x4* xr = (const GAS f32x4*)(X2 + (size_t)t * DM) + lane;
                const GAS u32x2* y0 = (const GAS u32x2*)(YB + (size_t)s0 * DM) + lane; const GAS u32x2* y1 = (const GAS u32x2*)(YB + (size_t)s1 * DM) + lane;
#pragma unroll
                for (int j = 0; j < 4; ++j) { xv[q][j] = xr[64 * j]; ya[q][j] = y0[64 * j]; yb[q][j] = y1[64 * j]; }
            }
#pragma unroll
            for (int q = 0; q < 2; ++q) {
                const int t = t0 + 2 * k + q;
                f32x4 v[4]; float s = 0.f;
#pragma unroll
                for (int j = 0; j < 4; ++j) { const f32x4 x4 = xv[q][j]; const u32x2 a = ya[q][j], b = yb[q][j];
                    f32x4 r;
                    r.x = x4.x + w0[q] * bflo(a.x) + w1[q] * bflo(b.x); r.y = x4.y + w0[q] * bfhi(a.x) + w1[q] * bfhi(b.x);
                    r.z = x4.z + w0[q] * bflo(a.y) + w1[q] * bflo(b.y); r.w = x4.w + w0[q] * bfhi(a.y) + w1[q] * bfhi(b.y);
                    v[j] = r; s += (r.x * r.x + r.y * r.y) + (r.z * r.z + r.w * r.w); }
                const float rstd = 1.0f / sqrtf(wave_sum(s) * (1.f / DM) + EPS);
                GAS f32x4* xw = (GAS f32x4*)(X2 + (size_t)t * DM) + lane;
#pragma unroll
                for (int j = 0; j < 4; ++j) xw[64 * j] = v[j] * rstd * gv[j];
            }
        }
    }
}

constexpr int NPHASE = 10;
struct Args { const float* in[17]; float* out; unsigned char* ws; int ph_lo, ph_hi, use_cg, pad; };
__global__ void __launch_bounds__(NWAVES * 64, 2) hybrid_fwd(Args args) {
    extern __shared__ __attribute__((aligned(16))) unsigned char lds[];
    Frame F;
    F.lds = (LAS unsigned char*)lds;
    F.MISC = (volatile LAS unsigned*)(F.lds + MISC_OFF);
    F.tid = threadIdx.x; F.lane = F.tid & 63; F.wave = __builtin_amdgcn_readfirstlane(F.tid >> 6);
    F.G = gridDim.x; { const int bx = blockIdx.x; F.vcu = (F.G % 8 == 0) ? (bx % 8) * (F.G / 8) + bx / 8 : bx; }
    F.ws = args.ws; F.outb = (unsigned char*)args.out; F.ctl = (unsigned*)(args.ws + WS_CTL);
    F.x = args.in[0]; F.g1 = args.in[1]; F.w_in = args.in[2]; F.b_in = args.in[3]; F.sinks = args.in[4]; F.w_au = args.in[5]; F.w_ru = args.in[6]; F.w_out = args.in[7];
    F.g2 = args.in[8]; F.w_gr = args.in[9]; F.b_gr = args.in[10]; F.w_er = args.in[11]; F.b_er = args.in[12]; F.w_ge = args.in[13]; F.w_ue = args.in[14]; F.w_de = args.in[15]; F.gf = args.in[16];
    for (int u = F.tid; u < (LDS_BYTES - MISC_OFF) / 4; u += NWAVES * 64) ((LAS unsigned*)(F.lds + MISC_OFF))[u] = 0u;
    __syncthreads();
    const int lo = args.ph_lo, hi = args.ph_hi;
    const bool multi = (hi - lo) > 1;
    XcdBarrier bar; bar.bar = F.ctl + CW_BAR; bar.x = 0; bar.st = nullptr;
    if (multi) bar = xcd_barrier_post(F.ctl + CW_BAR, F.MISC + 8);
    if (args.use_cg == 12345) cg::this_grid().sync();
#define IN(k) (lo <= (k) && (k) < hi)
#define SEAM(k) do { if (IN(k) && IN((k) + 1)) xcd_barrier(bar); } while (0)

#define REP(k) ((PROBE_REP >> (k)) & 1)
#define P1_BODY { DenseOrder S; S.A = (const char*)F.outb; S.Bt = (const char*)(F.ws + WS_WIN); S.nM = T / 256; S.nN = INW / 256; S.nwg = S.nM * S.nN; S.G = F.G; S.c = (int)blockIdx.x; S.ld = DM; S.nt = 16; \
        EpiProj E{(bf16_t*)(F.ws + WS_PA), (bf16_t*)(F.ws + WS_GT), F.b_in}; pg8::gemm_phase<EpiProj, DenseOrder>(F.lds, DM, S, E); }
#define P2_BODY { if (F.G >= 256) { if (F.vcu < 128) p2_retention_mfma(F, F.vcu, 128); else p2_attention_mfma(F, F.vcu - 128, F.G - 128); } \
        else { p2_retention_mfma(F, F.vcu, F.G); p2_attention_mfma(F, F.vcu, F.G); } }
#define P3_BODY { UpOrder S; S.d.A = (const char*)F.outb; S.d.Bt = (const char*)(F.ws + WS_WUP); S.d.nM = T / 256; S.d.nN = 4; S.d.nwg = S.d.nM * 4; S.d.G = F.G; S.d.c = (int)blockIdx.x; S.d.ld = ARW; S.d.nt = 0; \
        EpiUp E{(bf16_t*)(F.ws + WS_MIX), (const bf16_t*)(F.ws + WS_GT)}; pg8::gemm_phase<EpiUp, UpOrder>(F.lds, ARW, S, E); }
#define P4_BODY { DenseOrder S; S.A = (const char*)(F.ws + WS_MIX); S.Bt = (const char*)(F.ws + WS_WOUT); S.nM = T / 256; S.nN = 4; S.nwg = S.nM * 4; S.G = F.G; S.c = (int)blockIdx.x; S.ld = DM; S.nt = 16; \
        EpiOut E{F.x, (float*)F.outb}; pg8::gemm_phase<EpiOut, DenseOrder>(F.lds, DM, S, E); }
#define P7_BODY { const int ntl = expert_tiles_to_lds(F); \
        LAS int* IDS = (LAS int*)(F.lds + RING_BYTES);                   \
        { const int* LIST = (const int*)(F.ws + WS_LIST); \
          for (int ui_ = F.wave; ui_ < 16; ui_ += NWAVES) { const long L_ = (long)ui_ * F.G + (int)blockIdx.x; if (L_ >= (long)ntl * 4) break; \
              *(LAS u32x4*)(IDS + ui_ * 256 + F.lane * 4) = *(const u32x4*)(LIST + (L_ >> 2) * 256 + F.lane * 4); } } \
        __syncthreads(); \
        ExpertOrder S; S.A = (const char*)(F.ws + WS_H2); S.Bt = (const char*)(F.ws + WS_WGU); S.tp = (const volatile LAS int*)(F.MISC + 16); S.ntiles = ntl; S.G = F.G; S.c = (int)blockIdx.x; S.ldA = DM; S.nt = 16; S.gather = true; \
        S.bstride = (size_t)1024 * 1024 * 2; S.bpn = (size_t)256 * 1024 * 2; EpiSwiglu E{(bf16_t*)(F.ws + WS_ACT)}; pg8::gemm_phase<EpiSwiglu, ExpertOrder, true>(F.lds, DM, S, E, IDS); }
#define P8_BODY { const int ntl = expert_tiles_to_lds(F); \
        ExpertOrder S; S.A = (const char*)(F.ws + WS_ACT); S.Bt = (const char*)(F.ws + WS_WD); S.tp = (const volatile LAS int*)(F.MISC + 16); S.ntiles = ntl; S.G = F.G; S.c = (int)blockIdx.x; S.ldA = DEXP; S.nt = 8; S.gather = false; \
        S.bstride = (size_t)1024 * 512 * 2; S.bpn = (size_t)256 * 512 * 2; EpiDown E{(bf16_t*)(F.ws + WS_YB)}; pg8::gemm_phase<EpiDown, ExpertOrder>(F.lds, DEXP, S, E); }
#define RUN(k, BODY) do { if (IN(k)) { BODY; if (REP(k)) { xcd_barrier(bar); BODY; } } SEAM(k); } while (0)
    RUN(0, p0_prologue(F));
    RUN(1, P1_BODY);
#if (PROBE_REP & 0x1000)
    if (IN(2)) { if (F.vcu < 128) { p2_retention_mfma(F, F.vcu, 128); p2_retention_mfma(F, F.vcu, 128); } else p2_attention_mfma(F, F.vcu - 128, F.G - 128); } SEAM(2);
#elif (PROBE_REP & 0x2000)
    if (IN(2)) { if (F.vcu < 128) p2_retention_mfma(F, F.vcu, 128); else { p2_attention_mfma(F, F.vcu - 128, F.G - 128); p2_attention_mfma(F, F.vcu - 128, F.G - 128); } } SEAM(2);
#else
    RUN(2, P2_BODY);
#endif
    RUN(3, P3_BODY);
    RUN(4, P4_BODY);
    RUN(5, p5_router(F));
    RUN(6, p6_lists(F));
    RUN(7, P7_BODY);
    RUN(8, P8_BODY);
    if (IN(9)) { p9_combine(F); }
#undef IN
#undef SEAM
}

extern "C" void kernel_launch(void* const* d_in, const int* in_sizes, int n_in, void* d_out, int out_size, void* d_ws, size_t ws_size, hipStream_t stream) {
    static int grid = 0;
    if (grid == 0) {
        if (n_in != 17 || in_sizes[0] != T * DM || out_size != T * DM || ws_size < WS_END) {
            fprintf(stderr, "kernel_launch: unexpected shapes (n_in %d, in0 %d, out %d, ws %zu); nothing launched\n", n_in, n_in > 0 ? in_sizes[0] : -1, out_size, ws_size); grid = -1; return; }
        int dev = 0, cus = 0, per_cu = 0;
        if (hipGetDevice(&dev) != hipSuccess || hipDeviceGetAttribute(&cus, hipDeviceAttributeMultiprocessorCount, dev) != hipSuccess) { grid = -1; return; }
        if (hipFuncSetAttribute((const void*)hybrid_fwd, hipFuncAttributeMaxDynamicSharedMemorySize, LDS_BYTES) != hipSuccess) { fprintf(stderr, "kernel_launch: hipFuncSetAttribute failed\n"); grid = -1; return; }
        if (hipOccupancyMaxActiveBlocksPerMultiprocessor(&per_cu, (const void*)hybrid_fwd, NWAVES * 64, LDS_BYTES) != hipSuccess || per_cu < 1) { fprintf(stderr, "kernel_launch: occupancy query says %d blocks per CU\n", per_cu); grid = -1; (void)hipGetLastError(); return; }
        grid = cus;
    }
    if (grid < 0) return;
    if (hipMemsetAsync((char*)d_ws + WS_CTL, 0, CTL_ZERO_BYTES, stream) != hipSuccess) return;
    Args a{};
    for (int i = 0; i < 17; ++i) a.in[i] = (const float*)d_in[i];
    a.out = (float*)d_out; a.ws = (unsigned char*)d_ws; a.use_cg = 0; a.pad = 0;
    constexpr int NL = MK_N_LAUNCHES;
    if (NL == 1) {
        a.ph_lo = 0; a.ph_hi = NPHASE;
        void* kargs[] = {&a};
        hipError_t e = hipLaunchCooperativeKernel((const void*)hybrid_fwd, dim3(grid), dim3(NWAVES * 64), kargs, LDS_BYTES, stream);
        if (e != hipSuccess) fprintf(stderr, "kernel_launch: cooperative launch failed: %s (grid %d)\n", hipGetErrorString(e), grid);
    } else {
        for (int li = 0; li < NPHASE; ++li) {
            a.ph_lo = li; a.ph_hi = li + 1;
            hipLaunchKernelGGL(hybrid_fwd, dim3(grid), dim3(NWAVES * 64), LDS_BYTES, stream, a);
        }
    }
}
```
